# Optimizing an MI355X kernel written in HIP

```python
import jax, jax.numpy as jnp
from jax import lax
import numpy as np

D_MODEL = 1024
BATCH = 8
SEQ = 4096
DEPTH = 1

EPS = 1e-6
ROPE_THETA = 10000.0
BLOCK = 128

HEAD_DIM = 64
SWA_HEADS = 8
SWA_KV_HEADS = 2
SWA_GROUP = SWA_HEADS // SWA_KV_HEADS
WINDOW = 128

MLA_HEADS = 8
MLA_NOPE_DIM = 64
MLA_ROPE_DIM = 32
MLA_V_DIM = 64
MLA_QK_DIM = MLA_NOPE_DIM + MLA_ROPE_DIM
Q_LORA_RANK = 384
KV_LORA_RANK = 256

D_FF = -(-8 * D_MODEL // (3 * 256)) * 256

IN_SIZES = [
    SWA_HEADS * HEAD_DIM,
    SWA_KV_HEADS * HEAD_DIM,
    SWA_KV_HEADS * HEAD_DIM,
    Q_LORA_RANK,
    KV_LORA_RANK,
    MLA_ROPE_DIM,
    D_MODEL,
    D_MODEL,
]
IN_WIDTH = int(sum(IN_SIZES))
IN_OFFSETS = [int(v) for v in np.cumsum(IN_SIZES)[:-1]]

kernel_name = "hybrid_swa_sink_mla_gated_block"


def rmsnorm(x, g):
    xf = x.astype(jnp.float32)
    xf = xf * lax.rsqrt(jnp.mean(xf * xf, axis=-1, keepdims=True) + EPS)
    return (xf * g.astype(jnp.float32)).astype(x.dtype)


def rope_tables(seq, dim):
    inv = ROPE_THETA ** (-jnp.arange(0, dim, 2, dtype=jnp.float32) / dim)
    ang = jnp.arange(seq, dtype=jnp.float32)[:, None] * inv[None, :]
    return jnp.cos(ang)[:, None, :], jnp.sin(ang)[:, None, :]


def apply_rope(x, cos, sin):
    xf = x.astype(jnp.float32)
    x1, x2 = jnp.split(xf, 2, axis=-1)
    out = jnp.concatenate([x1 * cos - x2 * sin, x2 * cos + x1 * sin], axis=-1)
    return out.astype(x.dtype)


def swa_sink_attention(q, k, v, sinks):
    B, S = q.shape[0], q.shape[1]
    nb = S // BLOCK
    qb = q.reshape(B, nb, BLOCK, SWA_KV_HEADS, SWA_GROUP, HEAD_DIM)

    def band(t):
        tp = jnp.pad(t, ((0, 0), (BLOCK, 0), (0, 0), (0, 0)))
        tb = tp.reshape(B, nb + 1, BLOCK, SWA_KV_HEADS, HEAD_DIM)
        return jnp.concatenate([tb[:, :-1], tb[:, 1:]], axis=2)

    kw, vw = band(k), band(v)
    s = jnp.einsum('bnqhgd,bnkhd->bnhgqk', qb, kw,
                   preferred_element_type=jnp.float32) * (HEAD_DIM ** -0.5)
    qi = jnp.arange(BLOCK)[:, None]
    kj = jnp.arange(2 * BLOCK)[None, :]
    diff = qi - kj + BLOCK
    band_ok = (diff >= 0) & (diff < WINDOW)
    kpos = jnp.arange(nb)[:, None] * BLOCK + kj - BLOCK
    mask = band_ok[None] & (kpos >= 0)[:, None, :]
    s = jnp.where(mask[None, :, None, None], s, -jnp.inf)
    sink = sinks.astype(jnp.float32).reshape(1, 1, SWA_KV_HEADS, SWA_GROUP, 1, 1)
    m = jnp.maximum(jnp.max(s, axis=-1, keepdims=True), sink)
    p = jnp.exp(s - m)
    denom = jnp.sum(p, axis=-1, keepdims=True) + jnp.exp(sink - m)
    p = (p / denom).astype(v.dtype)
    o = jnp.einsum('bnhgqk,bnkhd->bnqhgd', p, vw)
    return o.reshape(B, S, SWA_HEADS * HEAD_DIM)


def mla_attention(q_nope, q_rope, k_nope, k_rope, v):
    B, S = q_nope.shape[0], q_nope.shape[1]
    nb = S // BLOCK
    scale = MLA_QK_DIM ** -0.5
    kpos = jnp.arange(S)

    def to_blocks(t):
        return jnp.moveaxis(t.reshape(B, nb, BLOCK, *t.shape[2:]), 1, 0)

    def one_block(args):
        qn, qr, n = args
        s = (jnp.einsum('bqhd,bkhd->bhqk', qn, k_nope, preferred_element_type=jnp.float32)
             + jnp.einsum('bqhr,bkr->bhqk', qr, k_rope, preferred_element_type=jnp.float32)) * scale
        qpos = n * BLOCK + jnp.arange(BLOCK)
        causal = kpos[None, :] <= qpos[:, None]
        s = jnp.where(causal[None, None], s, -jnp.inf)
        p = jax.nn.softmax(s, axis=-1).astype(v.dtype)
        return jnp.einsum('bhqk,bkhd->bqhd', p, v)

    o = lax.map(one_block, (to_blocks(q_nope), to_blocks(q_rope), jnp.arange(nb)))
    return jnp.moveaxis(o, 0, 1).reshape(B, S, MLA_HEADS * MLA_V_DIM)


def setup_inputs(seed: int = 0) -> dict:
    key = jax.random.key(seed)
    ks = jax.random.split(key, 17)
    f32 = jnp.float32

    def w(k, shape, fan_in):
        return jax.random.normal(k, shape, f32) * (fan_in ** -0.5)

    def gain(k, shape):
        return 1.0 + 0.02 * jax.random.normal(k, shape, f32)

    L = DEPTH
    return {
        "x": jax.random.normal(ks[0], (BATCH, SEQ, D_MODEL), f32),
        "mix_norm_g": gain(ks[1], (L, D_MODEL)),
        "w_in": w(ks[2], (L, D_MODEL, IN_WIDTH), D_MODEL),
        "swa_sinks": 0.5 * jax.random.normal(ks[3], (L, SWA_HEADS), f32),
        "q_norm_g": gain(ks[4], (L, Q_LORA_RANK)),
        "w_uq": w(ks[5], (L, Q_LORA_RANK, MLA_HEADS * MLA_QK_DIM), Q_LORA_RANK),
        "kv_norm_g": gain(ks[6], (L, KV_LORA_RANK)),
        "w_ukv": w(ks[7], (L, KV_LORA_RANK, MLA_HEADS * (MLA_NOPE_DIM + MLA_V_DIM)), KV_LORA_RANK),
        "w_o_swa": w(ks[8], (L, SWA_HEADS * HEAD_DIM, D_MODEL), SWA_HEADS * HEAD_DIM),
        "w_o_mla": w(ks[9], (L, MLA_HEADS * MLA_V_DIM, D_MODEL), MLA_HEADS * MLA_V_DIM),
        "w_out": w(ks[10], (L, D_MODEL, D_MODEL), D_MODEL),
        "ffn_norm_g": gain(ks[11], (L, D_MODEL)),
        "w_gate": w(ks[12], (L, D_MODEL, D_FF), D_MODEL),
        "w_up": w(ks[13], (L, D_MODEL, D_FF), D_MODEL),
        "w_down": w(ks[14], (L, D_FF, D_MODEL), D_FF),
        "final_norm_g": gain(ks[15], (D_MODEL,)),
    }


def reference(x, mix_norm_g, w_in, swa_sinks, q_norm_g, w_uq, kv_norm_g, w_ukv,
              w_o_swa, w_o_mla, w_out, ffn_norm_g, w_gate, w_up, w_down, final_norm_g):
    B, S = x.shape[0], x.shape[1]
    cos_a, sin_a = rope_tables(S, HEAD_DIM)
    cos_b, sin_b = rope_tables(S, MLA_ROPE_DIM)

    for l in range(DEPTH):
        h = rmsnorm(x, mix_norm_g[l])
        proj = h @ w_in[l]
        qa, ka, va, q_lat, kv_lat, k_r, g_a, g_b = jnp.split(proj, IN_OFFSETS, axis=-1)

        qa = apply_rope(qa.reshape(B, S, SWA_HEADS, HEAD_DIM), cos_a, sin_a)
        ka = apply_rope(ka.reshape(B, S, SWA_KV_HEADS, HEAD_DIM), cos_a, sin_a)
        va = va.reshape(B, S, SWA_KV_HEADS, HEAD_DIM)
        o_a = swa_sink_attention(qa, ka, va, swa_sinks[l])

        cq = rmsnorm(q_lat, q_norm_g[l])
        qb = (cq @ w_uq[l]).reshape(B, S, MLA_HEADS, MLA_QK_DIM)
        q_nope, q_rope = jnp.split(qb, [MLA_NOPE_DIM], axis=-1)
        q_rope = apply_rope(q_rope, cos_b, sin_b)
        ckv = rmsnorm(kv_lat, kv_norm_g[l])
        kvb = (ckv @ w_ukv[l]).reshape(B, S, MLA_HEADS, MLA_NOPE_DIM + MLA_V_DIM)
        k_nope, vb = jnp.split(kvb, [MLA_NOPE_DIM], axis=-1)
        k_rope = apply_rope(k_r[:, :, None, :], cos_b, sin_b)[:, :, 0, :]
        o_b = mla_attention(q_nope, q_rope, k_nope, k_rope, vb)

        y = jax.nn.sigmoid(g_a) * (o_a @ w_o_swa[l]) + jax.nn.sigmoid(g_b) * (o_b @ w_o_mla[l])
        x = x + y @ w_out[l]

        h = rmsnorm(x, ffn_norm_g[l])
        x = x + (jax.nn.silu(h @ w_gate[l]) * (h @ w_up[l])) @ w_down[l]

    return rmsnorm(x, final_norm_g)
```

```cpp
#include <hip/hip_runtime.h>
#include <cstdint>
#include <cstdio>

namespace nv {
constexpr int DM = 1024, NB = 8, S = 4096;
constexpr int INW = 3488, DFF = 2816;
constexpr int O_QA = 0, O_KA = 512, O_VA = 640, O_QL = 768, O_KVL = 1152, O_KR = 1408, O_GA = 1440, O_GB = 2464;

__global__ void k_tables(float* cosA, float* sinA, float* cosB, float* sinB) {
    int i = blockIdx.x * blockDim.x + threadIdx.x;
    if (i < S * 32) { int p = i / 32, j = i % 32; double a = (double)p * pow(10000.0, -(double)j / 32.0); cosA[i] = (float)cos(a); sinA[i] = (float)sin(a); }
    if (i < S * 16) { int p = i / 16, j = i % 16; double a = (double)p * pow(10000.0, -(double)j / 16.0); cosB[i] = (float)cos(a); sinB[i] = (float)sin(a); }
}

__global__ void k_rmsnorm(const float* x, int ldx, const float* g, float* out, int ldo, int n, int rows) {
    int wave = (blockIdx.x * blockDim.x + threadIdx.x) >> 6, lane = threadIdx.x & 63;
    if (wave >= rows) return;
    const float* xr = x + (size_t)wave * ldx; float s = 0.f;
    for (int i = lane; i < n; i += 64) s += xr[i] * xr[i];
    for (int o = 32; o; o >>= 1) s += __shfl_xor(s, o);
    float r = 1.0f / sqrtf(s / (float)n + 1e-6f);
    for (int i = lane; i < n; i += 64) out[(size_t)wave * ldo + i] = xr[i] * r * g[i];
}

__global__ __launch_bounds__(256) void k_gemm(const float* A, int lda, const float* W, int ldw, float* C, int ldc, int M, int N, int K) {
    __shared__ float As[16][65];
    __shared__ float Ws[16][65];
    const int tx = threadIdx.x & 15, ty = threadIdx.x >> 4;
    const int m0 = blockIdx.y * 64, n0 = blockIdx.x * 64;
    float acc[4][4];
#pragma unroll
    for (int i = 0; i < 4; ++i)
#pragma unroll
        for (int j = 0; j < 4; ++j) acc[i][j] = 0.f;
    for (int k0 = 0; k0 < K; k0 += 16) {
        for (int i = threadIdx.x; i < 1024; i += 256) { int m = i >> 4, k = i & 15; As[k][m] = A[(size_t)(m0 + m) * lda + k0 + k]; }
        for (int i = threadIdx.x; i < 1024; i += 256) { int k = i >> 6, n = i & 63; Ws[k][n] = (n0 + n < N) ? W[(size_t)(k0 + k) * ldw + n0 + n] : 0.f; }
        __syncthreads();
#pragma unroll
        for (int k = 0; k < 16; ++k) {
            float a0 = As[k][ty * 4 + 0], a1 = As[k][ty * 4 + 1], a2 = As[k][ty * 4 + 2], a3 = As[k][ty * 4 + 3];
            float b0 = Ws[k][tx * 4 + 0], b1 = Ws[k][tx * 4 + 1], b2 = Ws[k][tx * 4 + 2], b3 = Ws[k][tx * 4 + 3];
            acc[0][0] += a0 * b0; acc[0][1] += a0 * b1; acc[0][2] += a0 * b2; acc[0][3] += a0 * b3;
            acc[1][0] += a1 * b0; acc[1][1] += a1 * b1; acc[1][2] += a1 * b2; acc[1][3] += a1 * b3;
            acc[2][0] += a2 * b0; acc[2][1] += a2 * b1; acc[2][2] += a2 * b2; acc[2][3] += a2 * b3;
            acc[3][0] += a3 * b0; acc[3][1] += a3 * b1; acc[3][2] += a3 * b2; acc[3][3] += a3 * b3;
        }
        __syncthreads();
    }
#pragma unroll
    for (int i = 0; i < 4; ++i)
#pragma unroll
        for (int j = 0; j < 4; ++j) { int n = n0 + tx * 4 + j; if (n < N) C[(size_t)(m0 + ty * 4 + i) * ldc + n] = acc[i][j]; }
}

__global__ void k_rope(float* p, int ld, int col0, int nheads, int hd, const float* ct, const float* st) {
    int half = hd / 2;
    int i = blockIdx.x * blockDim.x + threadIdx.x;
    int total = S * nheads * half; if (i >= total) return;
    int j = i % half, h = (i / half) % nheads, pos = i / (half * nheads);
    float* q = p + (size_t)pos * ld + col0 + h * hd;
    float c = ct[pos * half + j], s = st[pos * half + j];
    float x1 = q[j], x2 = q[j + half];
    q[j] = x1 * c - x2 * s; q[j + half] = x2 * c + x1 * s;
}

__global__ __launch_bounds__(256) void k_swa(const float* proj, const float* sinks, float* oa) {
    int pos = blockIdx.x * 256 + threadIdx.x, h = blockIdx.y, kvh = h / 4;
    float q[64];
#pragma unroll
    for (int d = 0; d < 64; ++d) q[d] = proj[(size_t)pos * INW + O_QA + h * 64 + d];
    float m = sinks[h], l = 1.0f;
    float o[64];
#pragma unroll
    for (int d = 0; d < 64; ++d) o[d] = 0.f;
    int j0 = pos - 127; if (j0 < 0) j0 = 0;
    for (int j = j0; j <= pos; ++j) {
        const float* kr = proj + (size_t)j * INW + O_KA + kvh * 64;
        const float* vr = proj + (size_t)j * INW + O_VA + kvh * 64;
        float s = 0.f;
#pragma unroll
        for (int d = 0; d < 64; ++d) s += q[d] * kr[d];
        s *= 0.125f;
        float mn = fmaxf(m, s), f = expf(m - mn), pe = expf(s - mn);
        l = l * f + pe; m = mn;
#pragma unroll
        for (int d = 0; d < 64; ++d) o[d] = o[d] * f + pe * vr[d];
    }
    float inv = 1.0f / l;
#pragma unroll
    for (int d = 0; d < 64; ++d) oa[(size_t)pos * 512 + h * 64 + d] = o[d] * inv;
}

__global__ __launch_bounds__(256) void k_mla(const float* qb, const float* kvb, const float* proj, float* ob) {
    int pos = blockIdx.x * 256 + threadIdx.x, h = blockIdx.y;
    int pmax = blockIdx.x * 256 + 255;
    float q[96];
#pragma unroll
    for (int d = 0; d < 96; ++d) q[d] = qb[(size_t)pos * 768 + h * 96 + d];
    float m = -1e30f, l = 0.f;
    float o[64];
#pragma unroll
    for (int d = 0; d < 64; ++d) o[d] = 0.f;
    const float scale = 0.10206207261596577f;
    for (int j = 0; j <= pmax; ++j) {
        const float* kn = kvb + (size_t)j * 1024 + h * 128;
        const float* kr = proj + (size_t)j * INW + O_KR;
        float s = 0.f;
#pragma unroll
        for (int d = 0; d < 64; ++d) s += q[d] * kn[d];
#pragma unroll
        for (int d = 0; d < 32; ++d) s += q[64 + d] * kr[d];
        s *= scale;
        if (j <= pos) {
            float mn = fmaxf(m, s), f = expf(m - mn), pe = expf(s - mn);
            l = l * f + pe; m = mn;
#pragma unroll
            for (int d = 0; d < 64; ++d) o[d] = o[d] * f + pe * kn[64 + d];
        }
    }
    float inv = 1.0f / l;
#pragma unroll
    for (int d = 0; d < 64; ++d) ob[(size_t)pos * 512 + h * 64 + d] = o[d] * inv;
}

__global__ void k_gatemix(float* ya, const float* yb, const float* proj) {
    size_t i = (size_t)blockIdx.x * blockDim.x + threadIdx.x; if (i >= (size_t)S * DM) return;
    int r = (int)(i / DM), c = (int)(i % DM);
    float ga = proj[(size_t)r * INW + O_GA + c], gb = proj[(size_t)r * INW + O_GB + c];
    float sa = 1.0f / (1.0f + expf(-ga)), sb = 1.0f / (1.0f + expf(-gb));
    ya[i] = sa * ya[i] + sb * yb[i];
}
__global__ void k_add(const float* a, const float* b, float* out, size_t n) {
    size_t i = (size_t)blockIdx.x * blockDim.x + threadIdx.x; if (i < n) out[i] = a[i] + b[i];
}
__global__ void k_swiglu(float* gate, const float* up, size_t n) {
    size_t i = (size_t)blockIdx.x * blockDim.x + threadIdx.x; if (i >= n) return;
    float g = gate[i]; gate[i] = g / (1.0f + expf(-g)) * up[i];
}
}

extern "C" void kernel_launch(void* const* d_in, const int* in_sizes, int n_in, void* d_out, int out_size, void* d_ws, size_t ws_size, hipStream_t stream) {
    using namespace nv;
    const float* x = (const float*)d_in[0];
    const float* mix_g = (const float*)d_in[1];
    const float* w_in = (const float*)d_in[2];
    const float* sinks = (const float*)d_in[3];
    const float* qn_g = (const float*)d_in[4];
    const float* w_uq = (const float*)d_in[5];
    const float* kvn_g = (const float*)d_in[6];
    const float* w_ukv = (const float*)d_in[7];
    const float* w_o_swa = (const float*)d_in[8];
    const float* w_o_mla = (const float*)d_in[9];
    const float* w_out = (const float*)d_in[10];
    const float* ffn_g = (const float*)d_in[11];
    const float* w_gate = (const float*)d_in[12];
    const float* w_up = (const float*)d_in[13];
    const float* w_down = (const float*)d_in[14];
    const float* fin_g = (const float*)d_in[15];
    float* out = (float*)d_out;
    float* ws = (float*)d_ws;
    size_t off = 0;
    auto take = [&](size_t n) { float* p = ws + off; off += (n + 63) & ~(size_t)63; return p; };
    float* cosA = take(S * 32); float* sinA = take(S * 32); float* cosB = take(S * 16); float* sinB = take(S * 16);
    float* h = take((size_t)S * DM);
    float* proj = take((size_t)S * INW);
    float* cq = take((size_t)S * 384);
    float* ckv = take((size_t)S * 256);
    float* qb = take((size_t)S * 768);
    float* kvb = take((size_t)S * 1024);
    float* oa = take((size_t)S * 512);
    float* ob = take((size_t)S * 512);
    float* ya = take((size_t)S * DM);
    float* yb = take((size_t)S * DM);
    float* x1 = take((size_t)S * DM);
    float* gate = take((size_t)S * DFF);
    float* up = take((size_t)S * DFF);
    if (off * 4 > ws_size) { fprintf(stderr, "ws too small: need %zu have %zu\n", off * 4, ws_size); return; }

    k_tables<<<(S * 32 + 255) / 256, 256, 0, stream>>>(cosA, sinA, cosB, sinB);
    auto gemm = [&](const float* A, int lda, const float* W, int ldw, float* C, int ldc, int M, int N, int K) {
        k_gemm<<<dim3((N + 63) / 64, M / 64), 256, 0, stream>>>(A, lda, W, ldw, C, ldc, M, N, K);
    };
    const size_t SD = (size_t)S * DM;
    for (int b = 0; b < NB; ++b) {
        const float* xb = x + (size_t)b * SD;
        float* outb = out + (size_t)b * SD;
        k_rmsnorm<<<S / 4, 256, 0, stream>>>(xb, DM, mix_g, h, DM, DM, S);
        gemm(h, DM, w_in, INW, proj, INW, S, INW, DM);
        k_rope<<<(S * 10 * 32 + 255) / 256, 256, 0, stream>>>(proj, INW, O_QA, 10, 64, cosA, sinA);
        k_rope<<<(S * 1 * 16 + 255) / 256, 256, 0, stream>>>(proj, INW, O_KR, 1, 32, cosB, sinB);
        k_swa<<<dim3(S / 256, 8), 256, 0, stream>>>(proj, sinks, oa);
        k_rmsnorm<<<S / 4, 256, 0, stream>>>(proj + O_QL, INW, qn_g, cq, 384, 384, S);
        k_rmsnorm<<<S / 4, 256, 0, stream>>>(proj + O_KVL, INW, kvn_g, ckv, 256, 256, S);
        gemm(cq, 384, w_uq, 768, qb, 768, S, 768, 384);
        gemm(ckv, 256, w_ukv, 1024, kvb, 1024, S, 1024, 256);
        for (int hh = 0; hh < 8; ++hh)
            k_rope<<<(S * 16 + 255) / 256, 256, 0, stream>>>(qb, 768, hh * 96 + 64, 1, 32, cosB, sinB);
        k_mla<<<dim3(S / 256, 8), 256, 0, stream>>>(qb, kvb, proj, ob);
        gemm(oa, 512, w_o_swa, DM, ya, DM, S, DM, 512);
        gemm(ob, 512, w_o_mla, DM, yb, DM, S, DM, 512);
        k_gatemix<<<(unsigned)((SD + 255) / 256), 256, 0, stream>>>(ya, yb, proj);
        gemm(ya, DM, w_out, DM, yb, DM, S, DM, DM);
        k_add<<<(unsigned)((SD + 255) / 256), 256, 0, stream>>>(xb, yb, x1, SD);
        k_rmsnorm<<<S / 4, 256, 0, stream>>>(x1, DM, ffn_g, h, DM, DM, S);
        gemm(h, DM, w_gate, DFF, gate, DFF, S, DFF, DM);
        gemm(h, DM, w_up, DFF, up, DFF, S, DFF, DM);
        k_swiglu<<<(unsigned)(((size_t)S * DFF + 255) / 256), 256, 0, stream>>>(gate, up, (size_t)S * DFF);
        gemm(gate, DFF, w_down, DM, ya, DM, S, DM, DFF);
        k_add<<<(unsigned)((SD + 255) / 256), 256, 0, stream>>>(x1, ya, yb, SD);
        k_rmsnorm<<<S / 4, 256, 0, stream>>>(yb, DM, fin_g, outb, DM, DM, S);
    }
}
```

```cpp
#include <hip/hip_runtime.h>
#include <hip/hip_cooperative_groups.h>
#include <cstdio>
#include <cstdint>
namespace cg = cooperative_groups;

#ifndef MK_N_LAUNCHES
#define MK_N_LAUNCHES 1
#endif

#define LAS __attribute__((address_space(3)))
#define GAS __attribute__((address_space(1)))
typedef unsigned short bf16_t;
typedef short bf16x8 __attribute__((ext_vector_type(8)));
typedef short s16x4 __attribute__((ext_vector_type(4)));
typedef float f32x2 __attribute__((ext_vector_type(2)));
typedef float f32x4 __attribute__((ext_vector_type(4)));
typedef float f32x16 __attribute__((ext_vector_type(16)));
typedef unsigned u32x2 __attribute__((ext_vector_type(2)));
typedef unsigned u32x4 __attribute__((ext_vector_type(4)));
typedef __bf16 bf16x2_t __attribute__((ext_vector_type(2)));

constexpr int NB = 8, SEQ = 4096, T = NB * SEQ, DM = 1024, DFF = 2816;
constexpr int INW = 3488, NV1 = 3584;
constexpr int O_QA = 0, O_KA = 512, O_VA = 640, O_QL = 768, O_KVL = 1152, O_KR = 1408, O_GA = 1440, O_GB = 2464;
constexpr float EPS = 1e-6f;
constexpr float LOG2E = 1.4426950408889634f;
constexpr float QA_SCALE = 0.125f * LOG2E;
constexpr float QM_SCALE = 0.10206207261596577f * LOG2E;

constexpr size_t MiB = 1u << 20;
constexpr size_t WS_W1T = 0 * MiB, WS_WUQT = 7 * MiB, WS_WUKVT = 8 * MiB, WS_WOT = 9 * MiB, WS_WOUTT = 11 * MiB, WS_WGUT = 13 * MiB, WS_WDT = 24 * MiB;
constexpr size_t WS_TAB = 30 * MiB;
constexpr size_t WS_SSQ = 32 * MiB;
constexpr size_t WS_XN = 38 * MiB;
constexpr size_t WS_SG = 102 * MiB;
constexpr size_t WS_QA = 230 * MiB;
constexpr size_t WS_KA = 262 * MiB, WS_VA = 270 * MiB;
constexpr size_t WS_QLAT = 278 * MiB, WS_KVLAT = 302 * MiB;
constexpr size_t WS_QM = 318 * MiB, WS_KM = 366 * MiB;
constexpr size_t WS_VM = 414 * MiB, WS_OB = 446 * MiB;
constexpr size_t WS_END = 478 * MiB;
constexpr size_t WS_Y = WS_QM;
constexpr size_t WS_HDN = WS_SG;
static_assert(WS_HDN + (size_t)T * DFF * 2 <= WS_QLAT && WS_Y + (size_t)T * DM * 2 <= WS_VM, "overlays");

constexpr int NWAVES = 8;
constexpr int RING_BYTES = 131072, LDS_BYTES = 147456;

__device__ __forceinline__ unsigned cvtpk(float lo, float hi) { f32x2 v = {lo, hi}; bf16x2_t b = __builtin_convertvector(v, bf16x2_t); return __builtin_bit_cast(unsigned, b); }
__device__ __forceinline__ u32x4 pack8(f32x4 a, f32x4 b) { u32x4 w; w.x = cvtpk(a[0], a[1]); w.y = cvtpk(a[2], a[3]); w.z = cvtpk(b[0], b[1]); w.w = cvtpk(b[2], b[3]); return w; }
__device__ __forceinline__ u32x2 pack4(f32x4 a) { u32x2 w; w.x = cvtpk(a[0], a[1]); w.y = cvtpk(a[2], a[3]); return w; }
__device__ __forceinline__ float bf_lo(unsigned w) { return __uint_as_float(w << 16); }
__device__ __forceinline__ float bf_hi(unsigned w) { return __uint_as_float(w & 0xffff0000u); }
__device__ __forceinline__ float sigmoidf_fast(float x) { return __builtin_amdgcn_rcpf(1.0f + __builtin_amdgcn_exp2f(-x * LOG2E)); }
__device__ __forceinline__ float wave_sum(float v) {
#pragma unroll
    for (int o = 1; o < 64; o <<= 1) v += __shfl_xor(v, o);
    return v;
}
__device__ __forceinline__ float sumsq4(f32x4 a) { return (a[0] * a[0] + a[1] * a[1]) + (a[2] * a[2] + a[3] * a[3]); }

namespace pg8 {
constexpr int BM = 256, BK = 64, HALF = 128, HTB = HALF * BK * 2, STAGE_BYTES = 8 * HTB, NXCD = 8, WGM = 8;
__host__ __device__ __forceinline__ int lds_byte(int r, int c) { const int st = (r >> 4) * 2 + (c >> 5), rr = r & 15, cc = c & 31, ob = rr * 64 + cc * 2; return st * 1024 + (ob ^ (((ob >> 9) & 1) << 5)); }
__host__ __device__ __forceinline__ void stage_rc(int b, int& R, int& C) { const int st = b / 1024, sb = b % 1024, swz = sb ^ (((sb >> 9) & 1) << 5); R = (st >> 1) * 16 + swz / 64; C = (st & 1) * 32 + (swz % 64) / 2; }
__host__ __device__ __forceinline__ int perm32(int rho) { const int n = rho >> 4, i = rho & 15; return 8 * (i >> 2) + 4 * n + (i & 3); }

struct Unit { int pm, pn, part; };
struct Gemm { const bf16_t* A; const bf16_t* Bt; int lda, ldb, K; };

struct TileOrder {
    int nM, nN, nwg, G, c;
    __device__ void init(int nM_, int nN_, int G_, int c_) { nM = nM_; nN = nN_; nwg = nM * nN; G = G_; c = c_; }
    __device__ bool tile(int i, int& pm, int& pn) const {
        const long L = (long)i * G + c; if (L >= nwg) return false;
        int wgid = (int)L; { const int q = nwg / NXCD, r = nwg % NXCD, xcd = wgid % NXCD, off = wgid / NXCD; wgid = (xcd < r ? xcd * (q + 1) : r * (q + 1) + (xcd - r) * q) + off; }
        const int nig = WGM * nN, gid = wgid / nig, fm = gid * WGM, gsz = (nM - fm) < WGM ? (nM - fm) : WGM;
        pm = fm + ((wgid % nig) % gsz); pn = (wgid % nig) / gsz; return true;
    }
};
struct SchedPlain {
    TileOrder o; const Gemm g;
    __device__ bool next(int i, Unit& u) const { u.part = 0; return o.tile(i, u.pm, u.pn); }
    __device__ __forceinline__ void ptrs(const Unit& u, const char*& a, const char*& b) const { a = (const char*)g.A + (size_t)u.pm * BM * g.lda * 2; b = (const char*)g.Bt + (size_t)u.pn * BM * g.ldb * 2; }
    __device__ __forceinline__ bool keep(const Unit&) const { return false; }
};
struct SchedPair {
    TileOrder o; const bf16_t* A0; const bf16_t* A1; const bf16_t* Bt; int lda, ldb, K;
    __device__ bool next(int i, Unit& u) const { u.part = i & 1; return o.tile(i >> 1, u.pm, u.pn); }
    __device__ __forceinline__ void ptrs(const Unit& u, const char*& a, const char*& b) const { a = (const char*)(u.part ? A1 : A0) + (size_t)u.pm * BM * lda * 2; b = (const char*)Bt + (size_t)u.pn * BM * ldb * 2 + (size_t)u.part * K * 2; }
    __device__ __forceinline__ bool keep(const Unit& u) const { return u.part == 0; }
};

template <class Epi, class Sched, bool ALIGN_EPI, bool SP2>
__device__ __forceinline__ void gemm_phase(LAS unsigned char* lds, const int lda, const int ldb, const int K, const Sched& S, const Epi& E) {
    const int tid = threadIdx.x, wid = __builtin_amdgcn_readfirstlane(tid >> 6), lane = tid & 63, wr = wid >> 2, wc = wid & 3, fr = lane & 15, fq = lane >> 4;
    const int nt = K / BK;
    unsigned voffA[2], voffB[2];
#pragma unroll
    for (int i = 0; i < 2; ++i) { int R, C; stage_rc(tid * 16 + i * 8192, R, C); const int Rb = (R & ~31) + perm32(R & 31);
        voffA[i] = (unsigned)(R * lda + C) * 2u; voffB[i] = (unsigned)(Rb * ldb + C) * 2u; }
    const size_t kstep = (size_t)(BK * 2);
    const size_t hstepA = (size_t)HALF * lda * 2, hstepB = (size_t)HALF * ldb * 2;
    const unsigned ldsw = (unsigned)wid * 1024u;
    const int aoff = lds_byte(wr * 64 + fr, fq * 8), boff = lds_byte(wc * 32 + fr, fq * 8);
#define PG8_SA(b, h) (((b) * 2 + (h)) * HTB)
#define PG8_SB(b, h) ((4 + (b) * 2 + (h)) * HTB)
#define PG8_STAGE(bufoff, gbase, voff) do { _Pragma("unroll") for (int _i = 0; _i < 2; ++_i) \
        __builtin_amdgcn_global_load_lds((const unsigned*)((const char*)(gbase) + (voff)[_i]), (LAS unsigned*)(lds + (bufoff) + ldsw + _i * 8192), 16, 0, 0); } while (0)
#define PG8_LDA(dst, b, h) do { _Pragma("unroll") for (int m = 0; m < 4; ++m) _Pragma("unroll") for (int k = 0; k < 2; ++k) dst[m][k] = *(const LAS bf16x8*)(lds + PG8_SA(b, h) + aoff + m * 2048 + k * 1024); } while (0)
#define PG8_LDB(dst, b, h) do { _Pragma("unroll") for (int n = 0; n < 2; ++n) _Pragma("unroll") for (int k = 0; k < 2; ++k) dst[n][k] = *(const LAS bf16x8*)(lds + PG8_SB(b, h) + boff + n * 2048 + k * 1024); } while (0)
#define PG8_MMA(ai, bj, At, Bt) do { __builtin_amdgcn_s_setprio(1); _Pragma("unroll") for (int m = 0; m < 4; ++m) _Pragma("unroll") for (int n = 0; n < 2; ++n) _Pragma("unroll") for (int k = 0; k < 2; ++k) \
        acc[ai][bj][m][n] = __builtin_amdgcn_mfma_f32_16x16x32_bf16(Bt[n][k], At[m][k], acc[ai][bj][m][n], 0, 0, 0); __builtin_amdgcn_s_setprio(0); } while (0)
#define PG8_WAIT_V(n) asm volatile("s_waitcnt vmcnt(" #n ")" ::: "memory")
#define PG8_WAIT_L(n) asm volatile("s_waitcnt lgkmcnt(" #n ")" ::: "memory")
#define PG8_BAR __builtin_amdgcn_s_barrier()
#define PG8_SCHED __builtin_amdgcn_sched_barrier(0)
    Unit cur, nxt; int ui = 0;
    if (!S.next(0, cur)) return;
    f32x4 acc[2][2][4][2];
#pragma unroll
    for (int a = 0; a < 2; ++a)
#pragma unroll
        for (int b = 0; b < 2; ++b)
#pragma unroll
            for (int m = 0; m < 4; ++m)
#pragma unroll
                for (int n = 0; n < 2; ++n) acc[a][b][m][n] = (f32x4){0.f, 0.f, 0.f, 0.f};
    bf16x8 At[4][2], B0[2][2], B1[2][2];
    const char* cA; const char* cB; S.ptrs(cur, cA, cB);
    if constexpr (SP2) {
        PG8_STAGE(PG8_SB(0, 0), cB, voffB); PG8_STAGE(PG8_SB(0, 1), cB + hstepB, voffB); PG8_STAGE(PG8_SA(0, 0), cA, voffA); PG8_STAGE(PG8_SA(0, 1), cA + hstepA, voffA);
        if (wr == 1) PG8_BAR;
        PG8_WAIT_V(2); PG8_BAR;
        PG8_STAGE(PG8_SB(1, 0), cB + kstep, voffB); PG8_STAGE(PG8_SA(1, 0), cA + kstep, voffA); PG8_STAGE(PG8_SB(1, 1), cB + hstepB + kstep, voffB);
        PG8_WAIT_V(6); PG8_BAR;
    } else {
        PG8_STAGE(PG8_SB(0, 0), cB, voffB); PG8_STAGE(PG8_SA(0, 0), cA, voffA); PG8_STAGE(PG8_SB(0, 1), cB + hstepB, voffB); PG8_STAGE(PG8_SA(0, 1), cA + hstepA, voffA);
        if (wr == 1) PG8_BAR;
        PG8_WAIT_V(4); PG8_BAR;
        PG8_STAGE(PG8_SB(1, 0), cB + kstep, voffB); PG8_STAGE(PG8_SA(1, 0), cA + kstep, voffA); PG8_STAGE(PG8_SB(1, 1), cB + hstepB + kstep, voffB);
        PG8_WAIT_V(6); PG8_BAR;
    }
    for (;;) {
        const bool has_next = S.next(ui + 1, nxt);
        const char* nA = cA; const char* nB = cB; if (has_next) S.ptrs(nxt, nA, nB);
#pragma unroll 1
        for (int t = 0; t < nt; t += 2) {
            const bool last = (t == nt - 2);
            const char* a1 = cA + (size_t)(t + 1) * kstep;
            const char* a2 = last ? nA : cA + (size_t)(t + 2) * kstep; const char* b2 = last ? nB : cB + (size_t)(t + 2) * kstep;
            const char* a3 = a2 + kstep; const char* b3 = b2 + kstep;
            if constexpr (SP2) {
            PG8_LDB(B0, 0, 0); PG8_LDB(B1, 0, 1); PG8_SCHED; PG8_LDA(At, 0, 0); PG8_STAGE(PG8_SA(1, 1), a1 + hstepA, voffA);
            PG8_WAIT_V(8); PG8_WAIT_L(0); PG8_BAR; PG8_MMA(0, 0, At, B0); PG8_MMA(0, 1, At, B1); PG8_BAR; PG8_SCHED;
            PG8_LDA(At, 0, 1); PG8_STAGE(PG8_SB(0, 0), b2, voffB); PG8_STAGE(PG8_SB(0, 1), b2 + hstepB, voffB); PG8_STAGE(PG8_SA(0, 0), a2, voffA);
            PG8_WAIT_V(8); PG8_WAIT_L(0); PG8_BAR; PG8_MMA(1, 0, At, B0); PG8_MMA(1, 1, At, B1); PG8_BAR; PG8_SCHED;
            PG8_LDB(B0, 1, 0); PG8_LDB(B1, 1, 1); PG8_SCHED; PG8_LDA(At, 1, 0); PG8_STAGE(PG8_SA(0, 1), a2 + hstepA, voffA);
            PG8_WAIT_V(8); PG8_WAIT_L(0); PG8_BAR; PG8_MMA(0, 0, At, B0); PG8_MMA(0, 1, At, B1); PG8_BAR; PG8_SCHED;
            PG8_LDA(At, 1, 1); PG8_STAGE(PG8_SB(1, 0), b3, voffB); PG8_STAGE(PG8_SB(1, 1), b3 + hstepB, voffB); PG8_STAGE(PG8_SA(1, 0), a3, voffA);
            PG8_WAIT_V(8); PG8_WAIT_L(0); PG8_BAR; PG8_MMA(1, 0, At, B0); PG8_MMA(1, 1, At, B1); PG8_BAR; PG8_SCHED;
            } else {
            PG8_LDB(B0, 0, 0); PG8_SCHED; PG8_LDA(At, 0, 0); PG8_STAGE(PG8_SA(1, 1), a1 + hstepA, voffA);
            PG8_WAIT_L(8); PG8_BAR; PG8_WAIT_L(0); PG8_MMA(0, 0, At, B0); PG8_BAR; PG8_SCHED;
            PG8_LDB(B1, 0, 1); PG8_STAGE(PG8_SB(0, 0), b2, voffB);
            PG8_BAR; PG8_WAIT_L(0); PG8_MMA(0, 1, At, B1); PG8_BAR;
            PG8_LDA(At, 0, 1); PG8_STAGE(PG8_SA(0, 0), a2, voffA);
            PG8_BAR; PG8_WAIT_L(0); PG8_MMA(1, 0, At, B0); PG8_BAR; PG8_SCHED;
            PG8_STAGE(PG8_SB(0, 1), b2 + hstepB, voffB);
            PG8_WAIT_V(6); PG8_BAR; PG8_MMA(1, 1, At, B1); PG8_BAR;
            PG8_LDB(B0, 1, 0); PG8_SCHED; PG8_LDA(At, 1, 0); PG8_STAGE(PG8_SA(0, 1), a2 + hstepA, voffA);
            PG8_WAIT_L(8); PG8_BAR; PG8_WAIT_L(0); PG8_MMA(0, 0, At, B0); PG8_BAR; PG8_SCHED;
            PG8_LDB(B1, 1, 1); PG8_STAGE(PG8_SB(1, 0), b3, voffB);
            PG8_BAR; PG8_WAIT_L(0); PG8_MMA(0, 1, At, B1); PG8_BAR;
            PG8_LDA(At, 1, 1); PG8_STAGE(PG8_SA(1, 0), a3, voffA);
            PG8_BAR; PG8_WAIT_L(0); PG8_MMA(1, 0, At, B0); PG8_BAR; PG8_SCHED;
            PG8_STAGE(PG8_SB(1, 1), b3 + hstepB, voffB);
            PG8_WAIT_V(6); PG8_BAR; PG8_MMA(1, 1, At, B1); PG8_BAR;
            }
        }
        if constexpr (ALIGN_EPI) { if (wr == 0) PG8_BAR; }
        E(acc, cur, wr, wc, fr, fq);
        if (!has_next) break;
        if (!S.keep(cur)) {
#pragma unroll
        for (int a = 0; a < 2; ++a)
#pragma unroll
            for (int b = 0; b < 2; ++b)
#pragma unroll
                for (int m = 0; m < 4; ++m)
#pragma unroll
                    for (int n = 0; n < 2; ++n) acc[a][b][m][n] = (f32x4){0.f, 0.f, 0.f, 0.f};
        }
        cur = nxt; cA = nA; cB = nB; ++ui;
        if constexpr (ALIGN_EPI) { if (wr == 1) PG8_BAR; }
    }
    PG8_WAIT_V(0);
    if constexpr (!ALIGN_EPI) { if (wr == 0) PG8_BAR; }
    PG8_BAR;
#undef PG8_SA
#undef PG8_SB
#undef PG8_STAGE
#undef PG8_LDA
#undef PG8_LDB
#undef PG8_MMA
#undef PG8_WAIT_V
#undef PG8_WAIT_L
#undef PG8_BAR
#undef PG8_SCHED
}
}
using pg8::Unit;

struct EpiProj {
    bf16_t *QA, *KA, *VA, *QLAT, *KVLAT, *KM, *SG; float *SSQ_Q, *SSQ_KV; const float *cosA, *sinA, *cosB, *sinB;
    __device__ __forceinline__ void operator()(f32x4 (&acc)[2][2][4][2], const Unit& u, int wr, int wc, int fr, int fq) const {
        const int pn = u.pn, rbase = u.pm * 256 + wr * 64 + fr;
        if (pn <= 2) {
#pragma unroll
            for (int ai = 0; ai < 2; ++ai)
#pragma unroll
                for (int m = 0; m < 4; ++m) {
                    const int r = rbase + ai * 128 + m * 16, pos = r & (SEQ - 1);
                    const int d0 = 4 * (4 * (wc & 1) + fq);
                    const f32x4 c4 = *(const f32x4*)(cosA + pos * 32 + d0), s4 = *(const f32x4*)(sinA + pos * 32 + d0);
#pragma unroll
                    for (int bj = 0; bj < 2; ++bj) {
                        if (pn == 2 && bj == 1) { *(u32x4*)(VA + (size_t)r * 128 + 32 * wc + 8 * fq) = pack8(acc[ai][1][m][0], acc[ai][1][m][1]); }
                        else {
                            const f32x4 x1 = acc[ai][bj][m][0], x2 = acc[ai][bj][m][1];
                            f32x4 o1 = x1 * c4 - x2 * s4, o2 = x2 * c4 + x1 * s4;
                            bf16_t* dst;
                            if (pn < 2) { o1 = o1 * QA_SCALE; o2 = o2 * QA_SCALE; dst = QA + (size_t)r * 512 + (4 * pn + 2 * bj + (wc >> 1)) * 64 + d0; }
                            else dst = KA + (size_t)r * 128 + (wc >> 1) * 64 + d0;
                            *(u32x2*)dst = pack4(o1); *(u32x2*)(dst + 32) = pack4(o2);
                        }
                    }
                }
        } else if (pn <= 5) {
#pragma unroll
            for (int ai = 0; ai < 2; ++ai)
#pragma unroll
                for (int m = 0; m < 4; ++m) {
                    const int r = rbase + ai * 128 + m * 16, pos = r & (SEQ - 1);
                    float q = sumsq4(acc[ai][0][m][0]) + sumsq4(acc[ai][0][m][1]);
                    if (pn != 4) q += sumsq4(acc[ai][1][m][0]) + sumsq4(acc[ai][1][m][1]);
                    q += __shfl_xor(q, 16); q += __shfl_xor(q, 32);
                    if (pn == 3) {
                        *(u32x4*)(QLAT + (size_t)r * 384 + 32 * wc + 8 * fq) = pack8(acc[ai][0][m][0], acc[ai][0][m][1]);
                        *(u32x4*)(QLAT + (size_t)r * 384 + 128 + 32 * wc + 8 * fq) = pack8(acc[ai][1][m][0], acc[ai][1][m][1]);
                        if (fq == 0) SSQ_Q[(size_t)r * 8 + wc] = q;
                    } else if (pn == 4) {
                        *(u32x4*)(QLAT + (size_t)r * 384 + 256 + 32 * wc + 8 * fq) = pack8(acc[ai][0][m][0], acc[ai][0][m][1]);
                        if (fq == 0) SSQ_Q[(size_t)r * 8 + 4 + wc] = q;
                        if (wc == 0) {
                            const int i0 = 4 * fq;
                            const f32x4 c4 = *(const f32x4*)(cosB + pos * 16 + i0), s4 = *(const f32x4*)(sinB + pos * 16 + i0);
                            const f32x4 x1 = acc[ai][1][m][0], x2 = acc[ai][1][m][1];
                            const u32x2 w1 = pack4(x1 * c4 - x2 * s4), w2 = pack4(x2 * c4 + x1 * s4);
#pragma unroll
                            for (int h = 0; h < 8; ++h) { bf16_t* dst = KM + (size_t)r * 768 + h * 96 + 64 + i0; *(u32x2*)dst = w1; *(u32x2*)(dst + 16) = w2; }
                        }
                    } else {
                        *(u32x4*)(KVLAT + (size_t)r * 256 + 32 * wc + 8 * fq) = pack8(acc[ai][0][m][0], acc[ai][0][m][1]);
                        *(u32x4*)(KVLAT + (size_t)r * 256 + 128 + 32 * wc + 8 * fq) = pack8(acc[ai][1][m][0], acc[ai][1][m][1]);
                        if (fq == 0) SSQ_KV[(size_t)r * 4 + wc] = q;
                    }
                }
        } else {
            const int cb = (pn - 6) * 256 + 32 * wc + 8 * fq;
#pragma unroll
            for (int ai = 0; ai < 2; ++ai)
#pragma unroll
                for (int m = 0; m < 4; ++m) {
                    const int r = rbase + ai * 128 + m * 16;
#pragma unroll
                    for (int bj = 0; bj < 2; ++bj) {
                        f32x4 a = acc[ai][bj][m][0], b = acc[ai][bj][m][1];
#pragma unroll
                        for (int e = 0; e < 4; ++e) { a[e] = sigmoidf_fast(a[e]); b[e] = sigmoidf_fast(b[e]); }
                        *(u32x4*)(SG + (size_t)r * 2048 + cb + 128 * bj) = pack8(a, b);
                    }
                }
        }
    }
};

struct EpiUQ {
    bf16_t* QM; const float* SSQ_Q; const float *cosB, *sinB;
    __device__ __forceinline__ void operator()(f32x4 (&acc)[2][2][4][2], const Unit& u, int wr, int wc, int fr, int fq) const {
        const int pn = u.pn, rbase = u.pm * 256 + wr * 64 + fr;
#pragma unroll
        for (int ai = 0; ai < 2; ++ai)
#pragma unroll
            for (int m = 0; m < 4; ++m) {
                const int r = rbase + ai * 128 + m * 16, pos = r & (SEQ - 1);
                const f32x4 sa = *(const f32x4*)(SSQ_Q + (size_t)r * 8), sb = *(const f32x4*)(SSQ_Q + (size_t)r * 8 + 4);
                const float ss = ((sa[0] + sa[1]) + (sa[2] + sa[3])) + ((sb[0] + sb[1]) + (sb[2] + sb[3]));
                const float rs = __builtin_amdgcn_rsqf(ss * (1.0f / 384.0f) + EPS) * QM_SCALE;
                if (pn < 2) {
#pragma unroll
                    for (int bj = 0; bj < 2; ++bj)
                        *(u32x4*)(QM + (size_t)r * 768 + (4 * pn + 2 * bj + (wc >> 1)) * 96 + 32 * (wc & 1) + 8 * fq) = pack8(acc[ai][bj][m][0] * rs, acc[ai][bj][m][1] * rs);
                } else {
                    const int i0 = 4 * fq;
                    const f32x4 c4 = *(const f32x4*)(cosB + pos * 16 + i0), s4 = *(const f32x4*)(sinB + pos * 16 + i0);
#pragma unroll
                    for (int bj = 0; bj < 2; ++bj) {
                        const f32x4 x1 = acc[ai][bj][m][0] * rs, x2 = acc[ai][bj][m][1] * rs;
                        bf16_t* dst = QM + (size_t)r * 768 + (4 * bj + wc) * 96 + 64 + i0;
                        *(u32x2*)dst = pack4(x1 * c4 - x2 * s4); *(u32x2*)(dst + 16) = pack4(x2 * c4 + x1 * s4);
                    }
                }
                asm volatile("" ::: "memory");
            }
    }
};
struct EpiUKV {
    bf16_t *KM, *VM; const float* SSQ_KV;
    __device__ __forceinline__ void operator()(f32x4 (&acc)[2][2][4][2], const Unit& u, int wr, int wc, int fr, int fq) const {
        const int pn = u.pn, rbase = u.pm * 256 + wr * 64 + fr;
#pragma unroll
        for (int ai = 0; ai < 2; ++ai)
#pragma unroll
            for (int m = 0; m < 4; ++m) {
                const int r = rbase + ai * 128 + m * 16;
                const f32x4 sa = *(const f32x4*)(SSQ_KV + (size_t)r * 4);
                const float rs = __builtin_amdgcn_rsqf(((sa[0] + sa[1]) + (sa[2] + sa[3])) * (1.0f / 256.0f) + EPS);
#pragma unroll
                for (int bj = 0; bj < 2; ++bj) {
                    const int h = 4 * (pn & 1) + 2 * bj + (wc >> 1), d = 32 * (wc & 1) + 8 * fq;
                    bf16_t* dst = (pn < 2) ? KM + (size_t)r * 768 + h * 96 + d : VM + (size_t)r * 512 + h * 64 + d;
                    *(u32x4*)dst = pack8(acc[ai][bj][m][0] * rs, acc[ai][bj][m][1] * rs);
                }
                asm volatile("" ::: "memory");
            }
    }
};
struct EpiGate {
    const bf16_t* SG; bf16_t* Y;
    __device__ __forceinline__ void operator()(f32x4 (&acc)[2][2][4][2], const Unit& u, int wr, int wc, int fr, int fq) const {
        const int rbase = u.pm * 256 + wr * 64 + fr, cb = u.pn * 256 + 32 * wc + 8 * fq;
#pragma unroll
        for (int ai = 0; ai < 2; ++ai)
#pragma unroll
            for (int m = 0; m < 4; ++m) {
                const int r = rbase + ai * 128 + m * 16;
#pragma unroll
                for (int bj = 0; bj < 2; ++bj) {
                    const int c = cb + 128 * bj;
                    const u32x4 wb = *(const u32x4*)(SG + (size_t)r * 2048 + 1024 + c);
                    f32x4 b0 = {bf_lo(wb.x), bf_hi(wb.x), bf_lo(wb.y), bf_hi(wb.y)}, b1 = {bf_lo(wb.z), bf_hi(wb.z), bf_lo(wb.w), bf_hi(wb.w)};
                    if (u.part == 0) {
                        const u32x4 wa = *(const u32x4*)(SG + (size_t)r * 2048 + c);
                        const f32x4 a0 = {bf_lo(wa.x), bf_hi(wa.x), bf_lo(wa.y), bf_hi(wa.y)}, a1 = {bf_lo(wa.z), bf_hi(wa.z), bf_lo(wa.w), bf_hi(wa.w)};
#pragma unroll
                        for (int e = 0; e < 4; ++e) { acc[ai][bj][m][0][e] *= a0[e] * __builtin_amdgcn_rcpf(b0[e]); acc[ai][bj][m][1][e] *= a1[e] * __builtin_amdgcn_rcpf(b1[e]); }
                    } else {
                        *(u32x4*)(Y + (size_t)r * 1024 + c) = pack8(acc[ai][bj][m][0] * b0, acc[ai][bj][m][1] * b1);
                    }
                }
            }
    }
};
struct EpiRes1 {
    const float* X; float* OUT; bf16_t* X1B; float* SSQ;
    __device__ __forceinline__ void operator()(f32x4 (&acc)[2][2][4][2], const Unit& u, int wr, int wc, int fr, int fq) const {
        const int rbase = u.pm * 256 + wr * 64 + fr, cb = u.pn * 256 + 32 * wc + 8 * fq;
#pragma unroll
        for (int ai = 0; ai < 2; ++ai)
#pragma unroll
            for (int m = 0; m < 4; ++m) {
                const int r = rbase + ai * 128 + m * 16; float q = 0.f;
#pragma unroll
                for (int bj = 0; bj < 2; ++bj) {
                    const size_t o = (size_t)r * 1024 + cb + 128 * bj;
                    const f32x4 v0 = *(const f32x4*)(X + o) + acc[ai][bj][m][0], v1 = *(const f32x4*)(X + o + 4) + acc[ai][bj][m][1];
                    *(f32x4*)(OUT + o) = v0; *(f32x4*)(OUT + o + 4) = v1; *(u32x4*)(X1B + o) = pack8(v0, v1);
                    q += sumsq4(v0) + sumsq4(v1);
                }
                q += __shfl_xor(q, 16); q += __shfl_xor(q, 32);
                if (fq == 0) SSQ[(size_t)r * 16 + 4 * u.pn + wc] = q;
            }
    }
};
struct EpiSwiglu {
    const float* SSQ; bf16_t* HDN;
    __device__ __forceinline__ void operator()(f32x4 (&acc)[2][2][4][2], const Unit& u, int wr, int wc, int fr, int fq) const {
        const int rbase = u.pm * 256 + wr * 64 + fr, cb = u.pn * 128 + 32 * wc + 8 * fq;
#pragma unroll
        for (int ai = 0; ai < 2; ++ai)
#pragma unroll
            for (int m = 0; m < 4; ++m) {
                const int r = rbase + ai * 128 + m * 16;
                float ss = 0.f;
#pragma unroll
                for (int i = 0; i < 4; ++i) { const f32x4 s4 = *(const f32x4*)(SSQ + (size_t)r * 16 + 4 * i); ss += (s4[0] + s4[1]) + (s4[2] + s4[3]); }
                const float rs = __builtin_amdgcn_rsqf(ss * (1.0f / 1024.0f) + EPS);
                f32x4 h0, h1;
#pragma unroll
                for (int e = 0; e < 4; ++e) {
                    const float g0 = acc[ai][0][m][0][e] * rs, g1 = acc[ai][0][m][1][e] * rs;
                    h0[e] = g0 * sigmoidf_fast(g0) * (acc[ai][1][m][0][e] * rs); h1[e] = g1 * sigmoidf_fast(g1) * (acc[ai][1][m][1][e] * rs);
                }
                *(u32x4*)(HDN + (size_t)r * DFF + cb) = pack8(h0, h1);
            }
    }
};
struct EpiRes2 {
    float* OUT; float* SSQ;
    __device__ __forceinline__ void operator()(f32x4 (&acc)[2][2][4][2], const Unit& u, int wr, int wc, int fr, int fq) const {
        const int rbase = u.pm * 256 + wr * 64 + fr, cb = u.pn * 256 + 32 * wc + 8 * fq;
#pragma unroll
        for (int ai = 0; ai < 2; ++ai)
#pragma unroll
            for (int m = 0; m < 4; ++m) {
                const int r = rbase + ai * 128 + m * 16; float q = 0.f;
#pragma unroll
                for (int bj = 0; bj < 2; ++bj) {
                    const size_t o = (size_t)r * 1024 + cb + 128 * bj;
                    const f32x4 v0 = *(const f32x4*)(OUT + o) + acc[ai][bj][m][0], v1 = *(const f32x4*)(OUT + o + 4) + acc[ai][bj][m][1];
                    *(f32x4*)(OUT + o) = v0; *(f32x4*)(OUT + o + 4) = v1;
                    q += sumsq4(v0) + sumsq4(v1);
                }
                q += __shfl_xor(q, 16); q += __shfl_xor(q, 32);
                if (fq == 0) SSQ[(size_t)r * 16 + 4 * u.pn + wc] = q;
            }
    }
};

namespace att {
constexpr int KSLOT = 12288, VSLOT = 8192;
constexpr int LDS_K = 0, LDS_V = 2 * KSLOT, LDS_WS = LDS_V + 2 * VSLOT, LDS_OST = LDS_WS + NWAVES * 256, LDS_TOTAL = LDS_OST + NWAVES * 4096;
static_assert(LDS_TOTAL <= RING_BYTES, "attention LDS");
__device__ __forceinline__ int crow(int r, int hi) { return (r & 3) + 8 * (r >> 2) + 4 * hi; }
__device__ __forceinline__ void glds16(const void* g, unsigned lds_base) {
    unsigned sv; asm volatile("s_mov_b32 %0, m0\n\ts_mov_b32 m0, %2\n\ts_nop 0\n\tglobal_load_lds_dwordx4 %1, off\n\ts_mov_b32 m0, %0" : "=&s"(sv) : "v"(g), "s"(lds_base) : "memory"); }
#define ATT_WAIT_BAR() asm volatile("s_waitcnt vmcnt(0) lgkmcnt(0)\n\ts_barrier" ::: "memory")
#define MX3(a, b, c) __builtin_fmaxf(__builtin_fmaxf((a), (b)), (c))
__device__ __forceinline__ float rowmax(const f32x16& p0, const f32x16& p1) {
    float a = MX3(p0[0], p0[1], p1[0]), b = MX3(p0[2], p0[3], p1[1]); a = MX3(a, p1[2], p1[3]);
#pragma unroll
    for (int r = 4; r < 16; r += 4) { a = MX3(a, p0[r], p0[r + 1]); b = MX3(b, p0[r + 2], p0[r + 3]); a = MX3(a, p1[r], p1[r + 1]); b = MX3(b, p1[r + 2], p1[r + 3]); }
    float m = __builtin_fmaxf(a, b); auto rr = __builtin_amdgcn_permlane32_swap(__float_as_uint(m), __float_as_uint(m), false, false);
    return __builtin_fmaxf(__uint_as_float(rr[0]), __uint_as_float(rr[1])); }
typedef short v4i16_t __attribute__((ext_vector_type(4)));
__device__ __forceinline__ s16x4 vtr(const LAS char* p) { return __builtin_bit_cast(s16x4, __builtin_amdgcn_ds_read_tr16_b64_v4i16((LAS v4i16_t*)p)); }

template <int DQK, bool SWA>
__device__ __forceinline__ void unit(const bf16_t* Qw, int qpitch, const bf16_t* Kb, int kpitch, const bf16_t* Vb, int vpitch, bf16_t* Ow, int opitch,
                                     int pos0, int t0, int t1, int band_from, float m_init, float l_init, LAS unsigned char* lds) {
    constexpr int NKS = DQK / 16, NCH = DQK / 8;
    const int tid = threadIdx.x, lane = tid & 63, r32 = lane & 31, hi = lane >> 5; const int wid = __builtin_amdgcn_readfirstlane(tid >> 6);
    const unsigned lds0 = (unsigned)(uintptr_t)lds;
    LAS float* wsf = (LAS float*)(lds + LDS_WS) + wid * 64;
    const bf16_t* ksrc = Kb + (size_t)lane * kpitch + wid * 8;
    const bf16_t* vsrc = Vb + (size_t)(16 * (wid & 3) + (lane >> 2)) * vpitch + (wid >> 2) * 32 + (lane & 3) * 8;
    const unsigned kdst = lds0 + LDS_K + wid * 1024, vdst = lds0 + LDS_V + wid * 1024;
#define ATT_DMA(t, s) do { glds16(ksrc + (size_t)(t) * 64 * kpitch, (unsigned)__builtin_amdgcn_readfirstlane(kdst + (s) * KSLOT)); \
        if (NCH > 8 && wid + 8 < NCH) glds16(ksrc + (size_t)(t) * 64 * kpitch + 64, (unsigned)__builtin_amdgcn_readfirstlane(kdst + (s) * KSLOT + 8192)); \
        glds16(vsrc + (size_t)(t) * 64 * vpitch, (unsigned)__builtin_amdgcn_readfirstlane(vdst + (s) * VSLOT)); } while (0)
    ATT_DMA(t0, 0);
    bf16x8 qr[NKS];
#pragma unroll
    for (int d0 = 0; d0 < NKS; ++d0) qr[d0] = *(const bf16x8*)(Qw + (size_t)r32 * qpitch + d0 * 16 + hi * 8);
    float mrun = m_init, l_reg = (hi == 0) ? l_init : 0.f; f32x16 o[2]; o[0] = f32x16{}; o[1] = f32x16{};
    const int qpos = pos0 + r32;
    int slot = 0;
    for (int t = t0; t < t1; ++t) {
        ATT_WAIT_BAR();
        if (t + 1 < t1) ATT_DMA(t + 1, slot ^ 1);
        const LAS unsigned char* kb = lds + LDS_K + slot * KSLOT + hi * 1024 + r32 * 16;
        f32x16 p0 = f32x16{}, p1 = f32x16{};
#pragma unroll
        for (int d0 = 0; d0 < NKS; ++d0) {
            const bf16x8 b0 = *(const LAS bf16x8*)(kb + d0 * 2048), b1 = *(const LAS bf16x8*)(kb + d0 * 2048 + 512);
            p0 = __builtin_amdgcn_mfma_f32_32x32x16_bf16(b0, qr[d0], p0, 0, 0, 0);
            p1 = __builtin_amdgcn_mfma_f32_32x32x16_bf16(b1, qr[d0], p1, 0, 0, 0);
        }
        if (SWA || t >= band_from) {
            const int kb0 = t * 64 + 4 * hi;
#pragma unroll
            for (int r = 0; r < 16; ++r) {
                const int kv = kb0 + (r & 3) + 8 * (r >> 2);
                bool ok0 = kv <= qpos, ok1 = kv + 32 <= qpos;
                if (SWA) { ok0 = ok0 && (kv > qpos - 128); ok1 = ok1 && (kv + 32 > qpos - 128); }
                if (!ok0) p0[r] = -__builtin_inff(); if (!ok1) p1[r] = -__builtin_inff();
            }
        }
        const float rm = rowmax(p0, p1);
        const float mnew = __builtin_fmaxf(mrun, rm);
        if (__any(mnew > mrun)) {
            const float f = __builtin_amdgcn_exp2f(mrun - mnew);
            l_reg *= f; mrun = mnew;
            if (hi == 0) wsf[r32] = f;
#pragma unroll
            for (int r = 0; r < 16; ++r) { const float fr_ = wsf[crow(r, hi)]; o[0][r] *= fr_; o[1][r] *= fr_; }
        }
        float sacc = 0.f;
#pragma unroll
        for (int r = 0; r < 16; ++r) { p0[r] = __builtin_amdgcn_exp2f(p0[r] - mrun); p1[r] = __builtin_amdgcn_exp2f(p1[r] - mrun); sacc += p0[r] + p1[r]; }
        l_reg += sacc;
        u32x4 pw[4];
        pw[0] = (u32x4){cvtpk(p0[0], p0[1]), cvtpk(p0[2], p0[3]), cvtpk(p0[4], p0[5]), cvtpk(p0[6], p0[7])};
        pw[1] = (u32x4){cvtpk(p0[8], p0[9]), cvtpk(p0[10], p0[11]), cvtpk(p0[12], p0[13]), cvtpk(p0[14], p0[15])};
        pw[2] = (u32x4){cvtpk(p1[0], p1[1]), cvtpk(p1[2], p1[3]), cvtpk(p1[4], p1[5]), cvtpk(p1[6], p1[7])};
        pw[3] = (u32x4){cvtpk(p1[8], p1[9]), cvtpk(p1[10], p1[11]), cvtpk(p1[12], p1[13]), cvtpk(p1[14], p1[15])};
        const LAS char* vp = (const LAS char*)(lds + LDS_V + slot * VSLOT) + ((lane >> 4) & 1) * 32 + (lane & 3) * 8 + (4 * hi + ((lane & 15) >> 2)) * 64;
#pragma unroll
        for (int d0 = 0; d0 < 2; ++d0)
#pragma unroll
            for (int ks = 0; ks < 4; ++ks) {
                const s16x4 lo = vtr(vp + d0 * 4096 + ks * 1024), hh = vtr(vp + d0 * 4096 + ks * 1024 + 512);
                const bf16x8 vf = (bf16x8){lo[0], lo[1], lo[2], lo[3], hh[0], hh[1], hh[2], hh[3]};
                o[d0] = __builtin_amdgcn_mfma_f32_32x32x16_bf16(__builtin_bit_cast(bf16x8, pw[ks]), vf, o[d0], 0, 0, 0);
            }
        slot ^= 1;
    }
    { auto rr = __builtin_amdgcn_permlane32_swap(__float_as_uint(l_reg), __float_as_uint(l_reg), false, false); l_reg = __uint_as_float(rr[0]) + __uint_as_float(rr[1]); }
    if (hi == 0) wsf[32 + r32] = l_reg;
    float rli[16];
#pragma unroll
    for (int r = 0; r < 16; ++r) rli[r] = __builtin_amdgcn_rcpf(wsf[32 + crow(r, hi)]);
    LAS bf16_t* stg = (LAS bf16_t*)(lds + LDS_OST) + wid * 2048;
#pragma unroll
    for (int r = 0; r < 16; ++r) { const int orow = crow(r, hi);
#pragma unroll
        for (int d0 = 0; d0 < 2; ++d0) stg[orow * 64 + d0 * 32 + r32] = (bf16_t)(cvtpk(o[d0][r] * rli[r], 0.f) & 0xffffu); }
    asm volatile("s_waitcnt lgkmcnt(0)" ::: "memory");
#pragma unroll
    for (int i = 0; i < 4; ++i) { const int row = i * 8 + (lane >> 3), ch = lane & 7; const u32x4 v = *(const LAS u32x4*)(stg + row * 64 + ch * 8); *(u32x4*)(Ow + (size_t)row * opitch + ch * 8) = v; }
    asm volatile("s_waitcnt lgkmcnt(0)\n\ts_barrier" ::: "memory");
#undef ATT_DMA
}
#undef MX3
}

struct Args { const float* in[16]; float* out; unsigned char* ws; int ph_lo, ph_hi; };

__device__ __forceinline__ int rope64_src(int vv) { return 4 * (vv >> 3) + (vv & 3) + 32 * ((vv >> 2) & 1); }
__device__ __forceinline__ int rope32_src(int vv) { return 4 * (vv >> 3) + (vv & 3) + 16 * ((vv >> 2) & 1); }
__device__ __forceinline__ int src_w1(int v) {
    if (v < 512) return O_QA + (v & ~63) + rope64_src(v & 63);
    if (v < 640) { const int u = v - 512; return O_KA + (u & ~63) + rope64_src(u & 63); }
    if (v < 768) return O_VA + (v - 640);
    if (v < 1152) return O_QL + (v - 768);
    if (v < 1184) return O_KR + rope32_src(v - 1152);
    if (v < 1280) return -1;
    if (v < 1536) return O_KVL + (v - 1280);
    if (v < 2560) return O_GA + (v - 1536);
    return O_GB + (v - 2560);
}
__device__ __forceinline__ int src_uq(int v) { if (v < 512) return (v >> 6) * 96 + (v & 63); const int u = v - 512; return (u >> 5) * 96 + 64 + rope32_src(u & 31); }
__device__ __forceinline__ int src_ukv(int v) { if (v < 512) return (v >> 6) * 128 + (v & 63); const int u = v - 512; return (u >> 6) * 128 + 64 + (u & 63); }

template <bool GAIN> __device__ __forceinline__ void tr_item_t(const float* W, int ldw, int sc, const float* gain, int k0, bf16_t* dst, int ldd, LAS float* scr, int lane) {
    const float msk = sc >= 0 ? 1.f : 0.f; const int scc = sc >= 0 ? sc : 0;
#pragma unroll 8
    for (int i = 0; i < 32; ++i) { const int kk = 2 * i + (lane >> 5); float v = W[(size_t)(k0 + kk) * ldw + scc] * msk; if (GAIN) v *= gain[k0 + kk]; scr[kk * 33 + (lane & 31)] = v; }
    asm volatile("s_waitcnt lgkmcnt(0)" ::: "memory");
    const int c = lane & 7;
#pragma unroll
    for (int j = 0; j < 4; ++j) { const int n = (lane >> 3) + 8 * j; const LAS float* s = scr + (8 * c) * 33 + n;
        u32x4 o; o.x = cvtpk(s[0 * 33], s[1 * 33]); o.y = cvtpk(s[2 * 33], s[3 * 33]); o.z = cvtpk(s[4 * 33], s[5 * 33]); o.w = cvtpk(s[6 * 33], s[7 * 33]);
        *(u32x4*)(dst + (size_t)n * ldd + k0 + 8 * c) = o; }
    asm volatile("s_waitcnt lgkmcnt(0)" ::: "memory");
}

__device__ __forceinline__ void tr_item(const float* W, int ldw, int sc, const float* gain, int k0, bf16_t* dst, int ldd, LAS float* scr, int lane) {
    if (gain) tr_item_t<true>(W, ldw, sc, gain, k0, dst, ldd, scr, lane); else tr_item_t<false>(W, ldw, sc, gain, k0, dst, ldd, scr, lane);
}

__global__ void __launch_bounds__(NWAVES * 64, 2) fwd_kernel(Args args) {
    extern __shared__ __attribute__((aligned(16))) unsigned char lds_raw[];
    LAS unsigned char* lds = (LAS unsigned char*)lds_raw;
    const int tid = threadIdx.x, lane = tid & 63, wave = __builtin_amdgcn_readfirstlane(tid >> 6);
    const int G = gridDim.x, bx = blockIdx.x;
    const int vcu = (G % 8 == 0) ? (bx % 8) * (G / 8) + bx / 8 : bx;
    unsigned char* ws = args.ws;
    const float* X = args.in[0]; float* OUT = args.out;
    bf16_t* W1T = (bf16_t*)(ws + WS_W1T); bf16_t* WUQT = (bf16_t*)(ws + WS_WUQT); bf16_t* WUKVT = (bf16_t*)(ws + WS_WUKVT); bf16_t* WOT = (bf16_t*)(ws + WS_WOT);
    bf16_t* WOUTT = (bf16_t*)(ws + WS_WOUTT); bf16_t* WGUT = (bf16_t*)(ws + WS_WGUT); bf16_t* WDT = (bf16_t*)(ws + WS_WDT);
    float* cosA = (float*)(ws + WS_TAB); float* sinA = cosA + SEQ * 32; float* cosB = sinA + SEQ * 32; float* sinB = cosB + SEQ * 16;
    float* SSQ_Q = (float*)(ws + WS_SSQ); float* SSQ_KV = SSQ_Q + (size_t)T * 8; float* SSQ_X1 = SSQ_KV + (size_t)T * 4; float* SSQ_X2 = SSQ_X1 + (size_t)T * 16;
    bf16_t* XN = (bf16_t*)(ws + WS_XN); bf16_t* SG = (bf16_t*)(ws + WS_SG); bf16_t* QA = (bf16_t*)(ws + WS_QA); bf16_t* KA = (bf16_t*)(ws + WS_KA); bf16_t* VA = (bf16_t*)(ws + WS_VA);
    bf16_t* QLAT = (bf16_t*)(ws + WS_QLAT); bf16_t* KVLAT = (bf16_t*)(ws + WS_KVLAT); bf16_t* QM = (bf16_t*)(ws + WS_QM); bf16_t* KM = (bf16_t*)(ws + WS_KM);
    bf16_t* VM = (bf16_t*)(ws + WS_VM); bf16_t* OB = (bf16_t*)(ws + WS_OB); bf16_t* Y = (bf16_t*)(ws + WS_Y); bf16_t* HDN = (bf16_t*)(ws + WS_HDN);
    const int lo = args.ph_lo, hi = args.ph_hi;
#ifndef PHASE_MASK
#define PHASE_MASK 0x1ff
#endif
#define IN(k) (((PHASE_MASK >> (k)) & 1) && lo <= (k) && (k) < hi)
#if MK_N_LAUNCHES == 1
#define GRID_BAR() cg::this_grid().sync()
#else
#define GRID_BAR() do {} while (0)
#endif

    if (IN(0)) {
        LAS float* scr = (LAS float*)(lds + wave * 16384);
        const int gw = vcu * NWAVES + wave, NGW = G * NWAVES;
        constexpr int I_W1 = (DM / 64) * (NV1 / 32), I_UQ = (384 / 64) * (768 / 32), I_UKV = (256 / 64) * (1024 / 32), I_O = (512 / 64) * (1024 / 32), I_OUT = (DM / 64) * (DM / 32),
                      I_GU = (DM / 64) * (2 * DFF / 32), I_D = (DFF / 64) * (DM / 32);
        constexpr int NITEMS = I_W1 + I_UQ + I_UKV + 2 * I_O + I_OUT + I_GU + I_D;
        const int ln = lane & 31;
        for (int it = gw; it < NITEMS; it += NGW) {
            int r = it;
            if (r < I_W1) { const int nblk = NV1 / 32, kb = r / nblk, nb = r % nblk; tr_item(args.in[2], INW, src_w1(nb * 32 + ln), nullptr, kb * 64, W1T + (size_t)nb * 32 * DM, DM, scr, lane); continue; } r -= I_W1;
            if (r < I_UQ) { const int nblk = 768 / 32, kb = r / nblk, nb = r % nblk; tr_item(args.in[5], 768, src_uq(nb * 32 + ln), args.in[4], kb * 64, WUQT + (size_t)nb * 32 * 384, 384, scr, lane); continue; } r -= I_UQ;
            if (r < I_UKV) { const int nblk = 1024 / 32, kb = r / nblk, nb = r % nblk; tr_item(args.in[7], 1024, src_ukv(nb * 32 + ln), args.in[6], kb * 64, WUKVT + (size_t)nb * 32 * 256, 256, scr, lane); continue; } r -= I_UKV;
            if (r < I_O) { const int nblk = 1024 / 32, kb = r / nblk, nb = r % nblk; tr_item(args.in[8], DM, nb * 32 + ln, nullptr, kb * 64, WOT + (size_t)nb * 32 * 1024, 1024, scr, lane); continue; } r -= I_O;
            if (r < I_O) { const int nblk = 1024 / 32, kb = r / nblk, nb = r % nblk; tr_item(args.in[9], DM, nb * 32 + ln, nullptr, kb * 64, WOT + (size_t)nb * 32 * 1024 + 512, 1024, scr, lane); continue; } r -= I_O;
            if (r < I_OUT) { const int nblk = DM / 32, kb = r / nblk, nb = r % nblk; tr_item(args.in[10], DM, nb * 32 + ln, nullptr, kb * 64, WOUTT + (size_t)nb * 32 * DM, DM, scr, lane); continue; } r -= I_OUT;
            if (r < I_GU) { const int nblk = 2 * DFF / 32, kb = r / nblk, nb = r % nblk; const int v = nb * 32, pn = v >> 8, bj = (v >> 7) & 1, c = 128 * pn + (v & 127) + ln;
                            tr_item(bj ? args.in[13] : args.in[12], DFF, c, args.in[11], kb * 64, WGUT + (size_t)v * DM, DM, scr, lane); continue; } r -= I_GU;
            { const int nblk = DM / 32, kb = r / nblk, nb = r % nblk; tr_item(args.in[14], DM, nb * 32 + ln, nullptr, kb * 64, WDT + (size_t)nb * 32 * DFF, DFF, scr, lane); }
        }
        for (int i = (vcu * NWAVES + wave) * 64 + lane; i < SEQ * 32; i += G * NWAVES * 64) {
            { const int p = i >> 5, j = i & 31; const double a = (double)p * pow(10000.0, -(double)j / 32.0); cosA[i] = (float)cos(a); sinA[i] = (float)sin(a); }
            if (i < SEQ * 16) { const int p = i >> 4, j = i & 15; const double a = (double)p * pow(10000.0, -(double)j / 16.0); cosB[i] = (float)cos(a); sinB[i] = (float)sin(a); }
        }
        const float* g1 = args.in[1];
        f32x4 gv[4];
#pragma unroll
        for (int j = 0; j < 4; ++j) gv[j] = *(const f32x4*)(g1 + 4 * lane + 256 * j);
        for (int m = gw; m < T; m += NGW) {
            const f32x4* xr = (const f32x4*)(X + (size_t)m * DM) + lane;
            f32x4 v[4]; float s = 0.f;
#pragma unroll
            for (int j = 0; j < 4; ++j) { v[j] = xr[64 * j]; s += sumsq4(v[j]); }
            const float rs = 1.0f / sqrtf(wave_sum(s) * (1.0f / DM) + EPS);
            u32x2* o8 = (u32x2*)(XN + (size_t)m * DM) + lane;
#pragma unroll
            for (int j = 0; j < 4; ++j) o8[64 * j] = pack4(v[j] * rs * gv[j]);
        }
        if (IN(1)) GRID_BAR();
    }

    if (IN(1)) {
        pg8::Gemm g{XN, W1T, DM, DM, DM};
        pg8::SchedPlain S{{}, g}; S.o.init(T / 256, NV1 / 256, G, bx);
        EpiProj E{QA, KA, VA, QLAT, KVLAT, KM, SG, SSQ_Q, SSQ_KV, cosA, sinA, cosB, sinB};
        pg8::gemm_phase<EpiProj, pg8::SchedPlain, true, true>(lds, DM, DM, DM, S, E);
        if (IN(2)) GRID_BAR();
    }

    if (IN(2)) {
        { pg8::Gemm g{QLAT, WUQT, 384, 384, 384};
          pg8::SchedPlain S{{}, g}; S.o.init(T / 256, 3, G, bx);
          EpiUQ E{QM, SSQ_Q, cosB, sinB};
          pg8::gemm_phase<EpiUQ, pg8::SchedPlain, true, true>(lds, 384, 384, 384, S, E); }
        { pg8::Gemm g{KVLAT, WUKVT, 256, 256, 256};
          pg8::SchedPlain S{{}, g}; S.o.init(T / 256, 4, G, (G - 1) - bx);
          EpiUKV E{KM, VM, SSQ_KV};
          pg8::gemm_phase<EpiUKV, pg8::SchedPlain, true, true>(lds, 256, 256, 256, S, E); }
        if (IN(3)) GRID_BAR();
    }

    if (IN(3)) {
        const float* sinks = args.in[3];
        for (int base = vcu; base < 256; base += G) {
            const int bh = base >> 2, s = base & 3, b = bh >> 3, h = bh & 7;
            for (int i = 0; i < 4; ++i) {
                const int qb = (i == 0) ? s : (i == 1) ? 7 - s : (i == 2) ? 8 + s : 15 - s;
                const size_t row0 = (size_t)b * SEQ;
                const int q0 = qb * 256 + wave * 32;
                att::unit<96, false>(QM + (row0 + q0) * 768 + h * 96, 768, KM + row0 * 768 + h * 96, 768, VM + row0 * 512 + h * 64, 512,
                                     OB + (row0 + q0) * 512 + h * 64, 512, q0, 0, 4 * qb + 4, 4 * qb, -1e30f, 0.f, lds);
            }
        }
        for (int base = vcu; base < 256; base += G) {
            const int bk = base >> 4, b = bk >> 1, kvh = bk & 1;
            for (int i = 0; i < 4; ++i) {
                const int blk = (base & 15) + 16 * i;
                const size_t row0 = (size_t)b * SEQ;
                const int hq = 4 * kvh + (wave >> 1), q0 = 64 * blk + 32 * (wave & 1);
                const int t0 = blk >= 2 ? blk - 2 : 0;
                const float sk = sinks[hq] * LOG2E;
                att::unit<64, true>(QA + (row0 + q0) * 512 + hq * 64, 512, KA + row0 * 128 + kvh * 64, 128, VA + row0 * 128 + kvh * 64, 128,
                                    QA + (row0 + q0) * 512 + hq * 64, 512, q0, t0, blk + 1, 0, sk, 1.0f, lds);
            }
        }
        if (IN(4)) GRID_BAR();
    }

    if (IN(4)) {
        pg8::SchedPair S{{}, QA, OB, WOT, 512, 1024, 512}; S.o.init(T / 256, 4, G, bx);
        EpiGate E{SG, Y};
        pg8::gemm_phase<EpiGate, pg8::SchedPair, true, true>(lds, 512, 1024, 512, S, E);
        if (IN(5)) GRID_BAR();
    }

    if (IN(5)) {
        pg8::Gemm g{Y, WOUTT, DM, DM, DM};
        pg8::SchedPlain S{{}, g}; S.o.init(T / 256, 4, G, bx);
        EpiRes1 E{X, OUT, XN, SSQ_X1};
        pg8::gemm_phase<EpiRes1, pg8::SchedPlain, true, true>(lds, DM, DM, DM, S, E);
        if (IN(6)) GRID_BAR();
    }

    if (IN(6)) {
        pg8::Gemm g{XN, WGUT, DM, DM, DM};
        pg8::SchedPlain S{{}, g}; S.o.init(T / 256, 22, G, bx);
        EpiSwiglu E{SSQ_X1, HDN};
        pg8::gemm_phase<EpiSwiglu, pg8::SchedPlain, true, true>(lds, DM, DM, DM, S, E);
        if (IN(7)) GRID_BAR();
    }

    if (IN(7)) {
        pg8::Gemm g{HDN, WDT, DFF, DFF, DFF};
        pg8::SchedPlain S{{}, g}; S.o.init(T / 256, 4, G, bx);
        EpiRes2 E{OUT, SSQ_X2};
        pg8::gemm_phase<EpiRes2, pg8::SchedPlain, true, true>(lds, DFF, DFF, DFF, S, E);
        if (IN(8)) GRID_BAR();
    }

    if (IN(8)) {
        const int gw = vcu * NWAVES + wave, NGW = G * NWAVES;
        const float* gf = args.in[15];
        f32x4 gv[4];
#pragma unroll
        for (int j = 0; j < 4; ++j) gv[j] = *(const f32x4*)(gf + 4 * lane + 256 * j);
        for (int m = gw; m < T; m += NGW) {
            float ss = 0.f;
#pragma unroll
            for (int i = 0; i < 4; ++i) { const f32x4 s4 = *(const f32x4*)(SSQ_X2 + (size_t)m * 16 + 4 * i); ss += (s4[0] + s4[1]) + (s4[2] + s4[3]); }
            const float rs = 1.0f / sqrtf(ss * (1.0f / DM) + EPS);
            f32x4* xr = (f32x4*)(OUT + (size_t)m * DM) + lane;
#pragma unroll
            for (int j = 0; j < 4; ++j) xr[64 * j] = xr[64 * j] * rs * gv[j];
        }
    }
#undef IN
#undef GRID_BAR
}

extern "C" void kernel_launch(void* const* d_in, const int* in_sizes, int n_in, void* d_out, int out_size, void* d_ws, size_t ws_size, hipStream_t stream) {
    static int grid = 0;
    if (grid == 0) {
        if (n_in != 16 || out_size != T * DM || ws_size < WS_END) { fprintf(stderr, "kernel_launch: unexpected shapes (n_in %d out %d ws %zu, need ws >= %zu)\n", n_in, out_size, ws_size, (size_t)WS_END); grid = -1; return; }
        int dev = 0, cus = 0, per_cu = 0;
        hipGetDevice(&dev); hipDeviceGetAttribute(&cus, hipDeviceAttributeMultiprocessorCount, dev);
        if (hipFuncSetAttribute((const void*)fwd_kernel, hipFuncAttributeMaxDynamicSharedMemorySize, LDS_BYTES) != hipSuccess) { fprintf(stderr, "kernel_launch: hipFuncSetAttribute failed\n"); grid = -1; return; }
        if (hipOccupancyMaxActiveBlocksPerMultiprocessor(&per_cu, (const void*)fwd_kernel, NWAVES * 64, LDS_BYTES) != hipSuccess || per_cu < 1) { fprintf(stderr, "kernel_launch: occupancy query says %d\n", per_cu); per_cu = 1; }
        (void)hipGetLastError();
        grid = cus;
        fprintf(stderr, "kernel_launch: grid %d (cus %d, per_cu %d)\n", grid, cus, per_cu);
    }
    if (grid < 0) return;
    Args a{};
    for (int i = 0; i < 16; ++i) a.in[i] = (const float*)d_in[i];
    a.out = (float*)d_out; a.ws = (unsigned char*)d_ws;
#if MK_N_LAUNCHES == 1
    a.ph_lo = 0; a.ph_hi = 9;
    void* kargs[] = {&a};
    hipError_t e = hipLaunchCooperativeKernel((const void*)fwd_kernel, dim3(grid), dim3(NWAVES * 64), kargs, LDS_BYTES, stream);
    if (e != hipSuccess) fprintf(stderr, "cooperative launch failed: %s (grid %d)\n", hipGetErrorString(e), grid);
#else
    for (int p = 0; p < 9; ++p) { a.ph_lo = p; a.ph_hi = p + 1; hipLaunchKernelGGL(fwd_kernel, dim3(grid), dim3(NWAVES * 64), LDS_BYTES, stream, a); }
#endif
}
```

```cpp
#include <hip/hip_runtime.h>
#include <hip/hip_cooperative_groups.h>
#include <cstdio>
#include <cstdint>
namespace cg = cooperative_groups;

#ifndef MK_N_LAUNCHES
#define MK_N_LAUNCHES 1
#endif

#define LAS __attribute__((address_space(3)))
#define GAS __attribute__((address_space(1)))
typedef unsigned short bf16_t;
typedef short bf16x8 __attribute__((ext_vector_type(8)));
typedef short s16x4 __attribute__((ext_vector_type(4)));
typedef float f32x2 __attribute__((ext_vector_type(2)));
typedef float f32x4 __attribute__((ext_vector_type(4)));
typedef float f32x16 __attribute__((ext_vector_type(16)));
typedef unsigned u32x2 __attribute__((ext_vector_type(2)));
typedef unsigned u32x4 __attribute__((ext_vector_type(4)));
typedef __bf16 bf16x2_t __attribute__((ext_vector_type(2)));

constexpr int NB = 8, SEQ = 4096, T = NB * SEQ, DM = 1024, DFF = 2816;
constexpr int INW = 3488, NV1 = 3584;
constexpr int O_QA = 0, O_KA = 512, O_VA = 640, O_QL = 768, O_KVL = 1152, O_KR = 1408, O_GA = 1440, O_GB = 2464;
constexpr float EPS = 1e-6f;
constexpr float LOG2E = 1.4426950408889634f;
constexpr float QA_SCALE = 0.125f * LOG2E;
constexpr float QM_SCALE = 0.10206207261596577f * LOG2E;

constexpr size_t MiB = 1u << 20;
constexpr size_t WS_W1T = 0 * MiB, WS_WUQT = 7 * MiB, WS_WUKVT = 8 * MiB, WS_WOT = 9 * MiB, WS_WOUTT = 11 * MiB, WS_WGUT = 13 * MiB, WS_WDT = 24 * MiB;
constexpr size_t WS_TAB = 30 * MiB;
constexpr size_t WS_SSQ = 32 * MiB;
constexpr size_t WS_XN = 38 * MiB;
constexpr size_t WS_SG = 102 * MiB;
constexpr size_t WS_QA = 230 * MiB;
constexpr size_t WS_KA = 262 * MiB, WS_VA = 270 * MiB;
constexpr size_t WS_QLAT = 278 * MiB, WS_KVLAT = 302 * MiB;
constexpr size_t WS_QM = 318 * MiB, WS_KM = 366 * MiB;
constexpr size_t WS_VM = 414 * MiB, WS_OB = 446 * MiB;
constexpr size_t WS_CTL = 478 * MiB, CTL_BYTES = 16384;
constexpr size_t WS_END = 479 * MiB;
constexpr size_t WS_Y = WS_QM;
constexpr size_t WS_HDN = WS_SG;
static_assert(WS_HDN + (size_t)T * DFF * 2 <= WS_QLAT && WS_Y + (size_t)T * DM * 2 <= WS_VM, "overlays");

constexpr int NWAVES = 8;
constexpr int RING_BYTES = 131072, MISC_OFF = RING_BYTES + 320, LDS_BYTES = 147456;

__device__ __forceinline__ unsigned cvtpk(float lo, float hi) { f32x2 v = {lo, hi}; bf16x2_t b = __builtin_convertvector(v, bf16x2_t); return __builtin_bit_cast(unsigned, b); }
__device__ __forceinline__ u32x4 pack8(f32x4 a, f32x4 b) { u32x4 w; w.x = cvtpk(a[0], a[1]); w.y = cvtpk(a[2], a[3]); w.z = cvtpk(b[0], b[1]); w.w = cvtpk(b[2], b[3]); return w; }
__device__ __forceinline__ u32x2 pack4(f32x4 a) { u32x2 w; w.x = cvtpk(a[0], a[1]); w.y = cvtpk(a[2], a[3]); return w; }
__device__ __forceinline__ float bf_lo(unsigned w) { return __uint_as_float(w << 16); }
__device__ __forceinline__ float bf_hi(unsigned w) { return __uint_as_float(w & 0xffff0000u); }
__device__ __forceinline__ float sigmoidf_fast(float x) { return __builtin_amdgcn_rcpf(1.0f + __builtin_amdgcn_exp2f(-x * LOG2E)); }
__device__ __forceinline__ float wave_sum(float v) {
#pragma unroll
    for (int o = 1; o < 64; o <<= 1) v += __shfl_xor(v, o);
    return v;
}
__device__ __forceinline__ float sumsq4(f32x4 a) { return (a[0] * a[0] + a[1] * a[1]) + (a[2] * a[2] + a[3] * a[3]); }

namespace pg8 {
constexpr int BM = 256, BK = 64, HALF = 128, HTB = HALF * BK * 2, STAGE_BYTES = 8 * HTB, NXCD = 8, WGM = 8;
__host__ __device__ __forceinline__ int lds_byte(int r, int c) { const int st = (r >> 4) * 2 + (c >> 5), rr = r & 15, cc = c & 31, ob = rr * 64 + cc * 2; return st * 1024 + (ob ^ (((ob >> 9) & 1) << 5)); }
__host__ __device__ __forceinline__ void stage_rc(int b, int& R, int& C) { const int st = b / 1024, sb = b % 1024, swz = sb ^ (((sb >> 9) & 1) << 5); R = (st >> 1) * 16 + swz / 64; C = (st & 1) * 32 + (swz % 64) / 2; }
__host__ __device__ __forceinline__ int perm32(int rho) { const int n = rho >> 4, i = rho & 15; return 8 * (i >> 2) + 4 * n + (i & 3); }

struct Unit { int pm, pn, part; };
struct Gemm { const bf16_t* A; const bf16_t* Bt; int lda, ldb, K; };

struct TileOrder {
    int nM, nN, nwg, G, c;
    __device__ void init(int nM_, int nN_, int G_, int c_) { nM = nM_; nN = nN_; nwg = nM * nN; G = G_; c = c_; }
    __device__ bool tile(int i, int& pm, int& pn) const {
        const long L = (long)i * G + c; if (L >= nwg) return false;
        int wgid = (int)L; { const int q = nwg / NXCD, r = nwg % NXCD, xcd = wgid % NXCD, off = wgid / NXCD; wgid = (xcd < r ? xcd * (q + 1) : r * (q + 1) + (xcd - r) * q) + off; }
        const int nig = WGM * nN, gid = wgid / nig, fm = gid * WGM, gsz = (nM - fm) < WGM ? (nM - fm) : WGM;
        pm = fm + ((wgid % nig) % gsz); pn = (wgid % nig) / gsz; return true;
    }
};
struct SchedPlain {
    TileOrder o; const Gemm g;
    __device__ bool next(int i, Unit& u) const { u.part = 0; return o.tile(i, u.pm, u.pn); }
    __device__ __forceinline__ void ptrs(const Unit& u, const char*& a, const char*& b) const { a = (const char*)g.A + (size_t)u.pm * BM * g.lda * 2; b = (const char*)g.Bt + (size_t)u.pn * BM * g.ldb * 2; }
    __device__ __forceinline__ bool keep(const Unit&) const { return false; }
};
struct SchedPair {
    TileOrder o; const bf16_t* A0; const bf16_t* A1; const bf16_t* Bt; int lda, ldb, K;
    __device__ bool next(int i, Unit& u) const { u.part = i & 1; return o.tile(i >> 1, u.pm, u.pn); }
    __device__ __forceinline__ void ptrs(const Unit& u, const char*& a, const char*& b) const { a = (const char*)(u.part ? A1 : A0) + (size_t)u.pm * BM * lda * 2; b = (const char*)Bt + (size_t)u.pn * BM * ldb * 2 + (size_t)u.part * K * 2; }
    __device__ __forceinline__ bool keep(const Unit& u) const { return u.part == 0; }
};

template <class Epi, class Sched, bool ALIGN_EPI, bool SP2>
__device__ __forceinline__ void gemm_phase(LAS unsigned char* lds, const int lda, const int ldb, const int K, const Sched& S, const Epi& E) {
    const int tid = threadIdx.x, wid = __builtin_amdgcn_readfirstlane(tid >> 6), lane = tid & 63, wr = wid >> 2, wc = wid & 3, fr = lane & 15, fq = lane >> 4;
    const int nt = K / BK;
    unsigned voffA[2], voffB[2];
#pragma unroll
    for (int i = 0; i < 2; ++i) { int R, C; stage_rc(tid * 16 + i * 8192, R, C); const int Rb = (R & ~31) + perm32(R & 31);
        voffA[i] = (unsigned)(R * lda + C) * 2u; voffB[i] = (unsigned)(Rb * ldb + C) * 2u; }
    const size_t kstep = (size_t)(BK * 2);
    const size_t hstepA = (size_t)HALF * lda * 2, hstepB = (size_t)HALF * ldb * 2;
    const unsigned ldsw = (unsigned)wid * 1024u;
    const int aoff = lds_byte(wr * 64 + fr, fq * 8), boff = lds_byte(wc * 32 + fr, fq * 8);
#define PG8_SA(b, h) (((b) * 2 + (h)) * HTB)
#define PG8_SB(b, h) ((4 + (b) * 2 + (h)) * HTB)
#define PG8_STAGE(bufoff, gbase, voff) do { _Pragma("unroll") for (int _i = 0; _i < 2; ++_i) \
        __builtin_amdgcn_global_load_lds((const unsigned*)((const char*)(gbase) + (voff)[_i]), (LAS unsigned*)(lds + (bufoff) + ldsw + _i * 8192), 16, 0, 0); } while (0)
#define PG8_LDA(dst, b, h) do { _Pragma("unroll") for (int m = 0; m < 4; ++m) _Pragma("unroll") for (int k = 0; k < 2; ++k) dst[m][k] = *(const LAS bf16x8*)(lds + PG8_SA(b, h) + aoff + m * 2048 + k * 1024); } while (0)
#define PG8_LDB(dst, b, h) do { _Pragma("unroll") for (int n = 0; n < 2; ++n) _Pragma("unroll") for (int k = 0; k < 2; ++k) dst[n][k] = *(const LAS bf16x8*)(lds + PG8_SB(b, h) + boff + n * 2048 + k * 1024); } while (0)
#define PG8_MMA(ai, bj, At, Bt) do { __builtin_amdgcn_s_setprio(1); _Pragma("unroll") for (int m = 0; m < 4; ++m) _Pragma("unroll") for (int n = 0; n < 2; ++n) _Pragma("unroll") for (int k = 0; k < 2; ++k) \
        acc[ai][bj][m][n] = __builtin_amdgcn_mfma_f32_16x16x32_bf16(Bt[n][k], At[m][k], acc[ai][bj][m][n], 0, 0, 0); __builtin_amdgcn_s_setprio(0); } while (0)
#define PG8_WAIT_V(n) asm volatile("s_waitcnt vmcnt(" #n ")" ::: "memory")
#define PG8_WAIT_L(n) asm volatile("s_waitcnt lgkmcnt(" #n ")" ::: "memory")
#define PG8_BAR __builtin_amdgcn_s_barrier()
#define PG8_SCHED __builtin_amdgcn_sched_barrier(0)
    Unit cur, nxt; int ui = 0;
    if (!S.next(0, cur)) return;
    f32x4 acc[2][2][4][2];
#pragma unroll
    for (int a = 0; a < 2; ++a)
#pragma unroll
        for (int b = 0; b < 2; ++b)
#pragma unroll
            for (int m = 0; m < 4; ++m)
#pragma unroll
                for (int n = 0; n < 2; ++n) acc[a][b][m][n] = (f32x4){0.f, 0.f, 0.f, 0.f};
    bf16x8 At[4][2], B0[2][2], B1[2][2];
    const char* cA; const char* cB; S.ptrs(cur, cA, cB);
    if constexpr (SP2) {
        PG8_STAGE(PG8_SB(0, 0), cB, voffB); PG8_STAGE(PG8_SB(0, 1), cB + hstepB, voffB); PG8_STAGE(PG8_SA(0, 0), cA, voffA); PG8_STAGE(PG8_SA(0, 1), cA + hstepA, voffA);
        if (wr == 1) PG8_BAR;
        PG8_WAIT_V(2); PG8_BAR;
        PG8_STAGE(PG8_SB(1, 0), cB + kstep, voffB); PG8_STAGE(PG8_SA(1, 0), cA + kstep, voffA); PG8_STAGE(PG8_SB(1, 1), cB + hstepB + kstep, voffB);
        PG8_WAIT_V(6); PG8_BAR;
    } else {
        PG8_STAGE(PG8_SB(0, 0), cB, voffB); PG8_STAGE(PG8_SA(0, 0), cA, voffA); PG8_STAGE(PG8_SB(0, 1), cB + hstepB, voffB); PG8_STAGE(PG8_SA(0, 1), cA + hstepA, voffA);
        if (wr == 1) PG8_BAR;
        PG8_WAIT_V(4); PG8_BAR;
        PG8_STAGE(PG8_SB(1, 0), cB + kstep, voffB); PG8_STAGE(PG8_SA(1, 0), cA + kstep, voffA); PG8_STAGE(PG8_SB(1, 1), cB + hstepB + kstep, voffB);
        PG8_WAIT_V(6); PG8_BAR;
    }
    for (;;) {
        const bool has_next = S.next(ui + 1, nxt);
        const char* nA = cA; const char* nB = cB; if (has_next) S.ptrs(nxt, nA, nB);
#pragma unroll 1
        for (int t = 0; t < nt; t += 2) {
            const bool last = (t == nt - 2);
            const char* a1 = cA + (size_t)(t + 1) * kstep;
            const char* a2 = last ? nA : cA + (size_t)(t + 2) * kstep; const char* b2 = last ? nB : cB + (size_t)(t + 2) * kstep;
            const char* a3 = a2 + kstep; const char* b3 = b2 + kstep;
            if constexpr (SP2) {
            PG8_LDB(B0, 0, 0); PG8_LDB(B1, 0, 1); PG8_SCHED; PG8_LDA(At, 0, 0); PG8_STAGE(PG8_SA(1, 1), a1 + hstepA, voffA);
            PG8_WAIT_V(8); PG8_WAIT_L(0); PG8_BAR; PG8_MMA(0, 0, At, B0); PG8_MMA(0, 1, At, B1); PG8_BAR; PG8_SCHED;
            PG8_LDA(At, 0, 1); PG8_STAGE(PG8_SB(0, 0), b2, voffB); PG8_STAGE(PG8_SB(0, 1), b2 + hstepB, voffB); PG8_STAGE(PG8_SA(0, 0), a2, voffA);
            PG8_WAIT_V(8); PG8_WAIT_L(0); PG8_BAR; PG8_MMA(1, 0, At, B0); PG8_MMA(1, 1, At, B1); PG8_BAR; PG8_SCHED;
            PG8_LDB(B0, 1, 0); PG8_LDB(B1, 1, 1); PG8_SCHED; PG8_LDA(At, 1, 0); PG8_STAGE(PG8_SA(0, 1), a2 + hstepA, voffA);
            PG8_WAIT_V(8); PG8_WAIT_L(0); PG8_BAR; PG8_MMA(0, 0, At, B0); PG8_MMA(0, 1, At, B1); PG8_BAR; PG8_SCHED;
            PG8_LDA(At, 1, 1); PG8_STAGE(PG8_SB(1, 0), b3, voffB); PG8_STAGE(PG8_SB(1, 1), b3 + hstepB, voffB); PG8_STAGE(PG8_SA(1, 0), a3, voffA);
            PG8_WAIT_V(8); PG8_WAIT_L(0); PG8_BAR; PG8_MMA(1, 0, At, B0); PG8_MMA(1, 1, At, B1); PG8_BAR; PG8_SCHED;
            } else {
            PG8_LDB(B0, 0, 0); PG8_SCHED; PG8_LDA(At, 0, 0); PG8_STAGE(PG8_SA(1, 1), a1 + hstepA, voffA);
            PG8_WAIT_L(8); PG8_BAR; PG8_WAIT_L(0); PG8_MMA(0, 0, At, B0); PG8_BAR; PG8_SCHED;
            PG8_LDB(B1, 0, 1); PG8_STAGE(PG8_SB(0, 0), b2, voffB);
            PG8_BAR; PG8_WAIT_L(0); PG8_MMA(0, 1, At, B1); PG8_BAR;
            PG8_LDA(At, 0, 1); PG8_STAGE(PG8_SA(0, 0), a2, voffA);
            PG8_BAR; PG8_WAIT_L(0); PG8_MMA(1, 0, At, B0); PG8_BAR; PG8_SCHED;
            PG8_STAGE(PG8_SB(0, 1), b2 + hstepB, voffB);
            PG8_WAIT_V(6); PG8_BAR; PG8_MMA(1, 1, At, B1); PG8_BAR;
            PG8_LDB(B0, 1, 0); PG8_SCHED; PG8_LDA(At, 1, 0); PG8_STAGE(PG8_SA(0, 1), a2 + hstepA, voffA);
            PG8_WAIT_L(8); PG8_BAR; PG8_WAIT_L(0); PG8_MMA(0, 0, At, B0); PG8_BAR; PG8_SCHED;
            PG8_LDB(B1, 1, 1); PG8_STAGE(PG8_SB(1, 0), b3, voffB);
            PG8_BAR; PG8_WAIT_L(0); PG8_MMA(0, 1, At, B1); PG8_BAR;
            PG8_LDA(At, 1, 1); PG8_STAGE(PG8_SA(1, 0), a3, voffA);
            PG8_BAR; PG8_WAIT_L(0); PG8_MMA(1, 0, At, B0); PG8_BAR; PG8_SCHED;
            PG8_STAGE(PG8_SB(1, 1), b3 + hstepB, voffB);
            PG8_WAIT_V(6); PG8_BAR; PG8_MMA(1, 1, At, B1); PG8_BAR;
            }
        }
        if constexpr (ALIGN_EPI) { if (wr == 0) PG8_BAR; }
        E(acc, cur, wr, wc, fr, fq);
        if (!has_next) break;
        if (!S.keep(cur)) {
#pragma unroll
        for (int a = 0; a < 2; ++a)
#pragma unroll
            for (int b = 0; b < 2; ++b)
#pragma unroll
                for (int m = 0; m < 4; ++m)
#pragma unroll
                    for (int n = 0; n < 2; ++n) acc[a][b][m][n] = (f32x4){0.f, 0.f, 0.f, 0.f};
        }
        cur = nxt; cA = nA; cB = nB; ++ui;
        if constexpr (ALIGN_EPI) { if (wr == 1) PG8_BAR; }
    }
    PG8_WAIT_V(0);
    if constexpr (!ALIGN_EPI) { if (wr == 0) PG8_BAR; }
    PG8_BAR;
#undef PG8_SA
#undef PG8_SB
#undef PG8_STAGE
#undef PG8_LDA
#undef PG8_LDB
#undef PG8_MMA
#undef PG8_WAIT_V
#undef PG8_WAIT_L
#undef PG8_BAR
#undef PG8_SCHED
}
}
using pg8::Unit;

struct EpiProj {
    bf16_t *QA, *KA, *VA, *QLAT, *KVLAT, *KM, *SG; float *SSQ_Q, *SSQ_KV; const float *cosA, *sinA, *cosB, *sinB;
    __device__ __forceinline__ void operator()(f32x4 (&acc)[2][2][4][2], const Unit& u, int wr, int wc, int fr, int fq) const {
        const int pn = u.pn, rbase = u.pm * 256 + wr * 64 + fr;
        if (pn <= 2) {
#pragma unroll
            for (int ai = 0; ai < 2; ++ai)
#pragma unroll
                for (int m = 0; m < 4; ++m) {
                    const int r = rbase + ai * 128 + m * 16, pos = r & (SEQ - 1);
                    const int d0 = 4 * (4 * (wc & 1) + fq);
                    const f32x4 c4 = *(const f32x4*)(cosA + pos * 32 + d0), s4 = *(const f32x4*)(sinA + pos * 32 + d0);
#pragma unroll
                    for (int bj = 0; bj < 2; ++bj) {
                        if (pn == 2 && bj == 1) { *(u32x4*)(VA + (size_t)r * 128 + 32 * wc + 8 * fq) = pack8(acc[ai][1][m][0], acc[ai][1][m][1]); }
                        else {
                            const f32x4 x1 = acc[ai][bj][m][0], x2 = acc[ai][bj][m][1];
                            f32x4 o1 = x1 * c4 - x2 * s4, o2 = x2 * c4 + x1 * s4;
                            bf16_t* dst;
                            if (pn < 2) { o1 = o1 * QA_SCALE; o2 = o2 * QA_SCALE; dst = QA + (size_t)r * 512 + (4 * pn + 2 * bj + (wc >> 1)) * 64 + d0; }
                            else dst = KA + (size_t)r * 128 + (wc >> 1) * 64 + d0;
                            *(u32x2*)dst = pack4(o1); *(u32x2*)(dst + 32) = pack4(o2);
                        }
                    }
                }
        } else if (pn <= 5) {
#pragma unroll
            for (int ai = 0; ai < 2; ++ai)
#pragma unroll
                for (int m = 0; m < 4; ++m) {
                    const int r = rbase + ai * 128 + m * 16, pos = r & (SEQ - 1);
                    float q = sumsq4(acc[ai][0][m][0]) + sumsq4(acc[ai][0][m][1]);
                    if (pn != 4) q += sumsq4(acc[ai][1][m][0]) + sumsq4(acc[ai][1][m][1]);
                    q += __shfl_xor(q, 16); q += __shfl_xor(q, 32);
                    if (pn == 3) {
                        *(u32x4*)(QLAT + (size_t)r * 384 + 32 * wc + 8 * fq) = pack8(acc[ai][0][m][0], acc[ai][0][m][1]);
                        *(u32x4*)(QLAT + (size_t)r * 384 + 128 + 32 * wc + 8 * fq) = pack8(acc[ai][1][m][0], acc[ai][1][m][1]);
                        if (fq == 0) SSQ_Q[(size_t)r * 8 + wc] = q;
                    } else if (pn == 4) {
                        *(u32x4*)(QLAT + (size_t)r * 384 + 256 + 32 * wc + 8 * fq) = pack8(acc[ai][0][m][0], acc[ai][0][m][1]);
                        if (fq == 0) SSQ_Q[(size_t)r * 8 + 4 + wc] = q;
                        if (wc == 0) {
                            const int i0 = 4 * fq;
                            const f32x4 c4 = *(const f32x4*)(cosB + pos * 16 + i0), s4 = *(const f32x4*)(sinB + pos * 16 + i0);
                            const f32x4 x1 = acc[ai][1][m][0], x2 = acc[ai][1][m][1];
                            const u32x2 w1 = pack4(x1 * c4 - x2 * s4), w2 = pack4(x2 * c4 + x1 * s4);
#pragma unroll
                            for (int h = 0; h < 8; ++h) { bf16_t* dst = KM + (size_t)r * 768 + h * 96 + 64 + i0; *(u32x2*)dst = w1; *(u32x2*)(dst + 16) = w2; }
                        }
                    } else {
                        *(u32x4*)(KVLAT + (size_t)r * 256 + 32 * wc + 8 * fq) = pack8(acc[ai][0][m][0], acc[ai][0][m][1]);
                        *(u32x4*)(KVLAT + (size_t)r * 256 + 128 + 32 * wc + 8 * fq) = pack8(acc[ai][1][m][0], acc[ai][1][m][1]);
                        if (fq == 0) SSQ_KV[(size_t)r * 4 + wc] = q;
                    }
                }
        } else {
            const int cb = (pn - 6) * 256 + 32 * wc + 8 * fq;
#pragma unroll
            for (int ai = 0; ai < 2; ++ai)
#pragma unroll
                for (int m = 0; m < 4; ++m) {
                    const int r = rbase + ai * 128 + m * 16;
#pragma unroll
                    for (int bj = 0; bj < 2; ++bj) {
                        f32x4 a = acc[ai][bj][m][0], b = acc[ai][bj][m][1];
#pragma unroll
                        for (int e = 0; e < 4; ++e) { a[e] = sigmoidf_fast(a[e]); b[e] = sigmoidf_fast(b[e]); }
                        *(u32x4*)(SG + (size_t)r * 2048 + cb + 128 * bj) = pack8(a, b);
                    }
                }
        }
    }
};

struct EpiUQ {
    bf16_t* QM; const float* SSQ_Q; const float *cosB, *sinB;
    __device__ __forceinline__ void operator()(f32x4 (&acc)[2][2][4][2], const Unit& u, int wr, int wc, int fr, int fq) const {
        const int pn = u.pn, rbase = u.pm * 256 + wr * 64 + fr;
#pragma unroll
        for (int ai = 0; ai < 2; ++ai)
#pragma unroll
            for (int m = 0; m < 4; ++m) {
                const int r = rbase + ai * 128 + m * 16, pos = r & (SEQ - 1);
                const f32x4 sa = *(const f32x4*)(SSQ_Q + (size_t)r * 8), sb = *(const f32x4*)(SSQ_Q + (size_t)r * 8 + 4);
                const float ss = ((sa[0] + sa[1]) + (sa[2] + sa[3])) + ((sb[0] + sb[1]) + (sb[2] + sb[3]));
                const float rs = __builtin_amdgcn_rsqf(ss * (1.0f / 384.0f) + EPS) * QM_SCALE;
                if (pn < 2) {
#pragma unroll
                    for (int bj = 0; bj < 2; ++bj)
                        *(u32x4*)(QM + (size_t)r * 768 + (4 * pn + 2 * bj + (wc >> 1)) * 96 + 32 * (wc & 1) + 8 * fq) = pack8(acc[ai][bj][m][0] * rs, acc[ai][bj][m][1] * rs);
                } else {
                    const int i0 = 4 * fq;
                    const f32x4 c4 = *(const f32x4*)(cosB + pos * 16 + i0), s4 = *(const f32x4*)(sinB + pos * 16 + i0);
#pragma unroll
                    for (int bj = 0; bj < 2; ++bj) {
                        const f32x4 x1 = acc[ai][bj][m][0] * rs, x2 = acc[ai][bj][m][1] * rs;
                        bf16_t* dst = QM + (size_t)r * 768 + (4 * bj + wc) * 96 + 64 + i0;
                        *(u32x2*)dst = pack4(x1 * c4 - x2 * s4); *(u32x2*)(dst + 16) = pack4(x2 * c4 + x1 * s4);
                    }
                }
                asm volatile("" ::: "memory");
            }
    }
};
struct EpiUKV {
    bf16_t *KM, *VM; const float* SSQ_KV;
    __device__ __forceinline__ void operator()(f32x4 (&acc)[2][2][4][2], const Unit& u, int wr, int wc, int fr, int fq) const {
        const int pn = u.pn, rbase = u.pm * 256 + wr * 64 + fr;
#pragma unroll
        for (int ai = 0; ai < 2; ++ai)
#pragma unroll
            for (int m = 0; m < 4; ++m) {
                const int r = rbase + ai * 128 + m * 16;
                const f32x4 sa = *(const f32x4*)(SSQ_KV + (size_t)r * 4);
                const float rs = __builtin_amdgcn_rsqf(((sa[0] + sa[1]) + (sa[2] + sa[3])) * (1.0f / 256.0f) + EPS);
#pragma unroll
                for (int bj = 0; bj < 2; ++bj) {
                    const int h = 4 * (pn & 1) + 2 * bj + (wc >> 1), d = 32 * (wc & 1) + 8 * fq;
                    bf16_t* dst = (pn < 2) ? KM + (size_t)r * 768 + h * 96 + d : VM + (size_t)r * 512 + h * 64 + d;
                    *(u32x4*)dst = pack8(acc[ai][bj][m][0] * rs, acc[ai][bj][m][1] * rs);
                }
                asm volatile("" ::: "memory");
            }
    }
};
struct EpiGate {
    const bf16_t* SG; bf16_t* Y;
    __device__ __forceinline__ void operator()(f32x4 (&acc)[2][2][4][2], const Unit& u, int wr, int wc, int fr, int fq) const {
        const int rbase = u.pm * 256 + wr * 64 + fr, cb = u.pn * 256 + 32 * wc + 8 * fq;
#pragma unroll
        for (int ai = 0; ai < 2; ++ai)
#pragma unroll
            for (int m = 0; m < 4; ++m) {
                const int r = rbase + ai * 128 + m * 16;
#pragma unroll
                for (int bj = 0; bj < 2; ++bj) {
                    const int c = cb + 128 * bj;
                    const u32x4 wb = *(const u32x4*)(SG + (size_t)r * 2048 + 1024 + c);
                    f32x4 b0 = {bf_lo(wb.x), bf_hi(wb.x), bf_lo(wb.y), bf_hi(wb.y)}, b1 = {bf_lo(wb.z), bf_hi(wb.z), bf_lo(wb.w), bf_hi(wb.w)};
                    if (u.part == 0) {
                        const u32x4 wa = *(const u32x4*)(SG + (size_t)r * 2048 + c);
                        const f32x4 a0 = {bf_lo(wa.x), bf_hi(wa.x), bf_lo(wa.y), bf_hi(wa.y)}, a1 = {bf_lo(wa.z), bf_hi(wa.z), bf_lo(wa.w), bf_hi(wa.w)};
#pragma unroll
                        for (int e = 0; e < 4; ++e) { acc[ai][bj][m][0][e] *= a0[e] * __builtin_amdgcn_rcpf(b0[e]); acc[ai][bj][m][1][e] *= a1[e] * __builtin_amdgcn_rcpf(b1[e]); }
                    } else {
                        *(u32x4*)(Y + (size_t)r * 1024 + c) = pack8(acc[ai][bj][m][0] * b0, acc[ai][bj][m][1] * b1);
                    }
                }
            }
    }
};
struct EpiRes1 {
    const float* X; float* OUT; bf16_t* X1B; float* SSQ;
    __device__ __forceinline__ void operator()(f32x4 (&acc)[2][2][4][2], const Unit& u, int wr, int wc, int fr, int fq) const {
        const int rbase = u.pm * 256 + wr * 64 + fr, cb = u.pn * 256 + 32 * wc + 8 * fq;
#pragma unroll
        for (int ai = 0; ai < 2; ++ai)
#pragma unroll
            for (int m = 0; m < 4; ++m) {
                const int r = rbase + ai * 128 + m * 16; float q = 0.f;
#pragma unroll
                for (int bj = 0; bj < 2; ++bj) {
                    const size_t o = (size_t)r * 1024 + cb + 128 * bj;
                    const f32x4 v0 = *(const f32x4*)(X + o) + acc[ai][bj][m][0], v1 = *(const f32x4*)(X + o + 4) + acc[ai][bj][m][1];
                    *(f32x4*)(OUT + o) = v0; *(f32x4*)(OUT + o + 4) = v1; *(u32x4*)(X1B + o) = pack8(v0, v1);
                    q += sumsq4(v0) + sumsq4(v1);
                }
                q += __shfl_xor(q, 16); q += __shfl_xor(q, 32);
                if (fq == 0) SSQ[(size_t)r * 16 + 4 * u.pn + wc] = q;
            }
    }
};
struct EpiSwiglu {
    const float* SSQ; bf16_t* HDN;
    __device__ __forceinline__ void operator()(f32x4 (&acc)[2][2][4][2], const Unit& u, int wr, int wc, int fr, int fq) const {
        const int rbase = u.pm * 256 + wr * 64 + fr, cb = u.pn * 128 + 32 * wc + 8 * fq;
#pragma unroll
        for (int ai = 0; ai < 2; ++ai)
#pragma unroll
            for (int m = 0; m < 4; ++m) {
                const int r = rbase + ai * 128 + m * 16;
                float ss = 0.f;
#pragma unroll
                for (int i = 0; i < 4; ++i) { const f32x4 s4 = *(const f32x4*)(SSQ + (size_t)r * 16 + 4 * i); ss += (s4[0] + s4[1]) + (s4[2] + s4[3]); }
                const float rs = __builtin_amdgcn_rsqf(ss * (1.0f / 1024.0f) + EPS);
                f32x4 h0, h1;
#pragma unroll
                for (int e = 0; e < 4; ++e) {
                    const float g0 = acc[ai][0][m][0][e] * rs, g1 = acc[ai][0][m][1][e] * rs;
                    h0[e] = g0 * sigmoidf_fast(g0) * (acc[ai][1][m][0][e] * rs); h1[e] = g1 * sigmoidf_fast(g1) * (acc[ai][1][m][1][e] * rs);
                }
                *(u32x4*)(HDN + (size_t)r * DFF + cb) = pack8(h0, h1);
            }
    }
};
struct EpiRes2 {
    float* OUT; float* SSQ;
    __device__ __forceinline__ void operator()(f32x4 (&acc)[2][2][4][2], const Unit& u, int wr, int wc, int fr, int fq) const {
        const int rbase = u.pm * 256 + wr * 64 + fr, cb = u.pn * 256 + 32 * wc + 8 * fq;
#pragma unroll
        for (int ai = 0; ai < 2; ++ai)
#pragma unroll
            for (int m = 0; m < 4; ++m) {
                const int r = rbase + ai * 128 + m * 16; float q = 0.f;
#pragma unroll
                for (int bj = 0; bj < 2; ++bj) {
                    const size_t o = (size_t)r * 1024 + cb + 128 * bj;
                    const f32x4 v0 = *(const f32x4*)(OUT + o) + acc[ai][bj][m][0], v1 = *(const f32x4*)(OUT + o + 4) + acc[ai][bj][m][1];
                    *(f32x4*)(OUT + o) = v0; *(f32x4*)(OUT + o + 4) = v1;
                    q += sumsq4(v0) + sumsq4(v1);
                }
                q += __shfl_xor(q, 16); q += __shfl_xor(q, 32);
                if (fq == 0) SSQ[(size_t)r * 16 + 4 * u.pn + wc] = q;
            }
    }
};

namespace att {
constexpr int KSLOT = 12288, VSLOT = 8192;
constexpr int LDS_K = 0, LDS_V = 2 * KSLOT, LDS_WS = LDS_V + 2 * VSLOT, LDS_OST = LDS_WS + NWAVES * 256, LDS_TOTAL = LDS_OST + NWAVES * 4096;
static_assert(LDS_TOTAL <= RING_BYTES, "attention LDS");
__device__ __forceinline__ int crow(int r, int hi) { return (r & 3) + 8 * (r >> 2) + 4 * hi; }
__device__ __forceinline__ void glds16(const void* g, unsigned lds_base) {
    unsigned sv; asm volatile("s_mov_b32 %0, m0\n\ts_mov_b32 m0, %2\n\ts_nop 0\n\tglobal_load_lds_dwordx4 %1, off\n\ts_mov_b32 m0, %0" : "=&s"(sv) : "v"(g), "s"(lds_base) : "memory"); }
#define ATT_WAIT_BAR() asm volatile("s_waitcnt vmcnt(0) lgkmcnt(0)\n\ts_barrier" ::: "memory")
#define MX3(a, b, c) __builtin_fmaxf(__builtin_fmaxf((a), (b)), (c))
__device__ __forceinline__ float rowmax(const f32x16& p0, const f32x16& p1) {
    float a = MX3(p0[0], p0[1], p1[0]), b = MX3(p0[2], p0[3], p1[1]); a = MX3(a, p1[2], p1[3]);
#pragma unroll
    for (int r = 4; r < 16; r += 4) { a = MX3(a, p0[r], p0[r + 1]); b = MX3(b, p0[r + 2], p0[r + 3]); a = MX3(a, p1[r], p1[r + 1]); b = MX3(b, p1[r + 2], p1[r + 3]); }
    float m = __builtin_fmaxf(a, b); auto rr = __builtin_amdgcn_permlane32_swap(__float_as_uint(m), __float_as_uint(m), false, false);
    return __builtin_fmaxf(__uint_as_float(rr[0]), __uint_as_float(rr[1])); }
typedef short v4i16_t __attribute__((ext_vector_type(4)));
__device__ __forceinline__ s16x4 vtr(const LAS char* p) { return __builtin_bit_cast(s16x4, __builtin_amdgcn_ds_read_tr16_b64_v4i16((LAS v4i16_t*)p)); }

template <int DQK, bool SWA>
__device__ __forceinline__ void unit(const bf16_t* Qw, int qpitch, const bf16_t* Kb, int kpitch, const bf16_t* Vb, int vpitch, bf16_t* Ow, int opitch,
                                     int pos0, int t0, int t1, int band_from, float m_init, float l_init, LAS unsigned char* lds) {
    constexpr int NKS = DQK / 16, NCH = DQK / 8;
    const int tid = threadIdx.x, lane = tid & 63, r32 = lane & 31, hi = lane >> 5; const int wid = __builtin_amdgcn_readfirstlane(tid >> 6);
    const unsigned lds0 = (unsigned)(uintptr_t)lds;
    LAS float* wsf = (LAS float*)(lds + LDS_WS) + wid * 64;
    const bf16_t* ksrc = Kb + (size_t)lane * kpitch + wid * 8;
    const bf16_t* vsrc = Vb + (size_t)(16 * (wid & 3) + (lane >> 2)) * vpitch + (wid >> 2) * 32 + (lane & 3) * 8;
    const unsigned kdst = lds0 + LDS_K + wid * 1024, vdst = lds0 + LDS_V + wid * 1024;
#define ATT_DMA(t, s) do { glds16(ksrc + (size_t)(t) * 64 * kpitch, (unsigned)__builtin_amdgcn_readfirstlane(kdst + (s) * KSLOT)); \
        if (NCH > 8 && wid + 8 < NCH) glds16(ksrc + (size_t)(t) * 64 * kpitch + 64, (unsigned)__builtin_amdgcn_readfirstlane(kdst + (s) * KSLOT + 8192)); \
        glds16(vsrc + (size_t)(t) * 64 * vpitch, (unsigned)__builtin_amdgcn_readfirstlane(vdst + (s) * VSLOT)); } while (0)
    ATT_DMA(t0, 0);
    bf16x8 qr[NKS];
#pragma unroll
    for (int d0 = 0; d0 < NKS; ++d0) qr[d0] = *(const bf16x8*)(Qw + (size_t)r32 * qpitch + d0 * 16 + hi * 8);
    float mrun = m_init, l_reg = (hi == 0) ? l_init : 0.f; f32x16 o[2]; o[0] = f32x16{}; o[1] = f32x16{};
    const int qpos = pos0 + r32;
    int slot = 0;
    for (int t = t0; t < t1; ++t) {
        ATT_WAIT_BAR();
        if (t + 1 < t1) ATT_DMA(t + 1, slot ^ 1);
        const LAS unsigned char* kb = lds + LDS_K + slot * KSLOT + hi * 1024 + r32 * 16;
        f32x16 p0 = f32x16{}, p1 = f32x16{};
#pragma unroll
        for (int d0 = 0; d0 < NKS; ++d0) {
            const bf16x8 b0 = *(const LAS bf16x8*)(kb + d0 * 2048), b1 = *(const LAS bf16x8*)(kb + d0 * 2048 + 512);
            p0 = __builtin_amdgcn_mfma_f32_32x32x16_bf16(b0, qr[d0], p0, 0, 0, 0);
            p1 = __builtin_amdgcn_mfma_f32_32x32x16_bf16(b1, qr[d0], p1, 0, 0, 0);
        }
        if (SWA || t >= band_from) {
            const int kb0 = t * 64 + 4 * hi;
#pragma unroll
            for (int r = 0; r < 16; ++r) {
                const int kv = kb0 + (r & 3) + 8 * (r >> 2);
                bool ok0 = kv <= qpos, ok1 = kv + 32 <= qpos;
                if (SWA) { ok0 = ok0 && (kv > qpos - 128); ok1 = ok1 && (kv + 32 > qpos - 128); }
                if (!ok0) p0[r] = -__builtin_inff(); if (!ok1) p1[r] = -__builtin_inff();
            }
        }
        const float rm = rowmax(p0, p1);
        const float mnew = __builtin_fmaxf(mrun, rm);
        if (__any(mnew > mrun)) {
            const float f = __builtin_amdgcn_exp2f(mrun - mnew);
            l_reg *= f; mrun = mnew;
            if (hi == 0) wsf[r32] = f;
#pragma unroll
            for (int r = 0; r < 16; ++r) { const float fr_ = wsf[crow(r, hi)]; o[0][r] *= fr_; o[1][r] *= fr_; }
        }
        float sacc = 0.f;
#pragma unroll
        for (int r = 0; r < 16; ++r) { p0[r] = __builtin_amdgcn_exp2f(p0[r] - mrun); p1[r] = __builtin_amdgcn_exp2f(p1[r] - mrun); sacc += p0[r] + p1[r]; }
        l_reg += sacc;
        u32x4 pw[4];
        pw[0] = (u32x4){cvtpk(p0[0], p0[1]), cvtpk(p0[2], p0[3]), cvtpk(p0[4], p0[5]), cvtpk(p0[6], p0[7])};
        pw[1] = (u32x4){cvtpk(p0[8], p0[9]), cvtpk(p0[10], p0[11]), cvtpk(p0[12], p0[13]), cvtpk(p0[14], p0[15])};
        pw[2] = (u32x4){cvtpk(p1[0], p1[1]), cvtpk(p1[2], p1[3]), cvtpk(p1[4], p1[5]), cvtpk(p1[6], p1[7])};
        pw[3] = (u32x4){cvtpk(p1[8], p1[9]), cvtpk(p1[10], p1[11]), cvtpk(p1[12], p1[13]), cvtpk(p1[14], p1[15])};
        const LAS char* vp = (const LAS char*)(lds + LDS_V + slot * VSLOT) + ((lane >> 4) & 1) * 32 + (lane & 3) * 8 + (4 * hi + ((lane & 15) >> 2)) * 64;
#pragma unroll
        for (int d0 = 0; d0 < 2; ++d0)
#pragma unroll
            for (int ks = 0; ks < 4; ++ks) {
                const s16x4 lo = vtr(vp + d0 * 4096 + ks * 1024), hh = vtr(vp + d0 * 4096 + ks * 1024 + 512);
                const bf16x8 vf = (bf16x8){lo[0], lo[1], lo[2], lo[3], hh[0], hh[1], hh[2], hh[3]};
                o[d0] = __builtin_amdgcn_mfma_f32_32x32x16_bf16(__builtin_bit_cast(bf16x8, pw[ks]), vf, o[d0], 0, 0, 0);
            }
        slot ^= 1;
    }
    { auto rr = __builtin_amdgcn_permlane32_swap(__float_as_uint(l_reg), __float_as_uint(l_reg), false, false); l_reg = __uint_as_float(rr[0]) + __uint_as_float(rr[1]); }
    if (hi == 0) wsf[32 + r32] = l_reg;
    float rli[16];
#pragma unroll
    for (int r = 0; r < 16; ++r) rli[r] = __builtin_amdgcn_rcpf(wsf[32 + crow(r, hi)]);
    LAS bf16_t* stg = (LAS bf16_t*)(lds + LDS_OST) + wid * 2048;
#pragma unroll
    for (int r = 0; r < 16; ++r) { const int orow = crow(r, hi);
#pragma unroll
        for (int d0 = 0; d0 < 2; ++d0) stg[orow * 64 + d0 * 32 + r32] = (bf16_t)(cvtpk(o[d0][r] * rli[r], 0.f) & 0xffffu); }
    asm volatile("s_waitcnt lgkmcnt(0)" ::: "memory");
#pragma unroll
    for (int i = 0; i < 4; ++i) { const int row = i * 8 + (lane >> 3), ch = lane & 7; const u32x4 v = *(const LAS u32x4*)(stg + row * 64 + ch * 8); *(u32x4*)(Ow + (size_t)row * opitch + ch * 8) = v; }
    asm volatile("s_waitcnt lgkmcnt(0)\n\ts_barrier" ::: "memory");
#undef ATT_DMA
}
#undef MX3
}

#define XB_TMO      128
#define XB_XCNT(j)  (256  + 64 * (j))
#define XB_XSUB(j)  (1280 + 64 * (j))
#define XB_XGEN(j)  (2304 + 64 * (j))
#define XB_TOP      3328
#define XB_TOPGEN   3392
#define XCD_BAR_WORDS 3456
#define XB_SPIN_CAP (1u << 18)
__device__ __forceinline__ unsigned xb_ld(unsigned* p)              { return __hip_atomic_load(p, __ATOMIC_RELAXED, __HIP_MEMORY_SCOPE_AGENT); }
__device__ __forceinline__ unsigned xb_add(unsigned* p, unsigned v) { return __hip_atomic_fetch_add(p, v, __ATOMIC_RELAXED, __HIP_MEMORY_SCOPE_AGENT); }
__device__ __forceinline__ unsigned xb_xcc_id() { return (unsigned)__builtin_amdgcn_s_getreg((3 << 11) | 20) & 0xFu; }
#define XB_SPIN(cond, bar) do { unsigned _sp = 0; while (cond) { __builtin_amdgcn_s_sleep(1); \
    if ((++_sp & 255u) == 0u) { if (xb_ld(&(bar)[XB_TMO])) break; if (_sp > XB_SPIN_CAP) { atomicAdd(&(bar)[XB_TMO], 1u); break; } } } } while (0)
struct XcdBarrier { unsigned* bar; unsigned x; volatile LAS unsigned* st; };
__device__ __forceinline__ XcdBarrier xcd_barrier_post(unsigned* bar, volatile LAS unsigned* st) {
    XcdBarrier b; b.bar = bar; b.x = xb_xcc_id(); b.st = st;
    if (threadIdx.x == 0) (void)xb_add(&bar[XB_XCNT(b.x)], 1u);
    return b;
}
__device__ __forceinline__ void xcd_barrier_complete(unsigned* bar, unsigned x, unsigned& nloc, unsigned& nx) {
    const unsigned G = gridDim.x * gridDim.y * gridDim.z;
    unsigned sum, cnt, mine, sp = 0u;
    for (;;) {
        sum = 0u; cnt = 0u; mine = 0u;
#pragma unroll
        for (unsigned j = 0; j < 16; ++j) { const unsigned c = xb_ld(&bar[XB_XCNT(j)]); sum += c; cnt += (c > 0u) ? 1u : 0u; mine = (j == x) ? c : mine; }
        if (sum == G) break;
        __builtin_amdgcn_s_sleep(1);
        if ((++sp & 255u) == 0u) { if (xb_ld(&bar[XB_TMO])) break; if (sp > XB_SPIN_CAP) { atomicAdd(&bar[XB_TMO], 1u); break; } }
    }
    nloc = mine > 0u ? mine : 1u; nx = cnt > 0u ? cnt : 1u;
}
__device__ __forceinline__ void xcd_barrier(const XcdBarrier& b) {
    asm volatile("s_waitcnt vmcnt(0)" ::: "memory");
    __syncthreads();
    if (threadIdx.x == 0) {
        unsigned* bar = b.bar;
        __builtin_amdgcn_s_waitcnt(0);
        unsigned nloc = b.st[0], nx = b.st[1];
        if (nloc == 0u) { xcd_barrier_complete(bar, b.x, nloc, nx); b.st[0] = nloc; b.st[1] = nx; }
        const unsigned old = xb_add(&bar[XB_XSUB(b.x)], 1u);
        const unsigned gen = old / nloc;
        if (old + 1u == (gen + 1u) * nloc) {
            __builtin_amdgcn_fence(__ATOMIC_RELEASE, "agent");
            asm volatile("s_waitcnt vmcnt(0)" ::: "memory");
            const unsigned og = xb_add(&bar[XB_TOP], 1u);
            const unsigned tg = og / nx;
            if (og + 1u == (tg + 1u) * nx) xb_add(&bar[XB_TOPGEN], 1u);
            else XB_SPIN(xb_ld(&bar[XB_TOPGEN]) == tg, bar);
            __builtin_amdgcn_fence(__ATOMIC_ACQUIRE, "agent");
            xb_add(&bar[XB_XGEN(b.x)], 1u);
            asm volatile("s_waitcnt vmcnt(0)" ::: "memory");
        } else {
            XB_SPIN(xb_ld(&bar[XB_XGEN(b.x)]) == gen, bar);
            __builtin_amdgcn_fence(__ATOMIC_ACQUIRE, "agent");
            asm volatile("s_waitcnt vmcnt(0)" ::: "memory");
        }
    }
    __syncthreads();
}

struct Args { const float* in[16]; float* out; unsigned char* ws; int ph_lo, ph_hi; };

__device__ __forceinline__ int rope64_src(int vv) { return 4 * (vv >> 3) + (vv & 3) + 32 * ((vv >> 2) & 1); }
__device__ __forceinline__ int rope32_src(int vv) { return 4 * (vv >> 3) + (vv & 3) + 16 * ((vv >> 2) & 1); }
__device__ __forceinline__ int src_w1(int v) {
    if (v < 512) return O_QA + (v & ~63) + rope64_src(v & 63);
    if (v < 640) { const int u = v - 512; return O_KA + (u & ~63) + rope64_src(u & 63); }
    if (v < 768) return O_VA + (v - 640);
    if (v < 1152) return O_QL + (v - 768);
    if (v < 1184) return O_KR + rope32_src(v - 1152);
    if (v < 1280) return -1;
    if (v < 1536) return O_KVL + (v - 1280);
    if (v < 2560) return O_GA + (v - 1536);
    return O_GB + (v - 2560);
}
__device__ __forceinline__ int src_uq(int v) { if (v < 512) return (v >> 6) * 96 + (v & 63); const int u = v - 512; return (u >> 5) * 96 + 64 + rope32_src(u & 31); }
__device__ __forceinline__ int src_ukv(int v) { if (v < 512) return (v >> 6) * 128 + (v & 63); const int u = v - 512; return (u >> 6) * 128 + 64 + (u & 63); }

template <bool GAIN> __device__ __forceinline__ void tr_item_t(const float* W, int ldw, int sc, const float* gain, int k0, bf16_t* dst, int ldd, LAS float* scr, int lane) {
    const float msk = sc >= 0 ? 1.f : 0.f; const int scc = sc >= 0 ? sc : 0;
#pragma unroll 8
    for (int i = 0; i < 32; ++i) { const int kk = 2 * i + (lane >> 5); float v = W[(size_t)(k0 + kk) * ldw + scc] * msk; if (GAIN) v *= gain[k0 + kk]; scr[kk * 33 + (lane & 31)] = v; }
    asm volatile("s_waitcnt lgkmcnt(0)" ::: "memory");
    const int c = lane & 7;
#pragma unroll
    for (int j = 0; j < 4; ++j) { const int n = (lane >> 3) + 8 * j; const LAS float* s = scr + (8 * c) * 33 + n;
        u32x4 o; o.x = cvtpk(s[0 * 33], s[1 * 33]); o.y = cvtpk(s[2 * 33], s[3 * 33]); o.z = cvtpk(s[4 * 33], s[5 * 33]); o.w = cvtpk(s[6 * 33], s[7 * 33]);
        *(u32x4*)(dst + (size_t)n * ldd + k0 + 8 * c) = o; }
    asm volatile("s_waitcnt lgkmcnt(0)" ::: "memory");
}

__device__ __forceinline__ void tr_item(const float* W, int ldw, int sc, const float* gain, int k0, bf16_t* dst, int ldd, LAS float* scr, int lane) {
    if (gain) tr_item_t<true>(W, ldw, sc, gain, k0, dst, ldd, scr, lane); else tr_item_t<false>(W, ldw, sc, gain, k0, dst, ldd, scr, lane);
}

__global__ void __launch_bounds__(NWAVES * 64, 2) fwd_kernel(Args args) {
    extern __shared__ __attribute__((aligned(16))) unsigned char lds_raw[];
    LAS unsigned char* lds = (LAS unsigned char*)lds_raw;
    const int tid = threadIdx.x, lane = tid & 63, wave = __builtin_amdgcn_readfirstlane(tid >> 6);
    const int G = gridDim.x, bx = blockIdx.x;
    const int vcu = (G % 8 == 0) ? (bx % 8) * (G / 8) + bx / 8 : bx;
    unsigned char* ws = args.ws;
    const float* X = args.in[0]; float* OUT = args.out;
    bf16_t* W1T = (bf16_t*)(ws + WS_W1T); bf16_t* WUQT = (bf16_t*)(ws + WS_WUQT); bf16_t* WUKVT = (bf16_t*)(ws + WS_WUKVT); bf16_t* WOT = (bf16_t*)(ws + WS_WOT);
    bf16_t* WOUTT = (bf16_t*)(ws + WS_WOUTT); bf16_t* WGUT = (bf16_t*)(ws + WS_WGUT); bf16_t* WDT = (bf16_t*)(ws + WS_WDT);
    float* cosA = (float*)(ws + WS_TAB); float* sinA = cosA + SEQ * 32; float* cosB = sinA + SEQ * 32; float* sinB = cosB + SEQ * 16;
    float* SSQ_Q = (float*)(ws + WS_SSQ); float* SSQ_KV = SSQ_Q + (size_t)T * 8; float* SSQ_X1 = SSQ_KV + (size_t)T * 4; float* SSQ_X2 = SSQ_X1 + (size_t)T * 16;
    bf16_t* XN = (bf16_t*)(ws + WS_XN); bf16_t* SG = (bf16_t*)(ws + WS_SG); bf16_t* QA = (bf16_t*)(ws + WS_QA); bf16_t* KA = (bf16_t*)(ws + WS_KA); bf16_t* VA = (bf16_t*)(ws + WS_VA);
    bf16_t* QLAT = (bf16_t*)(ws + WS_QLAT); bf16_t* KVLAT = (bf16_t*)(ws + WS_KVLAT); bf16_t* QM = (bf16_t*)(ws + WS_QM); bf16_t* KM = (bf16_t*)(ws + WS_KM);
    bf16_t* VM = (bf16_t*)(ws + WS_VM); bf16_t* OB = (bf16_t*)(ws + WS_OB); bf16_t* Y = (bf16_t*)(ws + WS_Y); bf16_t* HDN = (bf16_t*)(ws + WS_HDN);
    const int lo = args.ph_lo, hi = args.ph_hi;
#ifndef PHASE_MASK
#define PHASE_MASK 0x1ff
#endif
#define IN(k) (((PHASE_MASK >> (k)) & 1) && lo <= (k) && (k) < hi)
#if MK_N_LAUNCHES == 1
    for (int u = tid; u < 32; u += NWAVES * 64) ((LAS unsigned*)(lds + MISC_OFF))[u] = 0u;
    __syncthreads();
    const XcdBarrier bar = xcd_barrier_post((unsigned*)(ws + WS_CTL), (volatile LAS unsigned*)(lds + MISC_OFF) + 8);
#define GRID_BAR() xcd_barrier(bar)
#else
#define GRID_BAR() do {} while (0)
#endif

    if (IN(0)) {
        LAS float* scr = (LAS float*)(lds + wave * 16384);
        const int gw = vcu * NWAVES + wave, NGW = G * NWAVES;
        constexpr int I_W1 = (DM / 64) * (NV1 / 32), I_UQ = (384 / 64) * (768 / 32), I_UKV = (256 / 64) * (1024 / 32), I_O = (512 / 64) * (1024 / 32), I_OUT = (DM / 64) * (DM / 32),
                      I_GU = (DM / 64) * (2 * DFF / 32), I_D = (DFF / 64) * (DM / 32);
        constexpr int NITEMS = I_W1 + I_UQ + I_UKV + 2 * I_O + I_OUT + I_GU + I_D;
        const int ln = lane & 31;
        for (int it = gw; it < NITEMS; it += NGW) {
            int r = it;
            if (r < I_W1) { const int nblk = NV1 / 32, kb = r / nblk, nb = r % nblk; tr_item(args.in[2], INW, src_w1(nb * 32 + ln), nullptr, kb * 64, W1T + (size_t)nb * 32 * DM, DM, scr, lane); continue; } r -= I_W1;
            if (r < I_UQ) { const int nblk = 768 / 32, kb = r / nblk, nb = r % nblk; tr_item(args.in[5], 768, src_uq(nb * 32 + ln), args.in[4], kb * 64, WUQT + (size_t)nb * 32 * 384, 384, scr, lane); continue; } r -= I_UQ;
            if (r < I_UKV) { const int nblk = 1024 / 32, kb = r / nblk, nb = r % nblk; tr_item(args.in[7], 1024, src_ukv(nb * 32 + ln), args.in[6], kb * 64, WUKVT + (size_t)nb * 32 * 256, 256, scr, lane); continue; } r -= I_UKV;
            if (r < I_O) { const int nblk = 1024 / 32, kb = r / nblk, nb = r % nblk; tr_item(args.in[8], DM, nb * 32 + ln, nullptr, kb * 64, WOT + (size_t)nb * 32 * 1024, 1024, scr, lane); continue; } r -= I_O;
            if (r < I_O) { const int nblk = 1024 / 32, kb = r / nblk, nb = r % nblk; tr_item(args.in[9], DM, nb * 32 + ln, nullptr, kb * 64, WOT + (size_t)nb * 32 * 1024 + 512, 1024, scr, lane); continue; } r -= I_O;
            if (r < I_OUT) { const int nblk = DM / 32, kb = r / nblk, nb = r % nblk; tr_item(args.in[10], DM, nb * 32 + ln, nullptr, kb * 64, WOUTT + (size_t)nb * 32 * DM, DM, scr, lane); continue; } r -= I_OUT;
            if (r < I_GU) { const int nblk = 2 * DFF / 32, kb = r / nblk, nb = r % nblk; const int v = nb * 32, pn = v >> 8, bj = (v >> 7) & 1, c = 128 * pn + (v & 127) + ln;
                            tr_item(bj ? args.in[13] : args.in[12], DFF, c, args.in[11], kb * 64, WGUT + (size_t)v * DM, DM, scr, lane); continue; } r -= I_GU;
            { const int nblk = DM / 32, kb = r / nblk, nb = r % nblk; tr_item(args.in[14], DM, nb * 32 + ln, nullptr, kb * 64, WDT + (size_t)nb * 32 * DFF, DFF, scr, lane); }
        }
        for (int i = (vcu * NWAVES + wave) * 64 + lane; i < SEQ * 32; i += G * NWAVES * 64) {
            { const int p = i >> 5, j = i & 31; const double a = (double)p * pow(10000.0, -(double)j / 32.0); cosA[i] = (float)cos(a); sinA[i] = (float)sin(a); }
            if (i < SEQ * 16) { const int p = i >> 4, j = i & 15; const double a = (double)p * pow(10000.0, -(double)j / 16.0); cosB[i] = (float)cos(a); sinB[i] = (float)sin(a); }
        }
        const float* g1 = args.in[1];
        f32x4 gv[4];
#pragma unroll
        for (int j = 0; j < 4; ++j) gv[j] = *(const f32x4*)(g1 + 4 * lane + 256 * j);
        for (int m = gw; m < T; m += NGW) {
            const f32x4* xr = (const f32x4*)(X + (size_t)m * DM) + lane;
            f32x4 v[4]; float s = 0.f;
#pragma unroll
            for (int j = 0; j < 4; ++j) { v[j] = xr[64 * j]; s += sumsq4(v[j]); }
            const float rs = 1.0f / sqrtf(wave_sum(s) * (1.0f / DM) + EPS);
            u32x2* o8 = (u32x2*)(XN + (size_t)m * DM) + lane;
#pragma unroll
            for (int j = 0; j < 4; ++j) o8[64 * j] = pack4(v[j] * rs * gv[j]);
        }
        if (IN(1)) GRID_BAR();
    }

    if (IN(1)) {
        pg8::Gemm g{XN, W1T, DM, DM, DM};
        pg8::SchedPlain S{{}, g}; S.o.init(T / 256, NV1 / 256, G, bx);
        EpiProj E{QA, KA, VA, QLAT, KVLAT, KM, SG, SSQ_Q, SSQ_KV, cosA, sinA, cosB, sinB};
        pg8::gemm_phase<EpiProj, pg8::SchedPlain, true, true>(lds, DM, DM, DM, S, E);
        if (IN(2)) GRID_BAR();
    }

    if (IN(2)) {
        { pg8::Gemm g{QLAT, WUQT, 384, 384, 384};
          pg8::SchedPlain S{{}, g}; S.o.init(T / 256, 3, G, bx);
          EpiUQ E{QM, SSQ_Q, cosB, sinB};
          pg8::gemm_phase<EpiUQ, pg8::SchedPlain, true, true>(lds, 384, 384, 384, S, E); }
        { pg8::Gemm g{KVLAT, WUKVT, 256, 256, 256};
          pg8::SchedPlain S{{}, g}; S.o.init(T / 256, 4, G, (G - 1) - bx);
          EpiUKV E{KM, VM, SSQ_KV};
          pg8::gemm_phase<EpiUKV, pg8::SchedPlain, true, true>(lds, 256, 256, 256, S, E); }
        if (IN(3)) GRID_BAR();
    }

    if (IN(3)) {
        const float* sinks = args.in[3];
        for (int base = vcu; base < 256; base += G) {
            const int bh = base >> 2, s = base & 3, b = bh >> 3, h = bh & 7;
            for (int i = 0; i < 4; ++i) {
                const int qb = (i == 0) ? s : (i == 1) ? 7 - s : (i == 2) ? 8 + s : 15 - s;
                const size_t row0 = (size_t)b * SEQ;
                const int q0 = qb * 256 + wave * 32;
                att::unit<96, false>(QM + (row0 + q0) * 768 + h * 96, 768, KM + row0 * 768 + h * 96, 768, VM + row0 * 512 + h * 64, 512,
                                     OB + (row0 + q0) * 512 + h * 64, 512, q0, 0, 4 * qb + 4, 4 * qb, -1e30f, 0.f, lds);
            }
        }
        for (int base = vcu; base < 256; base += G) {
            const int bk = base >> 4, b = bk >> 1, kvh = bk & 1;
            for (int i = 0; i < 4; ++i) {
                const int blk = (base & 15) + 16 * i;
                const size_t row0 = (size_t)b * SEQ;
                const int hq = 4 * kvh + (wave >> 1), q0 = 64 * blk + 32 * (wave & 1);
                const int t0 = blk >= 2 ? blk - 2 : 0;
                const float sk = sinks[hq] * LOG2E;
                att::unit<64, true>(QA + (row0 + q0) * 512 + hq * 64, 512, KA + row0 * 128 + kvh * 64, 128, VA + row0 * 128 + kvh * 64, 128,
                                    QA + (row0 + q0) * 512 + hq * 64, 512, q0, t0, blk + 1, 0, sk, 1.0f, lds);
            }
        }
        if (IN(4)) GRID_BAR();
    }

    if (IN(4)) {
        pg8::SchedPair S{{}, QA, OB, WOT, 512, 1024, 512}; S.o.init(T / 256, 4, G, bx);
        EpiGate E{SG, Y};
        pg8::gemm_phase<EpiGate, pg8::SchedPair, true, true>(lds, 512, 1024, 512, S, E);
        if (IN(5)) GRID_BAR();
    }

    if (IN(5)) {
        pg8::Gemm g{Y, WOUTT, DM, DM, DM};
        pg8::SchedPlain S{{}, g}; S.o.init(T / 256, 4, G, bx);
        EpiRes1 E{X, OUT, XN, SSQ_X1};
        pg8::gemm_phase<EpiRes1, pg8::SchedPlain, true, true>(lds, DM, DM, DM, S, E);
        if (IN(6)) GRID_BAR();
    }

    if (IN(6)) {
        pg8::Gemm g{XN, WGUT, DM, DM, DM};
        pg8::SchedPlain S{{}, g}; S.o.init(T / 256, 22, G, bx);
        EpiSwiglu E{SSQ_X1, HDN};
        pg8::gemm_phase<EpiSwiglu, pg8::SchedPlain, true, true>(lds, DM, DM, DM, S, E);
        if (IN(7)) GRID_BAR();
    }

    if (IN(7)) {
        pg8::Gemm g{HDN, WDT, DFF, DFF, DFF};
        pg8::SchedPlain S{{}, g}; S.o.init(T / 256, 4, G, bx);
        EpiRes2 E{OUT, SSQ_X2};
        pg8::gemm_phase<EpiRes2, pg8::SchedPlain, true, true>(lds, DFF, DFF, DFF, S, E);
        if (IN(8)) GRID_BAR();
    }

    if (IN(8)) {
        const int gw = vcu * NWAVES + wave, NGW = G * NWAVES;
        const float* gf = args.in[15];
        f32x4 gv[4];
#pragma unroll
        for (int j = 0; j < 4; ++j) gv[j] = *(const f32x4*)(gf + 4 * lane + 256 * j);
        for (int m = gw; m < T; m += NGW) {
            float ss = 0.f;
#pragma unroll
            for (int i = 0; i < 4; ++i) { const f32x4 s4 = *(const f32x4*)(SSQ_X2 + (size_t)m * 16 + 4 * i); ss += (s4[0] + s4[1]) + (s4[2] + s4[3]); }
            const float rs = 1.0f / sqrtf(ss * (1.0f / DM) + EPS);
            f32x4* xr = (f32x4*)(OUT + (size_t)m * DM) + lane;
#pragma unroll
            for (int j = 0; j < 4; ++j) xr[64 * j] = xr[64 * j] * rs * gv[j];
        }
    }
#undef IN
#undef GRID_BAR
}

extern "C" void kernel_launch(void* const* d_in, const int* in_sizes, int n_in, void* d_out, int out_size, void* d_ws, size_t ws_size, hipStream_t stream) {
    static int grid = 0;
    if (grid == 0) {
        if (n_in != 16 || out_size != T * DM || ws_size < WS_END) { fprintf(stderr, "kernel_launch: unexpected shapes (n_in %d out %d ws %zu, need ws >= %zu)\n", n_in, out_size, ws_size, (size_t)WS_END); grid = -1; return; }
        int dev = 0, cus = 0, per_cu = 0;
        hipGetDevice(&dev); hipDeviceGetAttribute(&cus, hipDeviceAttributeMultiprocessorCount, dev);
        if (hipFuncSetAttribute((const void*)fwd_kernel, hipFuncAttributeMaxDynamicSharedMemorySize, LDS_BYTES) != hipSuccess) { fprintf(stderr, "kernel_launch: hipFuncSetAttribute failed\n"); grid = -1; return; }
        if (hipOccupancyMaxActiveBlocksPerMultiprocessor(&per_cu, (const void*)fwd_kernel, NWAVES * 64, LDS_BYTES) != hipSuccess || per_cu < 1) { fprintf(stderr, "kernel_launch: occupancy query says %d\n", per_cu); per_cu = 1; }
        (void)hipGetLastError();
        grid = cus;
        fprintf(stderr, "kernel_launch: grid %d (cus %d, per_cu %d)\n", grid, cus, per_cu);
    }
    if (grid < 0) return;
    Args a{};
    for (int i = 0; i < 16; ++i) a.in[i] = (const float*)d_in[i];
    a.out = (float*)d_out; a.ws = (unsigned char*)d_ws;
#if MK_N_LAUNCHES == 1
    a.ph_lo = 0; a.ph_hi = 9;
    if (hipMemsetAsync((char*)d_ws + WS_CTL, 0, CTL_BYTES, stream) != hipSuccess) { fprintf(stderr, "kernel_launch: memset failed\n"); return; }
    void* kargs[] = {&a};
    hipError_t e = hipLaunchCooperativeKernel((const void*)fwd_kernel, dim3(grid), dim3(NWAVES * 64), kargs, LDS_BYTES, stream);
    if (e != hipSuccess) fprintf(stderr, "cooperative launch failed: %s (grid %d)\n", hipGetErrorString(e), grid);
#else
    for (int p = 0; p < 9; ++p) { a.ph_lo = p; a.ph_hi = p + 1; hipLaunchKernelGGL(fwd_kernel, dim3(grid), dim3(NWAVES * 64), LDS_BYTES, stream, a); }
#endif
}
```

```cpp
#include <hip/hip_runtime.h>
#include <hip/hip_cooperative_groups.h>
#include <cstdio>
#include <cstdint>
namespace cg = cooperative_groups;

#ifndef REP_P0
#define REP_P0 1
#endif
#ifndef REP_P1
#define REP_P1 1
#endif
#ifndef REP_P2
#define REP_P2 1
#endif
#ifndef REP_MLA
#define REP_MLA 1
#endif
#ifndef REP_SWA
#define REP_SWA 1
#endif
#ifndef REP_P7
#define REP_P7 1
#endif
#ifndef REP_P8
#define REP_P8 1
#endif
#ifndef REP_BAR
#define REP_BAR 1
#endif
#ifndef REP_P4
#define REP_P4 1
#endif
#ifndef REP_P5
#define REP_P5 1
#endif
#ifndef REP_P6
#define REP_P6 1
#endif
#ifndef MK_N_LAUNCHES
#define MK_N_LAUNCHES 1
#endif

#define LAS __attribute__((address_space(3)))
#define GAS __attribute__((address_space(1)))
typedef unsigned short bf16_t;
typedef short bf16x8 __attribute__((ext_vector_type(8)));
typedef short s16x4 __attribute__((ext_vector_type(4)));
typedef float f32x2 __attribute__((ext_vector_type(2)));
typedef float f32x4 __attribute__((ext_vector_type(4)));
typedef float f32x16 __attribute__((ext_vector_type(16)));
typedef unsigned u32x2 __attribute__((ext_vector_type(2)));
typedef unsigned u32x4 __attribute__((ext_vector_type(4)));
typedef __bf16 bf16x2_t __attribute__((ext_vector_type(2)));

constexpr int NB = 8, SEQ = 4096, T = NB * SEQ, DM = 1024, DFF = 2816;
constexpr int INW = 3488, NV1 = 3584;
constexpr int O_QA = 0, O_KA = 512, O_VA = 640, O_QL = 768, O_KVL = 1152, O_KR = 1408, O_GA = 1440, O_GB = 2464;
constexpr float EPS = 1e-6f;
constexpr float LOG2E = 1.4426950408889634f;
constexpr float QA_SCALE = 0.125f * LOG2E;
constexpr float QM_SCALE = 0.10206207261596577f * LOG2E;

constexpr size_t MiB = 1u << 20;
constexpr size_t WS_W1T = 0 * MiB, WS_WUQT = 7 * MiB, WS_WUKVT = 8 * MiB, WS_WOT = 9 * MiB, WS_WOUTT = 11 * MiB, WS_WGUT = 13 * MiB, WS_WDT = 24 * MiB;
constexpr size_t WS_TAB = 30 * MiB;
constexpr size_t WS_SSQ = 32 * MiB;
constexpr size_t WS_XN = 38 * MiB;
constexpr size_t WS_SG = 102 * MiB;
constexpr size_t WS_QA = 230 * MiB;
constexpr size_t WS_KA = 262 * MiB, WS_VA = 270 * MiB;
constexpr size_t WS_QLAT = 278 * MiB, WS_KVLAT = 302 * MiB;
constexpr size_t WS_QM = 318 * MiB, WS_KM = 366 * MiB;
constexpr size_t WS_VM = 414 * MiB, WS_OB = 446 * MiB;
constexpr size_t WS_CTL = 478 * MiB, CTL_BYTES = 16384;
constexpr size_t WS_OA = 479 * MiB;
constexpr size_t WS_END = 511 * MiB;
constexpr size_t WS_Y = WS_QM;
constexpr size_t WS_X2 = WS_QLAT;
constexpr size_t WS_HDN = WS_SG;
static_assert(WS_HDN + (size_t)T * DFF * 2 <= WS_QLAT && WS_Y + (size_t)T * DM * 2 <= WS_VM, "overlays");

constexpr int NWAVES = 8;
constexpr int RING_BYTES = 131072, MISC_OFF = RING_BYTES + 320, LDS_BYTES = 147456;

__device__ __forceinline__ unsigned cvtpk(float lo, float hi) { f32x2 v = {lo, hi}; bf16x2_t b = __builtin_convertvector(v, bf16x2_t); return __builtin_bit_cast(unsigned, b); }
__device__ __forceinline__ u32x4 pack8(f32x4 a, f32x4 b) { u32x4 w; w.x = cvtpk(a[0], a[1]); w.y = cvtpk(a[2], a[3]); w.z = cvtpk(b[0], b[1]); w.w = cvtpk(b[2], b[3]); return w; }
__device__ __forceinline__ u32x2 pack4(f32x4 a) { u32x2 w; w.x = cvtpk(a[0], a[1]); w.y = cvtpk(a[2], a[3]); return w; }
__device__ __forceinline__ float bf_lo(unsigned w) { return __uint_as_float(w << 16); }
__device__ __forceinline__ float bf_hi(unsigned w) { return __uint_as_float(w & 0xffff0000u); }
__device__ __forceinline__ float sigmoidf_fast(float x) { return __builtin_amdgcn_rcpf(1.0f + __builtin_amdgcn_exp2f(-x * LOG2E)); }
__device__ __forceinline__ float wave_sum(float v) {
#pragma unroll
    for (int o = 1; o < 64; o <<= 1) v += __shfl_xor(v, o);
    return v;
}
__device__ __forceinline__ float sumsq4(f32x4 a) { return (a[0] * a[0] + a[1] * a[1]) + (a[2] * a[2] + a[3] * a[3]); }

namespace pg8 {
constexpr int BM = 256, BK = 64, HALF = 128, HTB = HALF * BK * 2, STAGE_BYTES = 8 * HTB, NXCD = 8, WGM = 8;
__host__ __device__ __forceinline__ int lds_byte(int r, int c) { const int st = (r >> 4) * 2 + (c >> 5), rr = r & 15, cc = c & 31, ob = rr * 64 + cc * 2; return st * 1024 + (ob ^ (((ob >> 9) & 1) << 5)); }
__host__ __device__ __forceinline__ void stage_rc(int b, int& R, int& C) { const int st = b / 1024, sb = b % 1024, swz = sb ^ (((sb >> 9) & 1) << 5); R = (st >> 1) * 16 + swz / 64; C = (st & 1) * 32 + (swz % 64) / 2; }
__host__ __device__ __forceinline__ int perm32(int rho) { const int n = rho >> 4, i = rho & 15; return 8 * (i >> 2) + 4 * n + (i & 3); }

struct Unit { int pm, pn, part; };
struct Gemm { const bf16_t* A; const bf16_t* Bt; int lda, ldb, K; };

struct TileOrder {
    int nM, nN, nwg, G, c;
    __device__ void init(int nM_, int nN_, int G_, int c_) { nM = nM_; nN = nN_; nwg = nM * nN; G = G_; c = c_; }
    __device__ bool tile(int i, int& pm, int& pn) const {
        const long L = (long)i * G + c; if (L >= nwg) return false;
        int wgid = (int)L; { const int q = nwg / NXCD, r = nwg % NXCD, xcd = wgid % NXCD, off = wgid / NXCD; wgid = (xcd < r ? xcd * (q + 1) : r * (q + 1) + (xcd - r) * q) + off; }
        const int nig = WGM * nN, gid = wgid / nig, fm = gid * WGM, gsz = (nM - fm) < WGM ? (nM - fm) : WGM;
        pm = fm + ((wgid % nig) % gsz); pn = (wgid % nig) / gsz; return true;
    }
};
struct SchedPlain {
    TileOrder o; const Gemm g;
    __device__ bool next(int i, Unit& u) const { u.part = 0; return o.tile(i, u.pm, u.pn); }
    __device__ __forceinline__ void ptrs(const Unit& u, const char*& a, const char*& b) const { a = (const char*)g.A + (size_t)u.pm * BM * g.lda * 2; b = (const char*)g.Bt + (size_t)u.pn * BM * g.ldb * 2; }
    __device__ __forceinline__ bool keep(const Unit&) const { return false; }
};
struct SchedPair {
    TileOrder o; const bf16_t* A0; const bf16_t* A1; const bf16_t* Bt; int lda, ldb, K;
    __device__ bool next(int i, Unit& u) const { u.part = i & 1; return o.tile(i >> 1, u.pm, u.pn); }
    __device__ __forceinline__ void ptrs(const Unit& u, const char*& a, const char*& b) const { a = (const char*)(u.part ? A1 : A0) + (size_t)u.pm * BM * lda * 2; b = (const char*)Bt + (size_t)u.pn * BM * ldb * 2 + (size_t)u.part * K * 2; }
    __device__ __forceinline__ bool keep(const Unit& u) const { return u.part == 0; }
};

template <class Epi, class Sched, bool ALIGN_EPI, bool SP2>
__device__ __forceinline__ void gemm_phase(LAS unsigned char* lds, const int lda, const int ldb, const int K, const Sched& S, const Epi& E) {
    const int tid = threadIdx.x, wid = __builtin_amdgcn_readfirstlane(tid >> 6), lane = tid & 63, wr = wid >> 2, wc = wid & 3, fr = lane & 15, fq = lane >> 4;
    const int nt = K / BK;
    unsigned voffA[2], voffB[2];
#pragma unroll
    for (int i = 0; i < 2; ++i) { int R, C; stage_rc(tid * 16 + i * 8192, R, C); const int Rb = (R & ~31) + perm32(R & 31);
        voffA[i] = (unsigned)(R * lda + C) * 2u; voffB[i] = (unsigned)(Rb * ldb + C) * 2u; }
    const size_t kstep = (size_t)(BK * 2);
    const size_t hstepA = (size_t)HALF * lda * 2, hstepB = (size_t)HALF * ldb * 2;
    const unsigned ldsw = (unsigned)wid * 1024u;
    const int aoff = lds_byte(wr * 64 + fr, fq * 8), boff = lds_byte(wc * 32 + fr, fq * 8);
#define PG8_SA(b, h) (((b) * 2 + (h)) * HTB)
#define PG8_SB(b, h) ((4 + (b) * 2 + (h)) * HTB)
#define PG8_STAGE(bufoff, gbase, voff) do { _Pragma("unroll") for (int _i = 0; _i < 2; ++_i) \
        __builtin_amdgcn_global_load_lds((const unsigned*)((const char*)(gbase) + (voff)[_i]), (LAS unsigned*)(lds + (bufoff) + ldsw + _i * 8192), 16, 0, 0); } while (0)
#define PG8_LDA(dst, b, h) do { _Pragma("unroll") for (int m = 0; m < 4; ++m) _Pragma("unroll") for (int k = 0; k < 2; ++k) dst[m][k] = *(const LAS bf16x8*)(lds + PG8_SA(b, h) + aoff + m * 2048 + k * 1024); } while (0)
#define PG8_LDB(dst, b, h) do { _Pragma("unroll") for (int n = 0; n < 2; ++n) _Pragma("unroll") for (int k = 0; k < 2; ++k) dst[n][k] = *(const LAS bf16x8*)(lds + PG8_SB(b, h) + boff + n * 2048 + k * 1024); } while (0)
#define PG8_MMA(ai, bj, At, Bt) do { __builtin_amdgcn_s_setprio(1); _Pragma("unroll") for (int m = 0; m < 4; ++m) _Pragma("unroll") for (int n = 0; n < 2; ++n) _Pragma("unroll") for (int k = 0; k < 2; ++k) \
        acc[ai][bj][m][n] = __builtin_amdgcn_mfma_f32_16x16x32_bf16(Bt[n][k], At[m][k], acc[ai][bj][m][n], 0, 0, 0); __builtin_amdgcn_s_setprio(0); } while (0)
#define PG8_WAIT_V(n) asm volatile("s_waitcnt vmcnt(" #n ")" ::: "memory")
#define PG8_WAIT_L(n) asm volatile("s_waitcnt lgkmcnt(" #n ")" ::: "memory")
#define PG8_BAR __builtin_amdgcn_s_barrier()
#define PG8_SCHED __builtin_amdgcn_sched_barrier(0)
    Unit cur, nxt; int ui = 0;
    if (!S.next(0, cur)) return;
    f32x4 acc[2][2][4][2];
#pragma unroll
    for (int a = 0; a < 2; ++a)
#pragma unroll
        for (int b = 0; b < 2; ++b)
#pragma unroll
            for (int m = 0; m < 4; ++m)
#pragma unroll
                for (int n = 0; n < 2; ++n) acc[a][b][m][n] = (f32x4){0.f, 0.f, 0.f, 0.f};
    bf16x8 At[4][2], B0[2][2], B1[2][2];
    const char* cA; const char* cB; S.ptrs(cur, cA, cB);
    if constexpr (SP2) {
        PG8_STAGE(PG8_SB(0, 0), cB, voffB); PG8_STAGE(PG8_SB(0, 1), cB + hstepB, voffB); PG8_STAGE(PG8_SA(0, 0), cA, voffA); PG8_STAGE(PG8_SA(0, 1), cA + hstepA, voffA);
        if (wr == 1) PG8_BAR;
        PG8_WAIT_V(2); PG8_BAR;
        PG8_STAGE(PG8_SB(1, 0), cB + kstep, voffB); PG8_STAGE(PG8_SA(1, 0), cA + kstep, voffA); PG8_STAGE(PG8_SB(1, 1), cB + hstepB + kstep, voffB);
        PG8_WAIT_V(6); PG8_BAR;
    } else {
        PG8_STAGE(PG8_SB(0, 0), cB, voffB); PG8_STAGE(PG8_SA(0, 0), cA, voffA); PG8_STAGE(PG8_SB(0, 1), cB + hstepB, voffB); PG8_STAGE(PG8_SA(0, 1), cA + hstepA, voffA);
        if (wr == 1) PG8_BAR;
        PG8_WAIT_V(4); PG8_BAR;
        PG8_STAGE(PG8_SB(1, 0), cB + kstep, voffB); PG8_STAGE(PG8_SA(1, 0), cA + kstep, voffA); PG8_STAGE(PG8_SB(1, 1), cB + hstepB + kstep, voffB);
        PG8_WAIT_V(6); PG8_BAR;
    }
    for (;;) {
        const bool has_next = S.next(ui + 1, nxt);
        const char* nA = cA; const char* nB = cB; if (has_next) S.ptrs(nxt, nA, nB);
#pragma unroll 1
        for (int t = 0; t < nt; t += 2) {
            const bool last = (t == nt - 2);
            const char* a1 = cA + (size_t)(t + 1) * kstep;
            const char* a2 = last ? nA : cA + (size_t)(t + 2) * kstep; const char* b2 = last ? nB : cB + (size_t)(t + 2) * kstep;
            const char* a3 = a2 + kstep; const char* b3 = b2 + kstep;
            if constexpr (SP2) {
            PG8_LDB(B0, 0, 0); PG8_LDB(B1, 0, 1); PG8_SCHED; PG8_LDA(At, 0, 0); PG8_STAGE(PG8_SA(1, 1), a1 + hstepA, voffA);
            PG8_WAIT_V(8); PG8_WAIT_L(0); PG8_BAR; PG8_MMA(0, 0, At, B0); PG8_MMA(0, 1, At, B1); PG8_BAR; PG8_SCHED;
            PG8_LDA(At, 0, 1); PG8_STAGE(PG8_SB(0, 0), b2, voffB); PG8_STAGE(PG8_SB(0, 1), b2 + hstepB, voffB); PG8_STAGE(PG8_SA(0, 0), a2, voffA);
            PG8_WAIT_V(8); PG8_WAIT_L(0); PG8_BAR; PG8_MMA(1, 0, At, B0); PG8_MMA(1, 1, At, B1); PG8_BAR; PG8_SCHED;
            PG8_LDB(B0, 1, 0); PG8_LDB(B1, 1, 1); PG8_SCHED; PG8_LDA(At, 1, 0); PG8_STAGE(PG8_SA(0, 1), a2 + hstepA, voffA);
            PG8_WAIT_V(8); PG8_WAIT_L(0); PG8_BAR; PG8_MMA(0, 0, At, B0); PG8_MMA(0, 1, At, B1); PG8_BAR; PG8_SCHED;
            PG8_LDA(At, 1, 1); PG8_STAGE(PG8_SB(1, 0), b3, voffB); PG8_STAGE(PG8_SB(1, 1), b3 + hstepB, voffB); PG8_STAGE(PG8_SA(1, 0), a3, voffA);
            PG8_WAIT_V(8); PG8_WAIT_L(0); PG8_BAR; PG8_MMA(1, 0, At, B0); PG8_MMA(1, 1, At, B1); PG8_BAR; PG8_SCHED;
            } else {
            PG8_LDB(B0, 0, 0); PG8_SCHED; PG8_LDA(At, 0, 0); PG8_STAGE(PG8_SA(1, 1), a1 + hstepA, voffA);
            PG8_WAIT_L(8); PG8_BAR; PG8_WAIT_L(0); PG8_MMA(0, 0, At, B0); PG8_BAR; PG8_SCHED;
            PG8_LDB(B1, 0, 1); PG8_STAGE(PG8_SB(0, 0), b2, voffB);
            PG8_BAR; PG8_WAIT_L(0); PG8_MMA(0, 1, At, B1); PG8_BAR;
            PG8_LDA(At, 0, 1); PG8_STAGE(PG8_SA(0, 0), a2, voffA);
            PG8_BAR; PG8_WAIT_L(0); PG8_MMA(1, 0, At, B0); PG8_BAR; PG8_SCHED;
            PG8_STAGE(PG8_SB(0, 1), b2 + hstepB, voffB);
            PG8_WAIT_V(6); PG8_BAR; PG8_MMA(1, 1, At, B1); PG8_BAR;
            PG8_LDB(B0, 1, 0); PG8_SCHED; PG8_LDA(At, 1, 0); PG8_STAGE(PG8_SA(0, 1), a2 + hstepA, voffA);
            PG8_WAIT_L(8); PG8_BAR; PG8_WAIT_L(0); PG8_MMA(0, 0, At, B0); PG8_BAR; PG8_SCHED;
            PG8_LDB(B1, 1, 1); PG8_STAGE(PG8_SB(1, 0), b3, voffB);
            PG8_BAR; PG8_WAIT_L(0); PG8_MMA(0, 1, At, B1); PG8_BAR;
            PG8_LDA(At, 1, 1); PG8_STAGE(PG8_SA(1, 0), a3, voffA);
            PG8_BAR; PG8_WAIT_L(0); PG8_MMA(1, 0, At, B0); PG8_BAR; PG8_SCHED;
            PG8_STAGE(PG8_SB(1, 1), b3 + hstepB, voffB);
            PG8_WAIT_V(6); PG8_BAR; PG8_MMA(1, 1, At, B1); PG8_BAR;
            }
        }
        if constexpr (ALIGN_EPI) { if (wr == 0) PG8_BAR; }
        E(acc, cur, wr, wc, fr, fq);
        if (!has_next) break;
        if (!S.keep(cur)) {
#pragma unroll
        for (int a = 0; a < 2; ++a)
#pragma unroll
            for (int b = 0; b < 2; ++b)
#pragma unroll
                for (int m = 0; m < 4; ++m)
#pragma unroll
                    for (int n = 0; n < 2; ++n) acc[a][b][m][n] = (f32x4){0.f, 0.f, 0.f, 0.f};
        }
        cur = nxt; cA = nA; cB = nB; ++ui;
        if constexpr (ALIGN_EPI) { if (wr == 1) PG8_BAR; }
    }
    PG8_WAIT_V(0);
    if constexpr (!ALIGN_EPI) { if (wr == 0) PG8_BAR; }
    PG8_BAR;
#undef PG8_SA
#undef PG8_SB
#undef PG8_STAGE
#undef PG8_LDA
#undef PG8_LDB
#undef PG8_MMA
#undef PG8_WAIT_V
#undef PG8_WAIT_L
#undef PG8_BAR
#undef PG8_SCHED
}
}
using pg8::Unit;

struct EpiProj {
    bf16_t *QA, *KA, *VA, *QLAT, *KVLAT, *KM, *SG; float *SSQ_Q, *SSQ_KV; const float *cosA, *sinA, *cosB, *sinB;
    __device__ __forceinline__ void operator()(f32x4 (&acc)[2][2][4][2], const Unit& u, int wr, int wc, int fr, int fq) const {
        const int pn = u.pn, rbase = u.pm * 256 + wr * 64 + fr;
        if (pn <= 2) {
#pragma unroll
            for (int ai = 0; ai < 2; ++ai)
#pragma unroll
                for (int m = 0; m < 4; ++m) {
                    const int r = rbase + ai * 128 + m * 16, pos = r & (SEQ - 1);
                    const int d0 = 4 * (4 * (wc & 1) + fq);
                    const f32x4 c4 = *(const f32x4*)(cosA + pos * 32 + d0), s4 = *(const f32x4*)(sinA + pos * 32 + d0);
#pragma unroll
                    for (int bj = 0; bj < 2; ++bj) {
                        if (pn == 2 && bj == 1) { *(u32x4*)(VA + (size_t)r * 128 + 32 * wc + 8 * fq) = pack8(acc[ai][1][m][0], acc[ai][1][m][1]); }
                        else {
                            const f32x4 x1 = acc[ai][bj][m][0], x2 = acc[ai][bj][m][1];
                            f32x4 o1 = x1 * c4 - x2 * s4, o2 = x2 * c4 + x1 * s4;
                            bf16_t* dst;
                            if (pn < 2) { o1 = o1 * QA_SCALE; o2 = o2 * QA_SCALE; dst = QA + (size_t)r * 512 + (4 * pn + 2 * bj + (wc >> 1)) * 64 + d0; }
                            else dst = KA + (size_t)r * 128 + (wc >> 1) * 64 + d0;
                            *(u32x2*)dst = pack4(o1); *(u32x2*)(dst + 32) = pack4(o2);
                        }
                    }
                }
        } else if (pn <= 5) {
#pragma unroll
            for (int ai = 0; ai < 2; ++ai)
#pragma unroll
                for (int m = 0; m < 4; ++m) {
                    const int r = rbase + ai * 128 + m * 16, pos = r & (SEQ - 1);
                    float q = sumsq4(acc[ai][0][m][0]) + sumsq4(acc[ai][0][m][1]);
                    if (pn != 4) q += sumsq4(acc[ai][1][m][0]) + sumsq4(acc[ai][1][m][1]);
                    q += __shfl_xor(q, 16); q += __shfl_xor(q, 32);
                    if (pn == 3) {
                        *(u32x4*)(QLAT + (size_t)r * 384 + 32 * wc + 8 * fq) = pack8(acc[ai][0][m][0], acc[ai][0][m][1]);
                        *(u32x4*)(QLAT + (size_t)r * 384 + 128 + 32 * wc + 8 * fq) = pack8(acc[ai][1][m][0], acc[ai][1][m][1]);
                        if (fq == 0) SSQ_Q[(size_t)r * 8 + wc] = q;
                    } else if (pn == 4) {
                        *(u32x4*)(QLAT + (size_t)r * 384 + 256 + 32 * wc + 8 * fq) = pack8(acc[ai][0][m][0], acc[ai][0][m][1]);
                        if (fq == 0) SSQ_Q[(size_t)r * 8 + 4 + wc] = q;
                        if (wc == 0) {
                            const int i0 = 4 * fq;
                            const f32x4 c4 = *(const f32x4*)(cosB + pos * 16 + i0), s4 = *(const f32x4*)(sinB + pos * 16 + i0);
                            const f32x4 x1 = acc[ai][1][m][0], x2 = acc[ai][1][m][1];
                            const u32x2 w1 = pack4(x1 * c4 - x2 * s4), w2 = pack4(x2 * c4 + x1 * s4);
#pragma unroll
                            for (int h = 0; h < 8; ++h) { bf16_t* dst = KM + (size_t)r * 768 + h * 96 + 64 + i0; *(u32x2*)dst = w1; *(u32x2*)(dst + 16) = w2; }
                        }
                    } else {
                        *(u32x4*)(KVLAT + (size_t)r * 256 + 32 * wc + 8 * fq) = pack8(acc[ai][0][m][0], acc[ai][0][m][1]);
                        *(u32x4*)(KVLAT + (size_t)r * 256 + 128 + 32 * wc + 8 * fq) = pack8(acc[ai][1][m][0], acc[ai][1][m][1]);
                        if (fq == 0) SSQ_KV[(size_t)r * 4 + wc] = q;
                    }
                }
        } else {
            const int cb = (pn - 6) * 256 + 32 * wc + 8 * fq;
#pragma unroll
            for (int ai = 0; ai < 2; ++ai)
#pragma unroll
                for (int m = 0; m < 4; ++m) {
                    const int r = rbase + ai * 128 + m * 16;
#pragma unroll
                    for (int bj = 0; bj < 2; ++bj) {
                        f32x4 a = acc[ai][bj][m][0], b = acc[ai][bj][m][1];
#pragma unroll
                        for (int e = 0; e < 4; ++e) { a[e] = sigmoidf_fast(a[e]); b[e] = sigmoidf_fast(b[e]); }
                        *(u32x4*)(SG + (size_t)r * 2048 + cb + 128 * bj) = pack8(a, b);
                    }
                }
        }
    }
};

struct EpiUQ {
    bf16_t* QM; const float* SSQ_Q; const float *cosB, *sinB;
    __device__ __forceinline__ void operator()(f32x4 (&acc)[2][2][4][2], const Unit& u, int wr, int wc, int fr, int fq) const {
        const int pn = u.pn, rbase = u.pm * 256 + wr * 64 + fr;
#pragma unroll
        for (int ai = 0; ai < 2; ++ai)
#pragma unroll
            for (int m = 0; m < 4; ++m) {
                const int r = rbase + ai * 128 + m * 16, pos = r & (SEQ - 1);
                const f32x4 sa = *(const f32x4*)(SSQ_Q + (size_t)r * 8), sb = *(const f32x4*)(SSQ_Q + (size_t)r * 8 + 4);
                const float ss = ((sa[0] + sa[1]) + (sa[2] + sa[3])) + ((sb[0] + sb[1]) + (sb[2] + sb[3]));
                const float rs = __builtin_amdgcn_rsqf(ss * (1.0f / 384.0f) + EPS) * QM_SCALE;
                if (pn < 2) {
#pragma unroll
                    for (int bj = 0; bj < 2; ++bj)
                        *(u32x4*)(QM + (size_t)r * 768 + (4 * pn + 2 * bj + (wc >> 1)) * 96 + 32 * (wc & 1) + 8 * fq) = pack8(acc[ai][bj][m][0] * rs, acc[ai][bj][m][1] * rs);
                } else {
                    const int i0 = 4 * fq;
                    const f32x4 c4 = *(const f32x4*)(cosB + pos * 16 + i0), s4 = *(const f32x4*)(sinB + pos * 16 + i0);
#pragma unroll
                    for (int bj = 0; bj < 2; ++bj) {
                        const f32x4 x1 = acc[ai][bj][m][0] * rs, x2 = acc[ai][bj][m][1] * rs;
                        bf16_t* dst = QM + (size_t)r * 768 + (4 * bj + wc) * 96 + 64 + i0;
                        *(u32x2*)dst = pack4(x1 * c4 - x2 * s4); *(u32x2*)(dst + 16) = pack4(x2 * c4 + x1 * s4);
                    }
                }
                asm volatile("" ::: "memory");
            }
    }
};
struct EpiUKV {
    bf16_t *KM, *VM; const float* SSQ_KV;
    __device__ __forceinline__ void operator()(f32x4 (&acc)[2][2][4][2], const Unit& u, int wr, int wc, int fr, int fq) const {
        const int pn = u.pn, rbase = u.pm * 256 + wr * 64 + fr;
#pragma unroll
        for (int ai = 0; ai < 2; ++ai)
#pragma unroll
            for (int m = 0; m < 4; ++m) {
                const int r = rbase + ai * 128 + m * 16;
                const f32x4 sa = *(const f32x4*)(SSQ_KV + (size_t)r * 4);
                const float rs = __builtin_amdgcn_rsqf(((sa[0] + sa[1]) + (sa[2] + sa[3])) * (1.0f / 256.0f) + EPS);
#pragma unroll
                for (int bj = 0; bj < 2; ++bj) {
                    const int h = 4 * (pn & 1) + 2 * bj + (wc >> 1), d = 32 * (wc & 1) + 8 * fq;
                    bf16_t* dst = (pn < 2) ? KM + (size_t)r * 768 + h * 96 + d : VM + (size_t)r * 512 + h * 64 + d;
                    *(u32x4*)dst = pack8(acc[ai][bj][m][0] * rs, acc[ai][bj][m][1] * rs);
                }
                asm volatile("" ::: "memory");
            }
    }
};
struct EpiGate {
    const bf16_t* SG; bf16_t* Y;
    __device__ __forceinline__ void operator()(f32x4 (&acc)[2][2][4][2], const Unit& u, int wr, int wc, int fr, int fq) const {
        const int rbase = u.pm * 256 + wr * 64 + fr, cb = u.pn * 256 + 32 * wc + 8 * fq;
#pragma unroll
        for (int ai = 0; ai < 2; ++ai)
#pragma unroll
            for (int m = 0; m < 4; ++m) {
                const int r = rbase + ai * 128 + m * 16;
#pragma unroll
                for (int bj = 0; bj < 2; ++bj) {
                    const int c = cb + 128 * bj;
                    const u32x4 wb = *(const u32x4*)(SG + (size_t)r * 2048 + 1024 + c);
                    f32x4 b0 = {bf_lo(wb.x), bf_hi(wb.x), bf_lo(wb.y), bf_hi(wb.y)}, b1 = {bf_lo(wb.z), bf_hi(wb.z), bf_lo(wb.w), bf_hi(wb.w)};
                    if (u.part == 0) {
                        const u32x4 wa = *(const u32x4*)(SG + (size_t)r * 2048 + c);
                        const f32x4 a0 = {bf_lo(wa.x), bf_hi(wa.x), bf_lo(wa.y), bf_hi(wa.y)}, a1 = {bf_lo(wa.z), bf_hi(wa.z), bf_lo(wa.w), bf_hi(wa.w)};
#pragma unroll
                        for (int e = 0; e < 4; ++e) { acc[ai][bj][m][0][e] *= a0[e] * __builtin_amdgcn_rcpf(b0[e]); acc[ai][bj][m][1][e] *= a1[e] * __builtin_amdgcn_rcpf(b1[e]); }
                    } else {
                        *(u32x4*)(Y + (size_t)r * 1024 + c) = pack8(acc[ai][bj][m][0] * b0, acc[ai][bj][m][1] * b1);
                    }
                }
            }
    }
};
struct EpiRes1 {
    const float* X; float* OUT; bf16_t* X1B; float* SSQ;
    __device__ __forceinline__ void operator()(f32x4 (&acc)[2][2][4][2], const Unit& u, int wr, int wc, int fr, int fq) const {
        const int rbase = u.pm * 256 + wr * 64 + fr, cb = u.pn * 256 + 32 * wc + 8 * fq;
#pragma unroll
        for (int ai = 0; ai < 2; ++ai)
#pragma unroll
            for (int m = 0; m < 4; ++m) {
                const int r = rbase + ai * 128 + m * 16; float q = 0.f;
#pragma unroll
                for (int bj = 0; bj < 2; ++bj) {
                    const size_t o = (size_t)r * 1024 + cb + 128 * bj;
                    const f32x4 v0 = *(const f32x4*)(X + o) + acc[ai][bj][m][0], v1 = *(const f32x4*)(X + o + 4) + acc[ai][bj][m][1];
                    *(f32x4*)(OUT + o) = v0; *(f32x4*)(OUT + o + 4) = v1; *(u32x4*)(X1B + o) = pack8(v0, v1);
                    q += sumsq4(v0) + sumsq4(v1);
                }
                q += __shfl_xor(q, 16); q += __shfl_xor(q, 32);
                if (fq == 0) SSQ[(size_t)r * 16 + 4 * u.pn + wc] = q;
            }
    }
};
struct EpiSwiglu {
    const float* SSQ; bf16_t* HDN;
    __device__ __forceinline__ void operator()(f32x4 (&acc)[2][2][4][2], const Unit& u, int wr, int wc, int fr, int fq) const {
        const int rbase = u.pm * 256 + wr * 64 + fr, cb = u.pn * 128 + 32 * wc + 8 * fq;
#pragma unroll
        for (int ai = 0; ai < 2; ++ai)
#pragma unroll
            for (int m = 0; m < 4; ++m) {
                const int r = rbase + ai * 128 + m * 16;
                float ss = 0.f;
#pragma unroll
                for (int i = 0; i < 4; ++i) { const f32x4 s4 = *(const f32x4*)(SSQ + (size_t)r * 16 + 4 * i); ss += (s4[0] + s4[1]) + (s4[2] + s4[3]); }
                const float rs = __builtin_amdgcn_rsqf(ss * (1.0f / 1024.0f) + EPS);
                f32x4 h0, h1;
#pragma unroll
                for (int e = 0; e < 4; ++e) {
                    const float g0 = acc[ai][0][m][0][e] * rs, g1 = acc[ai][0][m][1][e] * rs;
                    h0[e] = g0 * sigmoidf_fast(g0) * (acc[ai][1][m][0][e] * rs); h1[e] = g1 * sigmoidf_fast(g1) * (acc[ai][1][m][1][e] * rs);
                }
                *(u32x4*)(HDN + (size_t)r * DFF + cb) = pack8(h0, h1);
            }
    }
};
struct EpiRes2 {
    const float* X1; float* OUT; float* SSQ;
    __device__ __forceinline__ void operator()(f32x4 (&acc)[2][2][4][2], const Unit& u, int wr, int wc, int fr, int fq) const {
        const int rbase = u.pm * 256 + wr * 64 + fr, cb = u.pn * 256 + 32 * wc + 8 * fq;
#pragma unroll
        for (int ai = 0; ai < 2; ++ai)
#pragma unroll
            for (int m = 0; m < 4; ++m) {
                const int r = rbase + ai * 128 + m * 16; float q = 0.f;
#pragma unroll
                for (int bj = 0; bj < 2; ++bj) {
                    const size_t o = (size_t)r * 1024 + cb + 128 * bj;
                    const f32x4 v0 = *(const f32x4*)(X1 + o) + acc[ai][bj][m][0], v1 = *(const f32x4*)(X1 + o + 4) + acc[ai][bj][m][1];
                    *(f32x4*)(OUT + o) = v0; *(f32x4*)(OUT + o + 4) = v1;
                    q += sumsq4(v0) + sumsq4(v1);
                }
                q += __shfl_xor(q, 16); q += __shfl_xor(q, 32);
                if (fq == 0) SSQ[(size_t)r * 16 + 4 * u.pn + wc] = q;
            }
    }
};

namespace att {
constexpr int KSLOT = 12288, VSLOT = 8192, NKSL = 2, NVSL = 3;
constexpr int LDS_K = 0, LDS_V = NKSL * KSLOT, LDS_WS = LDS_V + NVSL * VSLOT, LDS_OST = LDS_WS + NWAVES * 256, LDS_TOTAL = LDS_OST + NWAVES * 4096;
static_assert(LDS_TOTAL <= RING_BYTES, "attention LDS");
constexpr float THR = 6.0f;
__device__ __forceinline__ int crow(int r, int hi) { return (r & 3) + 8 * (r >> 2) + 4 * hi; }
__device__ __forceinline__ void glds16(const void* g, unsigned lds_base) {
    unsigned sv; asm volatile("s_mov_b32 %0, m0\n\ts_mov_b32 m0, %2\n\ts_nop 0\n\tglobal_load_lds_dwordx4 %1, off\n\ts_mov_b32 m0, %0" : "=&s"(sv) : "v"(g), "s"(lds_base) : "memory"); }
#define ATT_WAIT_BAR() asm volatile("s_waitcnt vmcnt(0) lgkmcnt(0)\n\ts_barrier" ::: "memory")
#define MX3(a, b, c) __builtin_fmaxf(__builtin_fmaxf((a), (b)), (c))
__device__ __forceinline__ float rowmax(const f32x16& p0, const f32x16& p1) {
    float a = MX3(p0[0], p0[1], p1[0]), b = MX3(p0[2], p0[3], p1[1]); a = MX3(a, p1[2], p1[3]);
#pragma unroll
    for (int r = 4; r < 16; r += 4) { a = MX3(a, p0[r], p0[r + 1]); b = MX3(b, p0[r + 2], p0[r + 3]); a = MX3(a, p1[r], p1[r + 1]); b = MX3(b, p1[r + 2], p1[r + 3]); }
    float m = __builtin_fmaxf(a, b); auto rr = __builtin_amdgcn_permlane32_swap(__float_as_uint(m), __float_as_uint(m), false, false);
    return __builtin_fmaxf(__uint_as_float(rr[0]), __uint_as_float(rr[1])); }
typedef short v4i16_t __attribute__((ext_vector_type(4)));
__device__ __forceinline__ s16x4 vtr(const LAS char* p) { return __builtin_bit_cast(s16x4, __builtin_amdgcn_ds_read_tr16_b64_v4i16((LAS v4i16_t*)p)); }

template <int DQK, bool SWA>
__device__ __forceinline__ void unit(const bf16_t* Qw, int qpitch, const bf16_t* Kb, int kpitch, const bf16_t* Vb, int vpitch, bf16_t* Ow, int opitch,
                                     int pos0, int t0, int t1, int band_from, float m_init, float l_init, LAS unsigned char* lds) {
    constexpr int NKS = DQK / 16, NCH = DQK / 8;
    constexpr bool FIRST_REF = !SWA;
    const int tid = threadIdx.x, lane = tid & 63, r32 = lane & 31, hi = lane >> 5; const int wid = __builtin_amdgcn_readfirstlane(tid >> 6);
    const bool late = wid >= 4;
    const unsigned lds0 = (unsigned)(uintptr_t)lds;
    LAS float* wsf = (LAS float*)(lds + LDS_WS) + wid * 64;
    const bf16_t* ksrc = Kb + (size_t)lane * kpitch + wid * 8;
    const bf16_t* vsrc = Vb + (size_t)(16 * (wid & 3) + (lane >> 2)) * vpitch + (wid >> 2) * 32 + (lane & 3) * 8;
    const unsigned kdst = lds0 + LDS_K + wid * 1024, vdst = lds0 + LDS_V + wid * 1024;
#define ATT_DMA(t, ks, vs) do { glds16(ksrc + (size_t)(t) * 64 * kpitch, (unsigned)__builtin_amdgcn_readfirstlane(kdst + (ks) * KSLOT)); \
        if (NCH > 8 && wid + 8 < NCH) glds16(ksrc + (size_t)(t) * 64 * kpitch + 64, (unsigned)__builtin_amdgcn_readfirstlane(kdst + (ks) * KSLOT + 8192)); \
        glds16(vsrc + (size_t)(t) * 64 * vpitch, (unsigned)__builtin_amdgcn_readfirstlane(vdst + (vs) * VSLOT)); } while (0)
    ATT_DMA(t0, 0, 0);
    bf16x8 qr[NKS];
#pragma unroll
    for (int d0 = 0; d0 < NKS; ++d0) qr[d0] = *(const bf16x8*)(Qw + (size_t)r32 * qpitch + d0 * 16 + hi * 8);
    float mrun = FIRST_REF ? 0.f : m_init, l_reg = (hi == 0) ? l_init : 0.f; f32x16 o[2]; o[0] = f32x16{}; o[1] = f32x16{};
    f32x16 negm;
#pragma unroll
    for (int r = 0; r < 16; ++r) negm[r] = -mrun;
    asm volatile("" : "+v"(negm));
    const int qpos = pos0 + r32;
    f32x16 p0, p1;
    const LAS char* vlane = (const LAS char*)(lds + LDS_V) + ((lane >> 4) & 1) * 32 + (lane & 3) * 8 + (4 * hi + ((lane & 15) >> 2)) * 64;
    const LAS unsigned char* klane = lds + LDS_K + hi * 1024 + r32 * 16;

#define ATT_QK(ks) do { const LAS unsigned char* kb_ = klane + (ks) * KSLOT; \
        _Pragma("unroll") for (int d0 = 0; d0 < NKS; ++d0) { \
            const bf16x8 b0 = *(const LAS bf16x8*)(kb_ + d0 * 2048), b1 = *(const LAS bf16x8*)(kb_ + d0 * 2048 + 512); \
            if (d0 == 0) { p0 = __builtin_amdgcn_mfma_f32_32x32x16_bf16(b0, qr[0], negm, 0, 0, 0); p1 = __builtin_amdgcn_mfma_f32_32x32x16_bf16(b1, qr[0], negm, 0, 0, 0); } \
            else { p0 = __builtin_amdgcn_mfma_f32_32x32x16_bf16(b0, qr[d0], p0, 0, 0, 0); p1 = __builtin_amdgcn_mfma_f32_32x32x16_bf16(b1, qr[d0], p1, 0, 0, 0); } } } while (0)
#define ATT_SMPV(tt, vs) do { \
        if (SWA || (tt) >= band_from) { const int kb0 = (tt) * 64 + 4 * hi; \
            _Pragma("unroll") for (int r = 0; r < 16; ++r) { const int kv = kb0 + (r & 3) + 8 * (r >> 2); \
                bool ok0 = kv <= qpos, ok1 = kv + 32 <= qpos; if (SWA) { ok0 = ok0 && (kv > qpos - 128); ok1 = ok1 && (kv + 32 > qpos - 128); } \
                if (!ok0) p0[r] = -__builtin_inff(); if (!ok1) p1[r] = -__builtin_inff(); } } \
        const float rm = rowmax(p0, p1); \
        const bool first_ = FIRST_REF && (tt) == t0; \
        if (first_ || __any(rm > THR)) { \
            const float dl = first_ ? rm : __builtin_fmaxf(rm, 0.f); mrun += dl; \
            _Pragma("unroll") for (int r = 0; r < 16; ++r) { p0[r] -= dl; p1[r] -= dl; } \
            _Pragma("unroll") for (int r = 0; r < 16; ++r) negm[r] = -mrun; \
            asm volatile("" : "+v"(negm)); \
            if (!first_) { const float f = __builtin_amdgcn_exp2f(-dl); l_reg *= f; if (hi == 0) wsf[r32] = f; \
                _Pragma("unroll") for (int r = 0; r < 16; ++r) { const float fr_ = wsf[crow(r, hi)]; o[0][r] *= fr_; o[1][r] *= fr_; } } } \
        float sacc = 0.f; \
        _Pragma("unroll") for (int r = 0; r < 16; ++r) { p0[r] = __builtin_amdgcn_exp2f(p0[r]); p1[r] = __builtin_amdgcn_exp2f(p1[r]); sacc += p0[r] + p1[r]; } \
        l_reg += sacc; \
        u32x4 pw[4]; \
        pw[0] = (u32x4){cvtpk(p0[0], p0[1]), cvtpk(p0[2], p0[3]), cvtpk(p0[4], p0[5]), cvtpk(p0[6], p0[7])}; \
        pw[1] = (u32x4){cvtpk(p0[8], p0[9]), cvtpk(p0[10], p0[11]), cvtpk(p0[12], p0[13]), cvtpk(p0[14], p0[15])}; \
        pw[2] = (u32x4){cvtpk(p1[0], p1[1]), cvtpk(p1[2], p1[3]), cvtpk(p1[4], p1[5]), cvtpk(p1[6], p1[7])}; \
        pw[3] = (u32x4){cvtpk(p1[8], p1[9]), cvtpk(p1[10], p1[11]), cvtpk(p1[12], p1[13]), cvtpk(p1[14], p1[15])}; \
        const LAS char* vp = vlane + (vs) * VSLOT; \
        _Pragma("unroll") for (int d0 = 0; d0 < 2; ++d0) _Pragma("unroll") for (int ks_ = 0; ks_ < 4; ++ks_) { \
            const s16x4 lo = vtr(vp + d0 * 4096 + ks_ * 1024), hh = vtr(vp + d0 * 4096 + ks_ * 1024 + 512); \
            const bf16x8 vf = (bf16x8){lo[0], lo[1], lo[2], lo[3], hh[0], hh[1], hh[2], hh[3]}; \
            o[d0] = __builtin_amdgcn_mfma_f32_32x32x16_bf16(__builtin_bit_cast(bf16x8, pw[ks_]), vf, o[d0], 0, 0, 0); } } while (0)

    ATT_WAIT_BAR();
    if (t0 + 1 < t1) ATT_DMA(t0 + 1, 1, 1);
    int ks = 0, vs = 0;
#pragma unroll 1
    for (int t = t0; t < t1; ++t) {
        const int ksn = ks ^ 1, vsn = (vs == NVSL - 1) ? 0 : vs + 1, vsnn = (vsn == NVSL - 1) ? 0 : vsn + 1;
        ATT_QK(ks);
        if (late && t + 1 < t1) { ATT_WAIT_BAR(); if (t + 2 < t1) ATT_DMA(t + 2, ks, vsnn); }
        ATT_SMPV(t, vs);
        if (!late && t + 1 < t1) { ATT_WAIT_BAR(); if (t + 2 < t1) ATT_DMA(t + 2, ks, vsnn); }
        ks = ksn; vs = vsn;
    }
    { auto rr = __builtin_amdgcn_permlane32_swap(__float_as_uint(l_reg), __float_as_uint(l_reg), false, false); l_reg = __uint_as_float(rr[0]) + __uint_as_float(rr[1]); }
    if (hi == 0) wsf[32 + r32] = l_reg;
    float rli[16];
#pragma unroll
    for (int r = 0; r < 16; ++r) rli[r] = __builtin_amdgcn_rcpf(wsf[32 + crow(r, hi)]);
    LAS bf16_t* stg = (LAS bf16_t*)(lds + LDS_OST) + wid * 2048;
#pragma unroll
    for (int r = 0; r < 16; ++r) { const int orow = crow(r, hi);
#pragma unroll
        for (int d0 = 0; d0 < 2; ++d0) stg[orow * 64 + d0 * 32 + r32] = (bf16_t)(cvtpk(o[d0][r] * rli[r], 0.f) & 0xffffu); }
    asm volatile("s_waitcnt lgkmcnt(0)" ::: "memory");
#pragma unroll
    for (int i = 0; i < 4; ++i) { const int row = i * 8 + (lane >> 3), ch = lane & 7; const u32x4 v = *(const LAS u32x4*)(stg + row * 64 + ch * 8); *(u32x4*)(Ow + (size_t)row * opitch + ch * 8) = v; }
    asm volatile("s_waitcnt lgkmcnt(0)\n\ts_barrier" ::: "memory");
#undef ATT_DMA
#undef ATT_QK
#undef ATT_SMPV
}
#undef MX3
}

#define XB_TMO      128
#define XB_XCNT(j)  (256  + 64 * (j))
#define XB_XSUB(j)  (1280 + 64 * (j))
#define XB_XGEN(j)  (2304 + 64 * (j))
#define XB_TOP      3328
#define XB_TOPGEN   3392
#define XCD_BAR_WORDS 3456
#define XB_SPIN_CAP (1u << 18)
__device__ __forceinline__ unsigned xb_ld(unsigned* p)              { return __hip_atomic_load(p, __ATOMIC_RELAXED, __HIP_MEMORY_SCOPE_AGENT); }
__device__ __forceinline__ unsigned xb_add(unsigned* p, unsigned v) { return __hip_atomic_fetch_add(p, v, __ATOMIC_RELAXED, __HIP_MEMORY_SCOPE_AGENT); }
__device__ __forceinline__ unsigned xb_xcc_id() { return (unsigned)__builtin_amdgcn_s_getreg((3 << 11) | 20) & 0xFu; }
#define XB_SPIN(cond, bar) do { unsigned _sp = 0; while (cond) { __builtin_amdgcn_s_sleep(1); \
    if ((++_sp & 255u) == 0u) { if (xb_ld(&(bar)[XB_TMO])) break; if (_sp > XB_SPIN_CAP) { atomicAdd(&(bar)[XB_TMO], 1u); break; } } } } while (0)
struct XcdBarrier { unsigned* bar; unsigned x; volatile LAS unsigned* st; };
__device__ __forceinline__ XcdBarrier xcd_barrier_post(unsigned* bar, volatile LAS unsigned* st) {
    XcdBarrier b; b.bar = bar; b.x = xb_xcc_id(); b.st = st;
    if (threadIdx.x == 0) (void)xb_add(&bar[XB_XCNT(b.x)], 1u);
    return b;
}
__device__ __forceinline__ void xcd_barrier_complete(unsigned* bar, unsigned x, unsigned& nloc, unsigned& nx) {
    const unsigned G = gridDim.x * gridDim.y * gridDim.z;
    unsigned sum, cnt, mine, sp = 0u;
    for (;;) {
        sum = 0u; cnt = 0u; mine = 0u;
#pragma unroll
        for (unsigned j = 0; j < 16; ++j) { const unsigned c = xb_ld(&bar[XB_XCNT(j)]); sum += c; cnt += (c > 0u) ? 1u : 0u; mine = (j == x) ? c : mine; }
        if (sum == G) break;
        __builtin_amdgcn_s_sleep(1);
        if ((++sp & 255u) == 0u) { if (xb_ld(&bar[XB_TMO])) break; if (sp > XB_SPIN_CAP) { atomicAdd(&bar[XB_TMO], 1u); break; } }
    }
    nloc = mine > 0u ? mine : 1u; nx = cnt > 0u ? cnt : 1u;
}
__device__ __forceinline__ void xcd_barrier(const XcdBarrier& b) {
    asm volatile("s_waitcnt vmcnt(0)" ::: "memory");
    __syncthreads();
    if (threadIdx.x == 0) {
        unsigned* bar = b.bar;
        __builtin_amdgcn_s_waitcnt(0);
        unsigned nloc = b.st[0], nx = b.st[1];
        if (nloc == 0u) { xcd_barrier_complete(bar, b.x, nloc, nx); b.st[0] = nloc; b.st[1] = nx; }
        const unsigned old = xb_add(&bar[XB_XSUB(b.x)], 1u);
        const unsigned gen = old / nloc;
        if (old + 1u == (gen + 1u) * nloc) {
            __builtin_amdgcn_fence(__ATOMIC_RELEASE, "agent");
            asm volatile("s_waitcnt vmcnt(0)" ::: "memory");
            const unsigned og = xb_add(&bar[XB_TOP], 1u);
            const unsigned tg = og / nx;
            if (og + 1u == (tg + 1u) * nx) xb_add(&bar[XB_TOPGEN], 1u);
            else XB_SPIN(xb_ld(&bar[XB_TOPGEN]) == tg, bar);
            __builtin_amdgcn_fence(__ATOMIC_ACQUIRE, "agent");
            xb_add(&bar[XB_XGEN(b.x)], 1u);
            asm volatile("s_waitcnt vmcnt(0)" ::: "memory");
        } else {
            XB_SPIN(xb_ld(&bar[XB_XGEN(b.x)]) == gen, bar);
            __builtin_amdgcn_fence(__ATOMIC_ACQUIRE, "agent");
            asm volatile("s_waitcnt vmcnt(0)" ::: "memory");
        }
    }
    __syncthreads();
}

struct Args { const float* in[16]; float* out; unsigned char* ws; int ph_lo, ph_hi; };

__device__ __forceinline__ int rope64_src(int vv) { return 4 * (vv >> 3) + (vv & 3) + 32 * ((vv >> 2) & 1); }
__device__ __forceinline__ int rope32_src(int vv) { return 4 * (vv >> 3) + (vv & 3) + 16 * ((vv >> 2) & 1); }
__device__ __forceinline__ int src_w1(int v) {
    if (v < 512) return O_QA + (v & ~63) + rope64_src(v & 63);
    if (v < 640) { const int u = v - 512; return O_KA + (u & ~63) + rope64_src(u & 63); }
    if (v < 768) return O_VA + (v - 640);
    if (v < 1152) return O_QL + (v - 768);
    if (v < 1184) return O_KR + rope32_src(v - 1152);
    if (v < 1280) return -1;
    if (v < 1536) return O_KVL + (v - 1280);
    if (v < 2560) return O_GA + (v - 1536);
    return O_GB + (v - 2560);
}
__device__ __forceinline__ int src_uq(int v) { if (v < 512) return (v >> 6) * 96 + (v & 63); const int u = v - 512; return (u >> 5) * 96 + 64 + rope32_src(u & 31); }
__device__ __forceinline__ int src_ukv(int v) { if (v < 512) return (v >> 6) * 128 + (v & 63); const int u = v - 512; return (u >> 6) * 128 + 64 + (u & 63); }

template <bool GAIN> __device__ __forceinline__ void tr_item_t(const float* W, int ldw, int sc, const float* gain, int k0, bf16_t* dst, int ldd, LAS float* scr, int lane) {
    const float msk = sc >= 0 ? 1.f : 0.f; const int scc = sc >= 0 ? sc : 0;
#pragma unroll 8
    for (int i = 0; i < 32; ++i) { const int kk = 2 * i + (lane >> 5); float v = W[(size_t)(k0 + kk) * ldw + scc] * msk; if (GAIN) v *= gain[k0 + kk]; scr[kk * 33 + (lane & 31)] = v; }
    asm volatile("s_waitcnt lgkmcnt(0)" ::: "memory");
    const int c = lane & 7;
#pragma unroll
    for (int j = 0; j < 4; ++j) { const int n = (lane >> 3) + 8 * j; const LAS float* s = scr + (8 * c) * 33 + n;
        u32x4 o; o.x = cvtpk(s[0 * 33], s[1 * 33]); o.y = cvtpk(s[2 * 33], s[3 * 33]); o.z = cvtpk(s[4 * 33], s[5 * 33]); o.w = cvtpk(s[6 * 33], s[7 * 33]);
        *(u32x4*)(dst + (size_t)n * ldd + k0 + 8 * c) = o; }
    asm volatile("s_waitcnt lgkmcnt(0)" ::: "memory");
}

__device__ __forceinline__ void tr_item(const float* W, int ldw, int sc, const float* gain, int k0, bf16_t* dst, int ldd, LAS float* scr, int lane) {
    if (gain) tr_item_t<true>(W, ldw, sc, gain, k0, dst, ldd, scr, lane); else tr_item_t<false>(W, ldw, sc, gain, k0, dst, ldd, scr, lane);
}

__global__ void __launch_bounds__(NWAVES * 64, 2) fwd_kernel(Args args) {
    extern __shared__ __attribute__((aligned(16))) unsigned char lds_raw[];
    LAS unsigned char* lds = (LAS unsigned char*)lds_raw;
    const int tid = threadIdx.x, lane = tid & 63, wave = __builtin_amdgcn_readfirstlane(tid >> 6);
    const int G = gridDim.x, bx = blockIdx.x;
    const int vcu = (G % 8 == 0) ? (bx % 8) * (G / 8) + bx / 8 : bx;
    unsigned char* ws = args.ws;
    const float* X = args.in[0]; float* OUT = args.out;
    bf16_t* W1T = (bf16_t*)(ws + WS_W1T); bf16_t* WUQT = (bf16_t*)(ws + WS_WUQT); bf16_t* WUKVT = (bf16_t*)(ws + WS_WUKVT); bf16_t* WOT = (bf16_t*)(ws + WS_WOT);
    bf16_t* WOUTT = (bf16_t*)(ws + WS_WOUTT); bf16_t* WGUT = (bf16_t*)(ws + WS_WGUT); bf16_t* WDT = (bf16_t*)(ws + WS_WDT);
    float* cosA = (float*)(ws + WS_TAB); float* sinA = cosA + SEQ * 32; float* cosB = sinA + SEQ * 32; float* sinB = cosB + SEQ * 16;
    float* SSQ_Q = (float*)(ws + WS_SSQ); float* SSQ_KV = SSQ_Q + (size_t)T * 8; float* SSQ_X1 = SSQ_KV + (size_t)T * 4; float* SSQ_X2 = SSQ_X1 + (size_t)T * 16;
    bf16_t* XN = (bf16_t*)(ws + WS_XN); bf16_t* SG = (bf16_t*)(ws + WS_SG); bf16_t* QA = (bf16_t*)(ws + WS_QA); bf16_t* KA = (bf16_t*)(ws + WS_KA); bf16_t* VA = (bf16_t*)(ws + WS_VA);
    bf16_t* QLAT = (bf16_t*)(ws + WS_QLAT); bf16_t* KVLAT = (bf16_t*)(ws + WS_KVLAT); bf16_t* QM = (bf16_t*)(ws + WS_QM); bf16_t* KM = (bf16_t*)(ws + WS_KM);
    bf16_t* VM = (bf16_t*)(ws + WS_VM); bf16_t* OB = (bf16_t*)(ws + WS_OB); bf16_t* OA = (bf16_t*)(ws + WS_OA); bf16_t* Y = (bf16_t*)(ws + WS_Y); bf16_t* HDN = (bf16_t*)(ws + WS_HDN); float* X2 = (float*)(ws + WS_X2);
    const int lo = args.ph_lo, hi = args.ph_hi;
#ifndef PHASE_MASK
#define PHASE_MASK 0x1ff
#endif
#define IN(k) (((PHASE_MASK >> (k)) & 1) && lo <= (k) && (k) < hi)
#if MK_N_LAUNCHES == 1
    for (int u = tid; u < 32; u += NWAVES * 64) ((LAS unsigned*)(lds + MISC_OFF))[u] = 0u;
    __syncthreads();
    const XcdBarrier bar = xcd_barrier_post((unsigned*)(ws + WS_CTL), (volatile LAS unsigned*)(lds + MISC_OFF) + 8);
#define GRID_BAR() do { for (int rb_ = 0; rb_ < REP_BAR; ++rb_) xcd_barrier(bar); } while (0)
#else
#define GRID_BAR() do {} while (0)
#endif

    if (IN(0)) {
      for (int rep_ = 0; rep_ < REP_P0; ++rep_) {
        LAS float* scr = (LAS float*)(lds + wave * 16384);
        const int gw = vcu * NWAVES + wave, NGW = G * NWAVES;
        constexpr int I_W1 = (DM / 64) * (NV1 / 32), I_UQ = (384 / 64) * (768 / 32), I_UKV = (256 / 64) * (1024 / 32), I_O = (512 / 64) * (1024 / 32), I_OUT = (DM / 64) * (DM / 32),
                      I_GU = (DM / 64) * (2 * DFF / 32), I_D = (DFF / 64) * (DM / 32);
        constexpr int NITEMS = I_W1 + I_UQ + I_UKV + 2 * I_O + I_OUT + I_GU + I_D;
        const int ln = lane & 31;
        for (int it = gw; it < NITEMS; it += NGW) {
            int r = it;
            if (r < I_W1) { const int nblk = NV1 / 32, kb = r / nblk, nb = r % nblk; tr_item(args.in[2], INW, src_w1(nb * 32 + ln), nullptr, kb * 64, W1T + (size_t)nb * 32 * DM, DM, scr, lane); continue; } r -= I_W1;
            if (r < I_UQ) { const int nblk = 768 / 32, kb = r / nblk, nb = r % nblk; tr_item(args.in[5], 768, src_uq(nb * 32 + ln), args.in[4], kb * 64, WUQT + (size_t)nb * 32 * 384, 384, scr, lane); continue; } r -= I_UQ;
            if (r < I_UKV) { const int nblk = 1024 / 32, kb = r / nblk, nb = r % nblk; tr_item(args.in[7], 1024, src_ukv(nb * 32 + ln), args.in[6], kb * 64, WUKVT + (size_t)nb * 32 * 256, 256, scr, lane); continue; } r -= I_UKV;
            if (r < I_O) { const int nblk = 1024 / 32, kb = r / nblk, nb = r % nblk; tr_item(args.in[8], DM, nb * 32 + ln, nullptr, kb * 64, WOT + (size_t)nb * 32 * 1024, 1024, scr, lane); continue; } r -= I_O;
            if (r < I_O) { const int nblk = 1024 / 32, kb = r / nblk, nb = r % nblk; tr_item(args.in[9], DM, nb * 32 + ln, nullptr, kb * 64, WOT + (size_t)nb * 32 * 1024 + 512, 1024, scr, lane); continue; } r -= I_O;
            if (r < I_OUT) { const int nblk = DM / 32, kb = r / nblk, nb = r % nblk; tr_item(args.in[10], DM, nb * 32 + ln, nullptr, kb * 64, WOUTT + (size_t)nb * 32 * DM, DM, scr, lane); continue; } r -= I_OUT;
            if (r < I_GU) { const int nblk = 2 * DFF / 32, kb = r / nblk, nb = r % nblk; const int v = nb * 32, pn = v >> 8, bj = (v >> 7) & 1, c = 128 * pn + (v & 127) + ln;
                            tr_item(bj ? args.in[13] : args.in[12], DFF, c, args.in[11], kb * 64, WGUT + (size_t)v * DM, DM, scr, lane); continue; } r -= I_GU;
            { const int nblk = DM / 32, kb = r / nblk, nb = r % nblk; tr_item(args.in[14], DM, nb * 32 + ln, nullptr, kb * 64, WDT + (size_t)nb * 32 * DFF, DFF, scr, lane); }
        }
        for (int i = (vcu * NWAVES + wave) * 64 + lane; i < SEQ * 32; i += G * NWAVES * 64) {
            { const int p = i >> 5, j = i & 31; const double a = (double)p * pow(10000.0, -(double)j / 32.0); cosA[i] = (float)cos(a); sinA[i] = (float)sin(a); }
            if (i < SEQ * 16) { const int p = i >> 4, j = i & 15; const double a = (double)p * pow(10000.0, -(double)j / 16.0); cosB[i] = (float)cos(a); sinB[i] = (float)sin(a); }
        }
        const float* g1 = args.in[1];
        f32x4 gv[4];
#pragma unroll
        for (int j = 0; j < 4; ++j) gv[j] = *(const f32x4*)(g1 + 4 * lane + 256 * j);
        for (int m = gw; m < T; m += NGW) {
            const f32x4* xr = (const f32x4*)(X + (size_t)m * DM) + lane;
            f32x4 v[4]; float s = 0.f;
#pragma unroll
            for (int j = 0; j < 4; ++j) { v[j] = xr[64 * j]; s += sumsq4(v[j]); }
            const float rs = 1.0f / sqrtf(wave_sum(s) * (1.0f / DM) + EPS);
            u32x2* o8 = (u32x2*)(XN + (size_t)m * DM) + lane;
#pragma unroll
            for (int j = 0; j < 4; ++j) o8[64 * j] = pack4(v[j] * rs * gv[j]);
        }
      }
        if (IN(1)) GRID_BAR();
    }

    if (IN(1)) {
        pg8::Gemm g{XN, W1T, DM, DM, DM};
        pg8::SchedPlain S{{}, g}; S.o.init(T / 256, NV1 / 256, G, bx);
        EpiProj E{QA, KA, VA, QLAT, KVLAT, KM, SG, SSQ_Q, SSQ_KV, cosA, sinA, cosB, sinB};
        pg8::gemm_phase<EpiProj, pg8::SchedPlain, true, true>(lds, DM, DM, DM, S, E);
        if (REP_P1 > 1) pg8::gemm_phase<EpiProj, pg8::SchedPlain, true, true>(lds, DM, DM, DM, S, E);
        if (IN(2)) GRID_BAR();
    }

    if (IN(2)) {
        { pg8::Gemm g{QLAT, WUQT, 384, 384, 384};
          pg8::SchedPlain S{{}, g}; S.o.init(T / 256, 3, G, bx);
          EpiUQ E{QM, SSQ_Q, cosB, sinB};
          pg8::gemm_phase<EpiUQ, pg8::SchedPlain, true, true>(lds, 384, 384, 384, S, E);
          if (REP_P2 > 1) pg8::gemm_phase<EpiUQ, pg8::SchedPlain, true, true>(lds, 384, 384, 384, S, E); }
        { pg8::Gemm g{KVLAT, WUKVT, 256, 256, 256};
          pg8::SchedPlain S{{}, g}; S.o.init(T / 256, 4, G, (G - 1) - bx);
          EpiUKV E{KM, VM, SSQ_KV};
          pg8::gemm_phase<EpiUKV, pg8::SchedPlain, true, true>(lds, 256, 256, 256, S, E);
          if (REP_P2 > 1) pg8::gemm_phase<EpiUKV, pg8::SchedPlain, true, true>(lds, 256, 256, 256, S, E); }
        if (IN(3)) GRID_BAR();
    }

    if (IN(3)) {
        const float* sinks = args.in[3];
        for (int rep_ = 0; rep_ < REP_MLA; ++rep_)
        for (int base = vcu; base < 256; base += G) {
            const int bh = base >> 2, s = base & 3, b = bh >> 3, h = bh & 7;
            for (int i = 0; i < 4; ++i) {
                const int qb = (i == 0) ? s : (i == 1) ? 7 - s : (i == 2) ? 8 + s : 15 - s;
                const size_t row0 = (size_t)b * SEQ;
                const int q0 = qb * 256 + wave * 32;
                att::unit<96, false>(QM + (row0 + q0) * 768 + h * 96, 768, KM + row0 * 768 + h * 96, 768, VM + row0 * 512 + h * 64, 512,
                                     OB + (row0 + q0) * 512 + h * 64, 512, q0, 0, 4 * qb + 4, 4 * qb, -1e30f, 0.f, lds);
            }
        }
        for (int rep_ = 0; rep_ < REP_SWA; ++rep_)
        for (int base = vcu; base < 256; base += G) {
            const int bk = base >> 4, b = bk >> 1, kvh = bk & 1;
            for (int i = 0; i < 4; ++i) {
                const int blk = (base & 15) + 16 * i;
                const size_t row0 = (size_t)b * SEQ;
                const int hq = 4 * kvh + (wave >> 1), q0 = 64 * blk + 32 * (wave & 1);
                const int t0 = blk >= 2 ? blk - 2 : 0;
                const float sk = sinks[hq] * LOG2E;
                att::unit<64, true>(QA + (row0 + q0) * 512 + hq * 64, 512, KA + row0 * 128 + kvh * 64, 128, VA + row0 * 128 + kvh * 64, 128,
                                    OA + (row0 + q0) * 512 + hq * 64, 512, q0, t0, blk + 1, 0, sk, 1.0f, lds);
            }
        }
        if (IN(4)) GRID_BAR();
    }

    if (IN(4)) {
        pg8::SchedPair S{{}, OA, OB, WOT, 512, 1024, 512}; S.o.init(T / 256, 4, G, bx);
        EpiGate E{SG, Y};
        for (int rep_ = 0; rep_ < REP_P4; ++rep_) pg8::gemm_phase<EpiGate, pg8::SchedPair, true, true>(lds, 512, 1024, 512, S, E);
        if (IN(5)) GRID_BAR();
    }

    if (IN(5)) {
        pg8::Gemm g{Y, WOUTT, DM, DM, DM};
        pg8::SchedPlain S{{}, g}; S.o.init(T / 256, 4, G, bx);
        EpiRes1 E{X, OUT, XN, SSQ_X1};
        for (int rep_ = 0; rep_ < REP_P5; ++rep_) pg8::gemm_phase<EpiRes1, pg8::SchedPlain, true, true>(lds, DM, DM, DM, S, E);
        if (IN(6)) GRID_BAR();
    }

    if (IN(6)) {
        pg8::Gemm g{XN, WGUT, DM, DM, DM};
        pg8::SchedPlain S{{}, g}; S.o.init(T / 256, 22, G, bx);
        EpiSwiglu E{SSQ_X1, HDN};
        for (int rep_ = 0; rep_ < REP_P6; ++rep_) pg8::gemm_phase<EpiSwiglu, pg8::SchedPlain, true, true>(lds, DM, DM, DM, S, E);
        if (IN(7)) GRID_BAR();
    }

    if (IN(7)) {
        pg8::Gemm g{HDN, WDT, DFF, DFF, DFF};
        pg8::SchedPlain S{{}, g}; S.o.init(T / 256, 4, G, bx);
        EpiRes2 E{OUT, X2, SSQ_X2};
        pg8::gemm_phase<EpiRes2, pg8::SchedPlain, true, true>(lds, DFF, DFF, DFF, S, E);
        if (REP_P7 > 1) pg8::gemm_phase<EpiRes2, pg8::SchedPlain, true, true>(lds, DFF, DFF, DFF, S, E);
        if (IN(8)) GRID_BAR();
    }

    if (IN(8)) {
        const int gw = vcu * NWAVES + wave, NGW = G * NWAVES;
        const float* gf = args.in[15];
        f32x4 gv[4];
#pragma unroll
        for (int j = 0; j < 4; ++j) gv[j] = *(const f32x4*)(gf + 4 * lane + 256 * j);
        for (int rep_ = 0; rep_ < REP_P8; ++rep_)
        for (int m = gw; m < T; m += NGW) {
            float ss = 0.f;
#pragma unroll
            for (int i = 0; i < 4; ++i) { const f32x4 s4 = *(const f32x4*)(SSQ_X2 + (size_t)m * 16 + 4 * i); ss += (s4[0] + s4[1]) + (s4[2] + s4[3]); }
            const float rs = 1.0f / sqrtf(ss * (1.0f / DM) + EPS);
            const f32x4* xr = (const f32x4*)(X2 + (size_t)m * DM) + lane; f32x4* orow = (f32x4*)(OUT + (size_t)m * DM) + lane;
#pragma unroll
            for (int j = 0; j < 4; ++j) orow[64 * j] = xr[64 * j] * rs * gv[j];
        }
    }
#undef IN
#undef GRID_BAR
}

extern "C" void kernel_launch(void* const* d_in, const int* in_sizes, int n_in, void* d_out, int out_size, void* d_ws, size_t ws_size, hipStream_t stream) {
    static int grid = 0;
    if (grid == 0) {
        if (n_in != 16 || out_size != T * DM || ws_size < WS_END) { fprintf(stderr, "kernel_launch: unexpected shapes (n_in %d out %d ws %zu, need ws >= %zu)\n", n_in, out_size, ws_size, (size_t)WS_END); grid = -1; return; }
        int dev = 0, cus = 0, per_cu = 0;
        hipGetDevice(&dev); hipDeviceGetAttribute(&cus, hipDeviceAttributeMultiprocessorCount, dev);
        if (hipFuncSetAttribute((const void*)fwd_kernel, hipFuncAttributeMaxDynamicSharedMemorySize, LDS_BYTES) != hipSuccess) { fprintf(stderr, "kernel_launch: hipFuncSetAttribute failed\n"); grid = -1; return; }
        if (hipOccupancyMaxActiveBlocksPerMultiprocessor(&per_cu, (const void*)fwd_kernel, NWAVES * 64, LDS_BYTES) != hipSuccess || per_cu < 1) { fprintf(stderr, "kernel_launch: occupancy query says %d\n", per_cu); per_cu = 1; }
        (void)hipGetLastError();
        grid = cus;
        fprintf(stderr, "kernel_launch: grid %d (cus %d, per_cu %d)\n", grid, cus, per_cu);
    }
    if (grid < 0) return;
    Args a{};
    for (int i = 0; i < 16; ++i) a.in[i] = (const float*)d_in[i];
    a.out = (float*)d_out; a.ws = (unsigned char*)d_ws;
#if MK_N_LAUNCHES == 1
    a.ph_lo = 0; a.ph_hi = 9;
    if (hipMemsetAsync((char*)d_ws + WS_CTL, 0, CTL_BYTES, stream) != hipSuccess) { fprintf(stderr, "kernel_launch: memset failed\n"); return; }
    void* kargs[] = {&a};
    hipError_t e = hipLaunchCooperativeKernel((const void*)fwd_kernel, dim3(grid), dim3(NWAVES * 64), kargs, LDS_BYTES, stream);
    if (e != hipSuccess) fprintf(stderr, "cooperative launch failed: %s (grid %d)\n", hipGetErrorString(e), grid);
#else
    for (int p = 0; p < 9; ++p) { a.ph_lo = p; a.ph_hi = p + 1; hipLaunchKernelGGL(fwd_kernel, dim3(grid), dim3(NWAVES * 64), LDS_BYTES, stream, a); }
#endif
}
```

```cpp
#include <hip/hip_runtime.h>
#include <hip/hip_cooperative_groups.h>
#include <cstdio>
#include <cstdint>
namespace cg = cooperative_groups;

#ifndef REP_P0
#define REP_P0 1
#endif
#ifndef REP_P1
#define REP_P1 1
#endif
#ifndef REP_P2
#define REP_P2 1
#endif
#ifndef REP_MLA
#define REP_MLA 1
#endif
#ifndef REP_SWA
#define REP_SWA 1
#endif
#ifndef REP_P7
#define REP_P7 1
#endif
#ifndef REP_P8
#define REP_P8 1
#endif
#ifndef REP_BAR
#define REP_BAR 1
#endif
#ifndef REP_P4
#define REP_P4 1
#endif
#ifndef REP_P5
#define REP_P5 1
#endif
#ifndef REP_P6
#define REP_P6 1
#endif
#ifndef MK_N_LAUNCHES
#define MK_N_LAUNCHES 1
#endif

#define LAS __attribute__((address_space(3)))
#define GAS __attribute__((address_space(1)))
typedef unsigned short bf16_t;
typedef short bf16x8 __attribute__((ext_vector_type(8)));
typedef short s16x4 __attribute__((ext_vector_type(4)));
typedef float f32x2 __attribute__((ext_vector_type(2)));
typedef float f32x4 __attribute__((ext_vector_type(4)));
typedef float f32x16 __attribute__((ext_vector_type(16)));
typedef unsigned u32x2 __attribute__((ext_vector_type(2)));
typedef unsigned u32x4 __attribute__((ext_vector_type(4)));
typedef __bf16 bf16x2_t __attribute__((ext_vector_type(2)));

constexpr int NB = 8, SEQ = 4096, T = NB * SEQ, DM = 1024, DFF = 2816;
constexpr int INW = 3488, NV1 = 3584;
constexpr int O_QA = 0, O_KA = 512, O_VA = 640, O_QL = 768, O_KVL = 1152, O_KR = 1408, O_GA = 1440, O_GB = 2464;
constexpr float EPS = 1e-6f;
constexpr float LOG2E = 1.4426950408889634f;
constexpr float QA_SCALE = 0.125f * LOG2E;
constexpr float QM_SCALE = 0.10206207261596577f * LOG2E;

constexpr size_t MiB = 1u << 20;
constexpr size_t WS_W1T = 0 * MiB, WS_WUQT = 7 * MiB, WS_WUKVT = 8 * MiB, WS_WOT = 9 * MiB, WS_WOUTT = 11 * MiB, WS_WGUT = 13 * MiB, WS_WDT = 24 * MiB;
constexpr size_t WS_TAB = 30 * MiB;
constexpr size_t WS_SSQ = 32 * MiB;
constexpr size_t WS_XN = 38 * MiB;
constexpr size_t WS_SG = 102 * MiB;
constexpr size_t WS_QA = 230 * MiB;
constexpr size_t WS_KA = 262 * MiB, WS_VA = 270 * MiB;
constexpr size_t WS_QLAT = 278 * MiB, WS_KVLAT = 302 * MiB;
constexpr size_t WS_QM = 318 * MiB, WS_KM = 366 * MiB;
constexpr size_t WS_VM = 414 * MiB, WS_OB = 446 * MiB;
constexpr size_t WS_CTL = 478 * MiB, CTL_BYTES = 16384;
constexpr size_t WS_OA = 479 * MiB;
constexpr size_t WS_END = 511 * MiB;
constexpr size_t WS_Y = WS_QM;
constexpr size_t WS_X2 = WS_QLAT;
constexpr size_t WS_HDN = WS_SG;
static_assert(WS_HDN + (size_t)T * DFF * 2 <= WS_QLAT && WS_Y + (size_t)T * DM * 2 <= WS_VM, "overlays");

constexpr int NWAVES = 8;
constexpr int RING_BYTES = 131072, MISC_OFF = RING_BYTES + 320, LDS_BYTES = 147456;

__device__ __forceinline__ unsigned cvtpk(float lo, float hi) { f32x2 v = {lo, hi}; bf16x2_t b = __builtin_convertvector(v, bf16x2_t); return __builtin_bit_cast(unsigned, b); }
__device__ __forceinline__ u32x4 pack8(f32x4 a, f32x4 b) { u32x4 w; w.x = cvtpk(a[0], a[1]); w.y = cvtpk(a[2], a[3]); w.z = cvtpk(b[0], b[1]); w.w = cvtpk(b[2], b[3]); return w; }
__device__ __forceinline__ u32x2 pack4(f32x4 a) { u32x2 w; w.x = cvtpk(a[0], a[1]); w.y = cvtpk(a[2], a[3]); return w; }
__device__ __forceinline__ float bf_lo(unsigned w) { return __uint_as_float(w << 16); }
__device__ __forceinline__ float bf_hi(unsigned w) { return __uint_as_float(w & 0xffff0000u); }
__device__ __forceinline__ float sigmoidf_fast(float x) { return __builtin_amdgcn_rcpf(1.0f + __builtin_amdgcn_exp2f(-x * LOG2E)); }
__device__ __forceinline__ float wave_sum(float v) {
#pragma unroll
    for (int o = 1; o < 64; o <<= 1) v += __shfl_xor(v, o);
    return v;
}
__device__ __forceinline__ float sumsq4(f32x4 a) { return (a[0] * a[0] + a[1] * a[1]) + (a[2] * a[2] + a[3] * a[3]); }

namespace pg8 {
constexpr int BM = 256, BK = 64, HALF = 128, HTB = HALF * BK * 2, STAGE_BYTES = 8 * HTB, NXCD = 8, WGM = 8;
__host__ __device__ __forceinline__ int lds_byte(int r, int c) { const int st = (r >> 4) * 2 + (c >> 5), rr = r & 15, cc = c & 31, ob = rr * 64 + cc * 2; return st * 1024 + (ob ^ (((ob >> 9) & 1) << 5)); }
__host__ __device__ __forceinline__ void stage_rc(int b, int& R, int& C) { const int st = b / 1024, sb = b % 1024, swz = sb ^ (((sb >> 9) & 1) << 5); R = (st >> 1) * 16 + swz / 64; C = (st & 1) * 32 + (swz % 64) / 2; }
__host__ __device__ __forceinline__ int perm32(int rho) { const int n = rho >> 4, i = rho & 15; return 8 * (i >> 2) + 4 * n + (i & 3); }

struct Unit { int pm, pn, part; };
struct Gemm { const bf16_t* A; const bf16_t* Bt; int lda, ldb, K; };

struct TileOrder {
    int nM, nN, nwg, G, c;
    __device__ void init(int nM_, int nN_, int G_, int c_) { nM = nM_; nN = nN_; nwg = nM * nN; G = G_; c = c_; }
    __device__ bool tile(int i, int& pm, int& pn) const {
        const long L = (long)i * G + c; if (L >= nwg) return false;
        int wgid = (int)L; { const int q = nwg / NXCD, r = nwg % NXCD, xcd = wgid % NXCD, off = wgid / NXCD; wgid = (xcd < r ? xcd * (q + 1) : r * (q + 1) + (xcd - r) * q) + off; }
        const int nig = WGM * nN, gid = wgid / nig, fm = gid * WGM, gsz = (nM - fm) < WGM ? (nM - fm) : WGM;
        pm = fm + ((wgid % nig) % gsz); pn = (wgid % nig) / gsz; return true;
    }
};
struct SchedPlain {
    TileOrder o; const Gemm g;
    __device__ bool next(int i, Unit& u) const { u.part = 0; return o.tile(i, u.pm, u.pn); }
    __device__ __forceinline__ void ptrs(const Unit& u, const char*& a, const char*& b) const { a = (const char*)g.A + (size_t)u.pm * BM * g.lda * 2; b = (const char*)g.Bt + (size_t)u.pn * BM * g.ldb * 2; }
    __device__ __forceinline__ bool keep(const Unit&) const { return false; }
};
struct SchedPair {
    TileOrder o; const bf16_t* A0; const bf16_t* A1; const bf16_t* Bt; int lda, ldb, K;
    __device__ bool next(int i, Unit& u) const { u.part = i & 1; return o.tile(i >> 1, u.pm, u.pn); }
    __device__ __forceinline__ void ptrs(const Unit& u, const char*& a, const char*& b) const { a = (const char*)(u.part ? A1 : A0) + (size_t)u.pm * BM * lda * 2; b = (const char*)Bt + (size_t)u.pn * BM * ldb * 2 + (size_t)u.part * K * 2; }
    __device__ __forceinline__ bool keep(const Unit& u) const { return u.part == 0; }
};

template <class Epi, class Sched, bool ALIGN_EPI, bool SP2>
__device__ __forceinline__ void gemm_phase(LAS unsigned char* lds, const int lda, const int ldb, const int K, const Sched& S, const Epi& E) {
    const int tid = threadIdx.x, wid = __builtin_amdgcn_readfirstlane(tid >> 6), lane = tid & 63, wr = wid >> 2, wc = wid & 3, fr = lane & 15, fq = lane >> 4;
    const int nt = K / BK;
    unsigned voffA[2], voffB[2];
#pragma unroll
    for (int i = 0; i < 2; ++i) { int R, C; stage_rc(tid * 16 + i * 8192, R, C); const int Rb = (R & ~31) + perm32(R & 31);
        voffA[i] = (unsigned)(R * lda + C) * 2u; voffB[i] = (unsigned)(Rb * ldb + C) * 2u; }
    const size_t kstep = (size_t)(BK * 2);
    const size_t hstepA = (size_t)HALF * lda * 2, hstepB = (size_t)HALF * ldb * 2;
    const unsigned ldsw = (unsigned)wid * 1024u;
    const int aoff = lds_byte(wr * 64 + fr, fq * 8), boff = lds_byte(wc * 32 + fr, fq * 8);
#define PG8_SA(b, h) (((b) * 2 + (h)) * HTB)
#define PG8_SB(b, h) ((4 + (b) * 2 + (h)) * HTB)
#define PG8_STAGE(bufoff, gbase, voff) do { _Pragma("unroll") for (int _i = 0; _i < 2; ++_i) \
        __builtin_amdgcn_global_load_lds((const unsigned*)((const char*)(gbase) + (voff)[_i]), (LAS unsigned*)(lds + (bufoff) + ldsw + _i * 8192), 16, 0, 0); } while (0)
#define PG8_LDA(dst, b, h) do { _Pragma("unroll") for (int m = 0; m < 4; ++m) _Pragma("unroll") for (int k = 0; k < 2; ++k) dst[m][k] = *(const LAS bf16x8*)(lds + PG8_SA(b, h) + aoff + m * 2048 + k * 1024); } while (0)
#define PG8_LDB(dst, b, h) do { _Pragma("unroll") for (int n = 0; n < 2; ++n) _Pragma("unroll") for (int k = 0; k < 2; ++k) dst[n][k] = *(const LAS bf16x8*)(lds + PG8_SB(b, h) + boff + n * 2048 + k * 1024); } while (0)
#define PG8_MMA(ai, bj, At, Bt) do { __builtin_amdgcn_s_setprio(1); _Pragma("unroll") for (int m = 0; m < 4; ++m) _Pragma("unroll") for (int n = 0; n < 2; ++n) _Pragma("unroll") for (int k = 0; k < 2; ++k) \
        acc[ai][bj][m][n] = __builtin_amdgcn_mfma_f32_16x16x32_bf16(Bt[n][k], At[m][k], acc[ai][bj][m][n], 0, 0, 0); __builtin_amdgcn_s_setprio(0); } while (0)
#define PG8_WAIT_V(n) asm volatile("s_waitcnt vmcnt(" #n ")" ::: "memory")
#define PG8_WAIT_L(n) asm volatile("s_waitcnt lgkmcnt(" #n ")" ::: "memory")
#define PG8_BAR __builtin_amdgcn_s_barrier()
#define PG8_SCHED __builtin_amdgcn_sched_barrier(0)
    Unit cur, nxt; int ui = 0;
    if (!S.next(0, cur)) return;
    f32x4 acc[2][2][4][2];
#pragma unroll
    for (int a = 0; a < 2; ++a)
#pragma unroll
        for (int b = 0; b < 2; ++b)
#pragma unroll
            for (int m = 0; m < 4; ++m)
#pragma unroll
                for (int n = 0; n < 2; ++n) acc[a][b][m][n] = (f32x4){0.f, 0.f, 0.f, 0.f};
    bf16x8 At[4][2], B0[2][2], B1[2][2];
    const char* cA; const char* cB; S.ptrs(cur, cA, cB);
    if constexpr (SP2) {
        PG8_STAGE(PG8_SB(0, 0), cB, voffB); PG8_STAGE(PG8_SB(0, 1), cB + hstepB, voffB); PG8_STAGE(PG8_SA(0, 0), cA, voffA); PG8_STAGE(PG8_SA(0, 1), cA + hstepA, voffA);
        if (wr == 1) PG8_BAR;
        PG8_WAIT_V(2); PG8_BAR;
        PG8_STAGE(PG8_SB(1, 0), cB + kstep, voffB); PG8_STAGE(PG8_SA(1, 0), cA + kstep, voffA); PG8_STAGE(PG8_SB(1, 1), cB + hstepB + kstep, voffB);
        PG8_WAIT_V(6); PG8_BAR;
    } else {
        PG8_STAGE(PG8_SB(0, 0), cB, voffB); PG8_STAGE(PG8_SA(0, 0), cA, voffA); PG8_STAGE(PG8_SB(0, 1), cB + hstepB, voffB); PG8_STAGE(PG8_SA(0, 1), cA + hstepA, voffA);
        if (wr == 1) PG8_BAR;
        PG8_WAIT_V(4); PG8_BAR;
        PG8_STAGE(PG8_SB(1, 0), cB + kstep, voffB); PG8_STAGE(PG8_SA(1, 0), cA + kstep, voffA); PG8_STAGE(PG8_SB(1, 1), cB + hstepB + kstep, voffB);
        PG8_WAIT_V(6); PG8_BAR;
    }
    for (;;) {
        const bool has_next = S.next(ui + 1, nxt);
        const char* nA = cA; const char* nB = cB; if (has_next) S.ptrs(nxt, nA, nB);
#pragma unroll 1
        for (int t = 0; t < nt; t += 2) {
            const bool last = (t == nt - 2);
            const char* a1 = cA + (size_t)(t + 1) * kstep;
            const char* a2 = last ? nA : cA + (size_t)(t + 2) * kstep; const char* b2 = last ? nB : cB + (size_t)(t + 2) * kstep;
            const char* a3 = a2 + kstep; const char* b3 = b2 + kstep;
            if constexpr (SP2) {
            PG8_LDB(B0, 0, 0); PG8_LDB(B1, 0, 1); PG8_SCHED; PG8_LDA(At, 0, 0); PG8_STAGE(PG8_SA(1, 1), a1 + hstepA, voffA);
            PG8_WAIT_V(8); PG8_WAIT_L(0); PG8_BAR; PG8_MMA(0, 0, At, B0); PG8_MMA(0, 1, At, B1); PG8_BAR; PG8_SCHED;
            PG8_LDA(At, 0, 1); PG8_STAGE(PG8_SB(0, 0), b2, voffB); PG8_STAGE(PG8_SB(0, 1), b2 + hstepB, voffB); PG8_STAGE(PG8_SA(0, 0), a2, voffA);
            PG8_WAIT_V(8); PG8_WAIT_L(0); PG8_BAR; PG8_MMA(1, 0, At, B0); PG8_MMA(1, 1, At, B1); PG8_BAR; PG8_SCHED;
            PG8_LDB(B0, 1, 0); PG8_LDB(B1, 1, 1); PG8_SCHED; PG8_LDA(At, 1, 0); PG8_STAGE(PG8_SA(0, 1), a2 + hstepA, voffA);
            PG8_WAIT_V(8); PG8_WAIT_L(0); PG8_BAR; PG8_MMA(0, 0, At, B0); PG8_MMA(0, 1, At, B1); PG8_BAR; PG8_SCHED;
            PG8_LDA(At, 1, 1); PG8_STAGE(PG8_SB(1, 0), b3, voffB); PG8_STAGE(PG8_SB(1, 1), b3 + hstepB, voffB); PG8_STAGE(PG8_SA(1, 0), a3, voffA);
            PG8_WAIT_V(8); PG8_WAIT_L(0); PG8_BAR; PG8_MMA(1, 0, At, B0); PG8_MMA(1, 1, At, B1); PG8_BAR; PG8_SCHED;
            } else {
            PG8_LDB(B0, 0, 0); PG8_SCHED; PG8_LDA(At, 0, 0); PG8_STAGE(PG8_SA(1, 1), a1 + hstepA, voffA);
            PG8_WAIT_L(8); PG8_BAR; PG8_WAIT_L(0); PG8_MMA(0, 0, At, B0); PG8_BAR; PG8_SCHED;
            PG8_LDB(B1, 0, 1); PG8_STAGE(PG8_SB(0, 0), b2, voffB);
            PG8_BAR; PG8_WAIT_L(0); PG8_MMA(0, 1, At, B1); PG8_BAR;
            PG8_LDA(At, 0, 1); PG8_STAGE(PG8_SA(0, 0), a2, voffA);
            PG8_BAR; PG8_WAIT_L(0); PG8_MMA(1, 0, At, B0); PG8_BAR; PG8_SCHED;
            PG8_STAGE(PG8_SB(0, 1), b2 + hstepB, voffB);
            PG8_WAIT_V(6); PG8_BAR; PG8_MMA(1, 1, At, B1); PG8_BAR;
            PG8_LDB(B0, 1, 0); PG8_SCHED; PG8_LDA(At, 1, 0); PG8_STAGE(PG8_SA(0, 1), a2 + hstepA, voffA);
            PG8_WAIT_L(8); PG8_BAR; PG8_WAIT_L(0); PG8_MMA(0, 0, At, B0); PG8_BAR; PG8_SCHED;
            PG8_LDB(B1, 1, 1); PG8_STAGE(PG8_SB(1, 0), b3, voffB);
            PG8_BAR; PG8_WAIT_L(0); PG8_MMA(0, 1, At, B1); PG8_BAR;
            PG8_LDA(At, 1, 1); PG8_STAGE(PG8_SA(1, 0), a3, voffA);
            PG8_BAR; PG8_WAIT_L(0); PG8_MMA(1, 0, At, B0); PG8_BAR; PG8_SCHED;
            PG8_STAGE(PG8_SB(1, 1), b3 + hstepB, voffB);
            PG8_WAIT_V(6); PG8_BAR; PG8_MMA(1, 1, At, B1); PG8_BAR;
            }
        }
        if constexpr (ALIGN_EPI) { if (wr == 0) PG8_BAR; }
        E(acc, cur, wr, wc, fr, fq);
        if (!has_next) break;
        if (!S.keep(cur)) {
#pragma unroll
        for (int a = 0; a < 2; ++a)
#pragma unroll
            for (int b = 0; b < 2; ++b)
#pragma unroll
                for (int m = 0; m < 4; ++m)
#pragma unroll
                    for (int n = 0; n < 2; ++n) acc[a][b][m][n] = (f32x4){0.f, 0.f, 0.f, 0.f};
        }
        cur = nxt; cA = nA; cB = nB; ++ui;
        if constexpr (ALIGN_EPI) { if (wr == 1) PG8_BAR; }
    }
    PG8_WAIT_V(0);
    if constexpr (!ALIGN_EPI) { if (wr == 0) PG8_BAR; }
    PG8_BAR;
#undef PG8_SA
#undef PG8_SB
#undef PG8_STAGE
#undef PG8_LDA
#undef PG8_LDB
#undef PG8_MMA
#undef PG8_WAIT_V
#undef PG8_WAIT_L
#undef PG8_BAR
#undef PG8_SCHED
}
}
using pg8::Unit;

struct EpiProj {
    bf16_t *QA, *KA, *VA, *QLAT, *KVLAT, *KM, *SG; float *SSQ_Q, *SSQ_KV; const float *cosA, *sinA, *cosB, *sinB;
    __device__ __forceinline__ void operator()(f32x4 (&acc)[2][2][4][2], const Unit& u, int wr, int wc, int fr, int fq) const {
        const int pn = u.pn, rbase = u.pm * 256 + wr * 64 + fr;
        if (pn <= 2) {
#pragma unroll
            for (int ai = 0; ai < 2; ++ai)
#pragma unroll
                for (int m = 0; m < 4; ++m) {
                    const int r = rbase + ai * 128 + m * 16, pos = r & (SEQ - 1);
                    const int d0 = 4 * (4 * (wc & 1) + fq);
                    const f32x4 c4 = *(const f32x4*)(cosA + pos * 32 + d0), s4 = *(const f32x4*)(sinA + pos * 32 + d0);
#pragma unroll
                    for (int bj = 0; bj < 2; ++bj) {
                        if (pn == 2 && bj == 1) { *(u32x4*)(VA + (size_t)r * 128 + 32 * wc + 8 * fq) = pack8(acc[ai][1][m][0], acc[ai][1][m][1]); }
                        else {
                            const f32x4 x1 = acc[ai][bj][m][0], x2 = acc[ai][bj][m][1];
                            f32x4 o1 = x1 * c4 - x2 * s4, o2 = x2 * c4 + x1 * s4;
                            bf16_t* dst;
                            if (pn < 2) { o1 = o1 * QA_SCALE; o2 = o2 * QA_SCALE; dst = QA + (size_t)r * 512 + (4 * pn + 2 * bj + (wc >> 1)) * 64 + d0; }
                            else dst = KA + (size_t)r * 128 + (wc >> 1) * 64 + d0;
                            *(u32x2*)dst = pack4(o1); *(u32x2*)(dst + 32) = pack4(o2);
                        }
                    }
                }
        } else if (pn <= 5) {
#pragma unroll
            for (int ai = 0; ai < 2; ++ai)
#pragma unroll
                for (int m = 0; m < 4; ++m) {
                    const int r = rbase + ai * 128 + m * 16, pos = r & (SEQ - 1);
                    float q = sumsq4(acc[ai][0][m][0]) + sumsq4(acc[ai][0][m][1]);
                    if (pn != 4) q += sumsq4(acc[ai][1][m][0]) + sumsq4(acc[ai][1][m][1]);
                    q += __shfl_xor(q, 16); q += __shfl_xor(q, 32);
                    if (pn == 3) {
                        *(u32x4*)(QLAT + (size_t)r * 384 + 32 * wc + 8 * fq) = pack8(acc[ai][0][m][0], acc[ai][0][m][1]);
                        *(u32x4*)(QLAT + (size_t)r * 384 + 128 + 32 * wc + 8 * fq) = pack8(acc[ai][1][m][0], acc[ai][1][m][1]);
                        if (fq == 0) SSQ_Q[(size_t)r * 8 + wc] = q;
                    } else if (pn == 4) {
                        *(u32x4*)(QLAT + (size_t)r * 384 + 256 + 32 * wc + 8 * fq) = pack8(acc[ai][0][m][0], acc[ai][0][m][1]);
                        if (fq == 0) SSQ_Q[(size_t)r * 8 + 4 + wc] = q;
                        if (wc == 0) {
                            const int i0 = 4 * fq;
                            const f32x4 c4 = *(const f32x4*)(cosB + pos * 16 + i0), s4 = *(const f32x4*)(sinB + pos * 16 + i0);
                            const f32x4 x1 = acc[ai][1][m][0], x2 = acc[ai][1][m][1];
                            const u32x2 w1 = pack4(x1 * c4 - x2 * s4), w2 = pack4(x2 * c4 + x1 * s4);
#pragma unroll
                            for (int h = 0; h < 8; ++h) { bf16_t* dst = KM + (size_t)r * 768 + h * 96 + 64 + i0; *(u32x2*)dst = w1; *(u32x2*)(dst + 16) = w2; }
                        }
                    } else {
                        *(u32x4*)(KVLAT + (size_t)r * 256 + 32 * wc + 8 * fq) = pack8(acc[ai][0][m][0], acc[ai][0][m][1]);
                        *(u32x4*)(KVLAT + (size_t)r * 256 + 128 + 32 * wc + 8 * fq) = pack8(acc[ai][1][m][0], acc[ai][1][m][1]);
                        if (fq == 0) SSQ_KV[(size_t)r * 4 + wc] = q;
                    }
                }
        } else {
            const int cb = (pn - 6) * 256 + 32 * wc + 8 * fq;
#pragma unroll
            for (int ai = 0; ai < 2; ++ai)
#pragma unroll
                for (int m = 0; m < 4; ++m) {
                    const int r = rbase + ai * 128 + m * 16;
#pragma unroll
                    for (int bj = 0; bj < 2; ++bj) {
                        f32x4 a = acc[ai][bj][m][0], b = acc[ai][bj][m][1];
#pragma unroll
                        for (int e = 0; e < 4; ++e) { a[e] = sigmoidf_fast(a[e]); b[e] = sigmoidf_fast(b[e]); }
                        *(u32x4*)(SG + (size_t)r * 2048 + cb + 128 * bj) = pack8(a, b);
                    }
                }
        }
    }
};

struct EpiUQ {
    bf16_t* QM; const float* SSQ_Q; const float *cosB, *sinB;
    __device__ __forceinline__ void operator()(f32x4 (&acc)[2][2][4][2], const Unit& u, int wr, int wc, int fr, int fq) const {
        const int pn = u.pn, rbase = u.pm * 256 + wr * 64 + fr;
#pragma unroll
        for (int ai = 0; ai < 2; ++ai)
#pragma unroll
            for (int m = 0; m < 4; ++m) {
                const int r = rbase + ai * 128 + m * 16, pos = r & (SEQ - 1);
                const f32x4 sa = *(const f32x4*)(SSQ_Q + (size_t)r * 8), sb = *(const f32x4*)(SSQ_Q + (size_t)r * 8 + 4);
                const float ss = ((sa[0] + sa[1]) + (sa[2] + sa[3])) + ((sb[0] + sb[1]) + (sb[2] + sb[3]));
                const float rs = __builtin_amdgcn_rsqf(ss * (1.0f / 384.0f) + EPS) * QM_SCALE;
                if (pn < 2) {
#pragma unroll
                    for (int bj = 0; bj < 2; ++bj)
                        *(u32x4*)(QM + (size_t)r * 768 + (4 * pn + 2 * bj + (wc >> 1)) * 96 + 32 * (wc & 1) + 8 * fq) = pack8(acc[ai][bj][m][0] * rs, acc[ai][bj][m][1] * rs);
                } else {
                    const int i0 = 4 * fq;
                    const f32x4 c4 = *(const f32x4*)(cosB + pos * 16 + i0), s4 = *(const f32x4*)(sinB + pos * 16 + i0);
#pragma unroll
                    for (int bj = 0; bj < 2; ++bj) {
                        const f32x4 x1 = acc[ai][bj][m][0] * rs, x2 = acc[ai][bj][m][1] * rs;
                        bf16_t* dst = QM + (size_t)r * 768 + (4 * bj + wc) * 96 + 64 + i0;
                        *(u32x2*)dst = pack4(x1 * c4 - x2 * s4); *(u32x2*)(dst + 16) = pack4(x2 * c4 + x1 * s4);
                    }
                }
                asm volatile("" ::: "memory");
            }
    }
};
struct EpiUKV {
    bf16_t *KM, *VM; const float* SSQ_KV;
    __device__ __forceinline__ void operator()(f32x4 (&acc)[2][2][4][2], const Unit& u, int wr, int wc, int fr, int fq) const {
        const int pn = u.pn, rbase = u.pm * 256 + wr * 64 + fr;
#pragma unroll
        for (int ai = 0; ai < 2; ++ai)
#pragma unroll
            for (int m = 0; m < 4; ++m) {
                const int r = rbase + ai * 128 + m * 16;
                const f32x4 sa = *(const f32x4*)(SSQ_KV + (size_t)r * 4);
                const float rs = __builtin_amdgcn_rsqf(((sa[0] + sa[1]) + (sa[2] + sa[3])) * (1.0f / 256.0f) + EPS);
#pragma unroll
                for (int bj = 0; bj < 2; ++bj) {
                    const int h = 4 * (pn & 1) + 2 * bj + (wc >> 1), d = 32 * (wc & 1) + 8 * fq;
                    bf16_t* dst = (pn < 2) ? KM + (size_t)r * 768 + h * 96 + d : VM + (size_t)r * 512 + h * 64 + d;
                    *(u32x4*)dst = pack8(acc[ai][bj][m][0] * rs, acc[ai][bj][m][1] * rs);
                }
                asm volatile("" ::: "memory");
            }
    }
};
struct EpiGate {
    const bf16_t* SG; bf16_t* Y;
    __device__ __forceinline__ void operator()(f32x4 (&acc)[2][2][4][2], const Unit& u, int wr, int wc, int fr, int fq) const {
        const int rbase = u.pm * 256 + wr * 64 + fr, cb = u.pn * 256 + 32 * wc + 8 * fq;
#pragma unroll
        for (int ai = 0; ai < 2; ++ai)
#pragma unroll
            for (int m = 0; m < 4; ++m) {
                const int r = rbase + ai * 128 + m * 16;
#pragma unroll
                for (int bj = 0; bj < 2; ++bj) {
                    const int c = cb + 128 * bj;
                    const u32x4 wb = *(const u32x4*)(SG + (size_t)r * 2048 + 1024 + c);
                    f32x4 b0 = {bf_lo(wb.x), bf_hi(wb.x), bf_lo(wb.y), bf_hi(wb.y)}, b1 = {bf_lo(wb.z), bf_hi(wb.z), bf_lo(wb.w), bf_hi(wb.w)};
                    if (u.part == 0) {
                        const u32x4 wa = *(const u32x4*)(SG + (size_t)r * 2048 + c);
                        const f32x4 a0 = {bf_lo(wa.x), bf_hi(wa.x), bf_lo(wa.y), bf_hi(wa.y)}, a1 = {bf_lo(wa.z), bf_hi(wa.z), bf_lo(wa.w), bf_hi(wa.w)};
#pragma unroll
                        for (int e = 0; e < 4; ++e) { acc[ai][bj][m][0][e] *= a0[e] * __builtin_amdgcn_rcpf(b0[e]); acc[ai][bj][m][1][e] *= a1[e] * __builtin_amdgcn_rcpf(b1[e]); }
                    } else {
                        *(u32x4*)(Y + (size_t)r * 1024 + c) = pack8(acc[ai][bj][m][0] * b0, acc[ai][bj][m][1] * b1);
                    }
                }
            }
    }
};
struct EpiRes1 {
    const float* X; float* OUT; bf16_t* X1B; float* SSQ;
    __device__ __forceinline__ void operator()(f32x4 (&acc)[2][2][4][2], const Unit& u, int wr, int wc, int fr, int fq) const {
        const int rbase = u.pm * 256 + wr * 64 + fr, cb = u.pn * 256 + 32 * wc + 8 * fq;
#pragma unroll
        for (int ai = 0; ai < 2; ++ai)
#pragma unroll
            for (int m = 0; m < 4; ++m) {
                const int r = rbase + ai * 128 + m * 16; float q = 0.f;
#pragma unroll
                for (int bj = 0; bj < 2; ++bj) {
                    const size_t o = (size_t)r * 1024 + cb + 128 * bj;
                    const f32x4 v0 = *(const f32x4*)(X + o) + acc[ai][bj][m][0], v1 = *(const f32x4*)(X + o + 4) + acc[ai][bj][m][1];
                    *(f32x4*)(OUT + o) = v0; *(f32x4*)(OUT + o + 4) = v1; *(u32x4*)(X1B + o) = pack8(v0, v1);
                    q += sumsq4(v0) + sumsq4(v1);
                }
                q += __shfl_xor(q, 16); q += __shfl_xor(q, 32);
                if (fq == 0) SSQ[(size_t)r * 16 + 4 * u.pn + wc] = q;
            }
    }
};
struct EpiSwiglu {
    const float* SSQ; bf16_t* HDN;
    __device__ __forceinline__ void operator()(f32x4 (&acc)[2][2][4][2], const Unit& u, int wr, int wc, int fr, int fq) const {
        const int rbase = u.pm * 256 + wr * 64 + fr, cb = u.pn * 128 + 32 * wc + 8 * fq;
#pragma unroll
        for (int ai = 0; ai < 2; ++ai)
#pragma unroll
            for (int m = 0; m < 4; ++m) {
                const int r = rbase + ai * 128 + m * 16;
                float ss = 0.f;
#pragma unroll
                for (int i = 0; i < 4; ++i) { const f32x4 s4 = *(const f32x4*)(SSQ + (size_t)r * 16 + 4 * i); ss += (s4[0] + s4[1]) + (s4[2] + s4[3]); }
                const float rs = __builtin_amdgcn_rsqf(ss * (1.0f / 1024.0f) + EPS);
                f32x4 h0, h1;
#pragma unroll
                for (int e = 0; e < 4; ++e) {
                    const float g0 = acc[ai][0][m][0][e] * rs, g1 = acc[ai][0][m][1][e] * rs;
                    h0[e] = g0 * sigmoidf_fast(g0) * (acc[ai][1][m][0][e] * rs); h1[e] = g1 * sigmoidf_fast(g1) * (acc[ai][1][m][1][e] * rs);
                }
                *(u32x4*)(HDN + (size_t)r * DFF + cb) = pack8(h0, h1);
            }
    }
};
struct EpiRes2 {
    const float* X1; float* OUT; float* SSQ;
    __device__ __forceinline__ void operator()(f32x4 (&acc)[2][2][4][2], const Unit& u, int wr, int wc, int fr, int fq) const {
        const int rbase = u.pm * 256 + wr * 64 + fr, cb = u.pn * 256 + 32 * wc + 8 * fq;
#pragma unroll
        for (int ai = 0; ai < 2; ++ai)
#pragma unroll
            for (int m = 0; m < 4; ++m) {
                const int r = rbase + ai * 128 + m * 16; float q = 0.f;
#pragma unroll
                for (int bj = 0; bj < 2; ++bj) {
                    const size_t o = (size_t)r * 1024 + cb + 128 * bj;
                    const f32x4 v0 = *(const f32x4*)(X1 + o) + acc[ai][bj][m][0], v1 = *(const f32x4*)(X1 + o + 4) + acc[ai][bj][m][1];
                    *(f32x4*)(OUT + o) = v0; *(f32x4*)(OUT + o + 4) = v1;
                    q += sumsq4(v0) + sumsq4(v1);
                }
                q += __shfl_xor(q, 16); q += __shfl_xor(q, 32);
                if (fq == 0) SSQ[(size_t)r * 16 + 4 * u.pn + wc] = q;
            }
    }
};

namespace att {
constexpr int KSLOT = 12288, VSLOT = 8192, NKSL = 2, NVSL = 3;
constexpr int LDS_K = 0, LDS_V = NKSL * KSLOT, LDS_WS = LDS_V + NVSL * VSLOT, LDS_OST = LDS_WS + NWAVES * 256, LDS_TOTAL = LDS_OST + NWAVES * 4096;
static_assert(LDS_TOTAL <= RING_BYTES, "attention LDS");
constexpr float THR = 6.0f;
__device__ __forceinline__ int crow(int r, int hi) { return (r & 3) + 8 * (r >> 2) + 4 * hi; }
__device__ __forceinline__ void glds16(const void* g, unsigned lds_base) {
    unsigned sv; asm volatile("s_mov_b32 %0, m0\n\ts_mov_b32 m0, %2\n\ts_nop 0\n\tglobal_load_lds_dwordx4 %1, off\n\ts_mov_b32 m0, %0" : "=&s"(sv) : "v"(g), "s"(lds_base) : "memory"); }
#define ATT_WAIT_BAR() asm volatile("s_waitcnt vmcnt(0) lgkmcnt(0)\n\ts_barrier" ::: "memory")
#define MX3(a, b, c) __builtin_fmaxf(__builtin_fmaxf((a), (b)), (c))
__device__ __forceinline__ float rowmax(const f32x16& p0, const f32x16& p1) {
    float a = MX3(p0[0], p0[1], p1[0]), b = MX3(p0[2], p0[3], p1[1]); a = MX3(a, p1[2], p1[3]);
#pragma unroll
    for (int r = 4; r < 16; r += 4) { a = MX3(a, p0[r], p0[r + 1]); b = MX3(b, p0[r + 2], p0[r + 3]); a = MX3(a, p1[r], p1[r + 1]); b = MX3(b, p1[r + 2], p1[r + 3]); }
    float m = __builtin_fmaxf(a, b); auto rr = __builtin_amdgcn_permlane32_swap(__float_as_uint(m), __float_as_uint(m), false, false);
    return __builtin_fmaxf(__uint_as_float(rr[0]), __uint_as_float(rr[1])); }
typedef short v4i16_t __attribute__((ext_vector_type(4)));
__device__ __forceinline__ s16x4 vtr(const LAS char* p) { return __builtin_bit_cast(s16x4, __builtin_amdgcn_ds_read_tr16_b64_v4i16((LAS v4i16_t*)p)); }

template <int DQK, bool SWA>
__device__ __forceinline__ void unit(const bf16_t* Qw, int qpitch, const bf16_t* Kb, int kpitch, const bf16_t* Vb, int vpitch, bf16_t* Ow, int opitch,
                                     int pos0, int t0, int t1, int band_from, float m_init, float l_init, LAS unsigned char* lds) {
    constexpr int NKS = DQK / 16, NCH = DQK / 8;
    constexpr bool FIRST_REF = !SWA;
    const int tid = threadIdx.x, lane = tid & 63, r32 = lane & 31, hi = lane >> 5; const int wid = __builtin_amdgcn_readfirstlane(tid >> 6);
    const bool late = wid >= 4;
    const unsigned lds0 = (unsigned)(uintptr_t)lds;
    LAS float* wsf = (LAS float*)(lds + LDS_WS) + wid * 64;
    const bf16_t* ksrc = Kb + (size_t)lane * kpitch + wid * 8;
    const bf16_t* vsrc = Vb + (size_t)(16 * (wid & 3) + (lane >> 2)) * vpitch + (wid >> 2) * 32 + (lane & 3) * 8;
    const unsigned kdst = lds0 + LDS_K + wid * 1024, vdst = lds0 + LDS_V + wid * 1024;
#define ATT_DMA(t, ks, vs) do { glds16(ksrc + (size_t)(t) * 64 * kpitch, (unsigned)__builtin_amdgcn_readfirstlane(kdst + (ks) * KSLOT)); \
        if (NCH > 8 && wid + 8 < NCH) glds16(ksrc + (size_t)(t) * 64 * kpitch + 64, (unsigned)__builtin_amdgcn_readfirstlane(kdst + (ks) * KSLOT + 8192)); \
        glds16(vsrc + (size_t)(t) * 64 * vpitch, (unsigned)__builtin_amdgcn_readfirstlane(vdst + (vs) * VSLOT)); } while (0)
    ATT_DMA(t0, 0, 0);
    bf16x8 qr[NKS];
#pragma unroll
    for (int d0 = 0; d0 < NKS; ++d0) qr[d0] = *(const bf16x8*)(Qw + (size_t)r32 * qpitch + d0 * 16 + hi * 8);
    float mrun = FIRST_REF ? 0.f : m_init, l_reg = (hi == 0) ? l_init : 0.f; f32x16 o[2]; o[0] = f32x16{}; o[1] = f32x16{};
    f32x16 negm;
#pragma unroll
    for (int r = 0; r < 16; ++r) negm[r] = -mrun;
    asm volatile("" : "+v"(negm));
    const int qpos = pos0 + r32;
    f32x16 p0, p1;
    const LAS char* vlane = (const LAS char*)(lds + LDS_V) + ((lane >> 4) & 1) * 32 + (lane & 3) * 8 + (4 * hi + ((lane & 15) >> 2)) * 64;
    const LAS unsigned char* klane = lds + LDS_K + hi * 1024 + r32 * 16;

#define ATT_QK(ks) do { const LAS unsigned char* kb_ = klane + (ks) * KSLOT; bf16x8 kf[2 * NKS]; \
        _Pragma("unroll") for (int d0 = 0; d0 < NKS; ++d0) { kf[2 * d0] = *(const LAS bf16x8*)(kb_ + d0 * 2048); kf[2 * d0 + 1] = *(const LAS bf16x8*)(kb_ + d0 * 2048 + 512); } \
        __builtin_amdgcn_sched_barrier(0); \
        _Pragma("unroll") for (int d0 = 0; d0 < NKS; ++d0) { \
            if (d0 == 0) { p0 = __builtin_amdgcn_mfma_f32_32x32x16_bf16(kf[0], qr[0], negm, 0, 0, 0); p1 = __builtin_amdgcn_mfma_f32_32x32x16_bf16(kf[1], qr[0], negm, 0, 0, 0); } \
            else { p0 = __builtin_amdgcn_mfma_f32_32x32x16_bf16(kf[2 * d0], qr[d0], p0, 0, 0, 0); p1 = __builtin_amdgcn_mfma_f32_32x32x16_bf16(kf[2 * d0 + 1], qr[d0], p1, 0, 0, 0); } } } while (0)
#define ATT_SMPV(tt, vs) do { \
        const LAS char* vp = vlane + (vs) * VSLOT; s16x4 vlo[8], vhh[8]; \
        _Pragma("unroll") for (int i_ = 0; i_ < 8; ++i_) { vlo[i_] = vtr(vp + (i_ >> 2) * 4096 + (i_ & 3) * 1024); vhh[i_] = vtr(vp + (i_ >> 2) * 4096 + (i_ & 3) * 1024 + 512); } \
        __builtin_amdgcn_sched_barrier(0); \
        if (SWA || (tt) >= band_from) { const int kb0 = (tt) * 64 + 4 * hi; \
            _Pragma("unroll") for (int r = 0; r < 16; ++r) { const int kv = kb0 + (r & 3) + 8 * (r >> 2); \
                bool ok0 = kv <= qpos, ok1 = kv + 32 <= qpos; if (SWA) { ok0 = ok0 && (kv > qpos - 128); ok1 = ok1 && (kv + 32 > qpos - 128); } \
                if (!ok0) p0[r] = -__builtin_inff(); if (!ok1) p1[r] = -__builtin_inff(); } } \
        const float rm = rowmax(p0, p1); \
        const bool first_ = FIRST_REF && (tt) == t0; \
        if (first_ || __any(rm > THR)) { \
            const float dl = first_ ? rm : __builtin_fmaxf(rm, 0.f); mrun += dl; \
            _Pragma("unroll") for (int r = 0; r < 16; ++r) { p0[r] -= dl; p1[r] -= dl; } \
            _Pragma("unroll") for (int r = 0; r < 16; ++r) negm[r] = -mrun; \
            asm volatile("" : "+v"(negm)); \
            if (!first_) { const float f = __builtin_amdgcn_exp2f(-dl); l_reg *= f; if (hi == 0) wsf[r32] = f; \
                _Pragma("unroll") for (int r = 0; r < 16; ++r) { const float fr_ = wsf[crow(r, hi)]; o[0][r] *= fr_; o[1][r] *= fr_; } } } \
        float sa0 = 0.f, sa1 = 0.f, sa2 = 0.f, sa3 = 0.f; \
        _Pragma("unroll") for (int r = 0; r < 16; r += 2) { p0[r] = __builtin_amdgcn_exp2f(p0[r]); p1[r] = __builtin_amdgcn_exp2f(p1[r]); p0[r + 1] = __builtin_amdgcn_exp2f(p0[r + 1]); p1[r + 1] = __builtin_amdgcn_exp2f(p1[r + 1]); \
            sa0 += p0[r]; sa1 += p1[r]; sa2 += p0[r + 1]; sa3 += p1[r + 1]; } \
        l_reg += (sa0 + sa1) + (sa2 + sa3); \
        u32x4 pw[4]; \
        pw[0] = (u32x4){cvtpk(p0[0], p0[1]), cvtpk(p0[2], p0[3]), cvtpk(p0[4], p0[5]), cvtpk(p0[6], p0[7])}; \
        pw[1] = (u32x4){cvtpk(p0[8], p0[9]), cvtpk(p0[10], p0[11]), cvtpk(p0[12], p0[13]), cvtpk(p0[14], p0[15])}; \
        pw[2] = (u32x4){cvtpk(p1[0], p1[1]), cvtpk(p1[2], p1[3]), cvtpk(p1[4], p1[5]), cvtpk(p1[6], p1[7])}; \
        pw[3] = (u32x4){cvtpk(p1[8], p1[9]), cvtpk(p1[10], p1[11]), cvtpk(p1[12], p1[13]), cvtpk(p1[14], p1[15])}; \
        _Pragma("unroll") for (int d0 = 0; d0 < 2; ++d0) _Pragma("unroll") for (int ks_ = 0; ks_ < 4; ++ks_) { \
            const s16x4 lo = vlo[d0 * 4 + ks_], hh = vhh[d0 * 4 + ks_]; \
            const bf16x8 vf = (bf16x8){lo[0], lo[1], lo[2], lo[3], hh[0], hh[1], hh[2], hh[3]}; \
            o[d0] = __builtin_amdgcn_mfma_f32_32x32x16_bf16(__builtin_bit_cast(bf16x8, pw[ks_]), vf, o[d0], 0, 0, 0); } } while (0)

    ATT_WAIT_BAR();
    if (t0 + 1 < t1) ATT_DMA(t0 + 1, 1, 1);
    int ks = 0, vs = 0;
#pragma unroll 1
    for (int t = t0; t < t1; ++t) {
        const int ksn = ks ^ 1, vsn = (vs == NVSL - 1) ? 0 : vs + 1, vsnn = (vsn == NVSL - 1) ? 0 : vsn + 1;
        ATT_QK(ks);
        if (late && t + 1 < t1) { ATT_WAIT_BAR(); if (t + 2 < t1) ATT_DMA(t + 2, ks, vsnn); }
        ATT_SMPV(t, vs);
        if (!late && t + 1 < t1) { ATT_WAIT_BAR(); if (t + 2 < t1) ATT_DMA(t + 2, ks, vsnn); }
        ks = ksn; vs = vsn;
    }
    { auto rr = __builtin_amdgcn_permlane32_swap(__float_as_uint(l_reg), __float_as_uint(l_reg), false, false); l_reg = __uint_as_float(rr[0]) + __uint_as_float(rr[1]); }
    if (hi == 0) wsf[32 + r32] = l_reg;
    float rli[16];
#pragma unroll
    for (int r = 0; r < 16; ++r) rli[r] = __builtin_amdgcn_rcpf(wsf[32 + crow(r, hi)]);
    LAS bf16_t* stg = (LAS bf16_t*)(lds + LDS_OST) + wid * 2048;
#pragma unroll
    for (int r = 0; r < 16; ++r) { const int orow = crow(r, hi);
#pragma unroll
        for (int d0 = 0; d0 < 2; ++d0) stg[orow * 64 + d0 * 32 + r32] = (bf16_t)(cvtpk(o[d0][r] * rli[r], 0.f) & 0xffffu); }
    asm volatile("s_waitcnt lgkmcnt(0)" ::: "memory");
#pragma unroll
    for (int i = 0; i < 4; ++i) { const int row = i * 8 + (lane >> 3), ch = lane & 7; const u32x4 v = *(const LAS u32x4*)(stg + row * 64 + ch * 8); *(u32x4*)(Ow + (size_t)row * opitch + ch * 8) = v; }
    asm volatile("s_waitcnt lgkmcnt(0)\n\ts_barrier" ::: "memory");
#undef ATT_DMA
#undef ATT_QK
#undef ATT_SMPV
}
#undef MX3
}

#define XB_TMO      128
#define XB_XCNT(j)  (256  + 64 * (j))
#define XB_XSUB(j)  (1280 + 64 * (j))
#define XB_XGEN(j)  (2304 + 64 * (j))
#define XB_TOP      3328
#define XB_TOPGEN   3392
#define XCD_BAR_WORDS 3456
#define XB_SPIN_CAP (1u << 18)
__device__ __forceinline__ unsigned xb_ld(unsigned* p)              { return __hip_atomic_load(p, __ATOMIC_RELAXED, __HIP_MEMORY_SCOPE_AGENT); }
__device__ __forceinline__ unsigned xb_add(unsigned* p, unsigned v) { return __hip_atomic_fetch_add(p, v, __ATOMIC_RELAXED, __HIP_MEMORY_SCOPE_AGENT); }
__device__ __forceinline__ unsigned xb_xcc_id() { return (unsigned)__builtin_amdgcn_s_getreg((3 << 11) | 20) & 0xFu; }
#define XB_SPIN(cond, bar) do { unsigned _sp = 0; while (cond) { __builtin_amdgcn_s_sleep(1); \
    if ((++_sp & 255u) == 0u) { if (xb_ld(&(bar)[XB_TMO])) break; if (_sp > XB_SPIN_CAP) { atomicAdd(&(bar)[XB_TMO], 1u); break; } } } } while (0)
struct XcdBarrier { unsigned* bar; unsigned x; volatile LAS unsigned* st; };
__device__ __forceinline__ XcdBarrier xcd_barrier_post(unsigned* bar, volatile LAS unsigned* st) {
    XcdBarrier b; b.bar = bar; b.x = xb_xcc_id(); b.st = st;
    if (threadIdx.x == 0) (void)xb_add(&bar[XB_XCNT(b.x)], 1u);
    return b;
}
__device__ __forceinline__ void xcd_barrier_complete(unsigned* bar, unsigned x, unsigned& nloc, unsigned& nx) {
    const unsigned G = gridDim.x * gridDim.y * gridDim.z;
    unsigned sum, cnt, mine, sp = 0u;
    for (;;) {
        sum = 0u; cnt = 0u; mine = 0u;
#pragma unroll
        for (unsigned j = 0; j < 16; ++j) { const unsigned c = xb_ld(&bar[XB_XCNT(j)]); sum += c; cnt += (c > 0u) ? 1u : 0u; mine = (j == x) ? c : mine; }
        if (sum == G) break;
        __builtin_amdgcn_s_sleep(1);
        if ((++sp & 255u) == 0u) { if (xb_ld(&bar[XB_TMO])) break; if (sp > XB_SPIN_CAP) { atomicAdd(&bar[XB_TMO], 1u); break; } }
    }
    nloc = mine > 0u ? mine : 1u; nx = cnt > 0u ? cnt : 1u;
}
__device__ __forceinline__ void xcd_barrier(const XcdBarrier& b) {
    asm volatile("s_waitcnt vmcnt(0)" ::: "memory");
    __syncthreads();
    if (threadIdx.x == 0) {
        unsigned* bar = b.bar;
        __builtin_amdgcn_s_waitcnt(0);
        unsigned nloc = b.st[0], nx = b.st[1];
        if (nloc == 0u) { xcd_barrier_complete(bar, b.x, nloc, nx); b.st[0] = nloc; b.st[1] = nx; }
        const unsigned old = xb_add(&bar[XB_XSUB(b.x)], 1u);
        const unsigned gen = old / nloc;
        if (old + 1u == (gen + 1u) * nloc) {
            __builtin_amdgcn_fence(__ATOMIC_RELEASE, "agent");
            asm volatile("s_waitcnt vmcnt(0)" ::: "memory");
            const unsigned og = xb_add(&bar[XB_TOP], 1u);
            const unsigned tg = og / nx;
            if (og + 1u == (tg + 1u) * nx) xb_add(&bar[XB_TOPGEN], 1u);
            else XB_SPIN(xb_ld(&bar[XB_TOPGEN]) == tg, bar);
            __builtin_amdgcn_fence(__ATOMIC_ACQUIRE, "agent");
            xb_add(&bar[XB_XGEN(b.x)], 1u);
            asm volatile("s_waitcnt vmcnt(0)" ::: "memory");
        } else {
            XB_SPIN(xb_ld(&bar[XB_XGEN(b.x)]) == gen, bar);
            __builtin_amdgcn_fence(__ATOMIC_ACQUIRE, "agent");
            asm volatile("s_waitcnt vmcnt(0)" ::: "memory");
        }
    }
    __syncthreads();
}

struct Args { const float* in[16]; float* out; unsigned char* ws; int ph_lo, ph_hi; };

__device__ __forceinline__ int rope64_src(int vv) { return 4 * (vv >> 3) + (vv & 3) + 32 * ((vv >> 2) & 1); }
__device__ __forceinline__ int rope32_src(int vv) { return 4 * (vv >> 3) + (vv & 3) + 16 * ((vv >> 2) & 1); }
__device__ __forceinline__ int src_w1(int v) {
    if (v < 512) return O_QA + (v & ~63) + rope64_src(v & 63);
    if (v < 640) { const int u = v - 512; return O_KA + (u & ~63) + rope64_src(u & 63); }
    if (v < 768) return O_VA + (v - 640);
    if (v < 1152) return O_QL + (v - 768);
    if (v < 1184) return O_KR + rope32_src(v - 1152);
    if (v < 1280) return -1;
    if (v < 1536) return O_KVL + (v - 1280);
    if (v < 2560) return O_GA + (v - 1536);
    return O_GB + (v - 2560);
}
__device__ __forceinline__ int src_uq(int v) { if (v < 512) return (v >> 6) * 96 + (v & 63); const int u = v - 512; return (u >> 5) * 96 + 64 + rope32_src(u & 31); }
__device__ __forceinline__ int src_ukv(int v) { if (v < 512) return (v >> 6) * 128 + (v & 63); const int u = v - 512; return (u >> 6) * 128 + 64 + (u & 63); }

template <bool GAIN> __device__ __forceinline__ void tr_item_t(const float* W, int ldw, int sc, const float* gain, int k0, bf16_t* dst, int ldd, LAS float* scr, int lane) {
    const float msk = sc >= 0 ? 1.f : 0.f; const int scc = sc >= 0 ? sc : 0;
#pragma unroll 8
    for (int i = 0; i < 32; ++i) { const int kk = 2 * i + (lane >> 5); float v = W[(size_t)(k0 + kk) * ldw + scc] * msk; if (GAIN) v *= gain[k0 + kk]; scr[kk * 33 + (lane & 31)] = v; }
    asm volatile("s_waitcnt lgkmcnt(0)" ::: "memory");
    const int c = lane & 7;
#pragma unroll
    for (int j = 0; j < 4; ++j) { const int n = (lane >> 3) + 8 * j; const LAS float* s = scr + (8 * c) * 33 + n;
        u32x4 o; o.x = cvtpk(s[0 * 33], s[1 * 33]); o.y = cvtpk(s[2 * 33], s[3 * 33]); o.z = cvtpk(s[4 * 33], s[5 * 33]); o.w = cvtpk(s[6 * 33], s[7 * 33]);
        *(u32x4*)(dst + (size_t)n * ldd + k0 + 8 * c) = o; }
    asm volatile("s_waitcnt lgkmcnt(0)" ::: "memory");
}

__device__ __forceinline__ void tr_item(const float* W, int ldw, int sc, const float* gain, int k0, bf16_t* dst, int ldd, LAS float* scr, int lane) {
    if (gain) tr_item_t<true>(W, ldw, sc, gain, k0, dst, ldd, scr, lane); else tr_item_t<false>(W, ldw, sc, gain, k0, dst, ldd, scr, lane);
}

__global__ void __launch_bounds__(NWAVES * 64, 2) fwd_kernel(Args args) {
    extern __shared__ __attribute__((aligned(16))) unsigned char lds_raw[];
    LAS unsigned char* lds = (LAS unsigned char*)lds_raw;
    const int tid = threadIdx.x, lane = tid & 63, wave = __builtin_amdgcn_readfirstlane(tid >> 6);
    const int G = gridDim.x, bx = blockIdx.x;
    const int vcu = (G % 8 == 0) ? (bx % 8) * (G / 8) + bx / 8 : bx;
    unsigned char* ws = args.ws;
    const float* X = args.in[0]; float* OUT = args.out;
    bf16_t* W1T = (bf16_t*)(ws + WS_W1T); bf16_t* WUQT = (bf16_t*)(ws + WS_WUQT); bf16_t* WUKVT = (bf16_t*)(ws + WS_WUKVT); bf16_t* WOT = (bf16_t*)(ws + WS_WOT);
    bf16_t* WOUTT = (bf16_t*)(ws + WS_WOUTT); bf16_t* WGUT = (bf16_t*)(ws + WS_WGUT); bf16_t* WDT = (bf16_t*)(ws + WS_WDT);
    float* cosA = (float*)(ws + WS_TAB); float* sinA = cosA + SEQ * 32; float* cosB = sinA + SEQ * 32; float* sinB = cosB + SEQ * 16;
    float* SSQ_Q = (float*)(ws + WS_SSQ); float* SSQ_KV = SSQ_Q + (size_t)T * 8; float* SSQ_X1 = SSQ_KV + (size_t)T * 4; float* SSQ_X2 = SSQ_X1 + (size_t)T * 16;
    bf16_t* XN = (bf16_t*)(ws + WS_XN); bf16_t* SG = (bf16_t*)(ws + WS_SG); bf16_t* QA = (bf16_t*)(ws + WS_QA); bf16_t* KA = (bf16_t*)(ws + WS_KA); bf16_t* VA = (bf16_t*)(ws + WS_VA);
    bf16_t* QLAT = (bf16_t*)(ws + WS_QLAT); bf16_t* KVLAT = (bf16_t*)(ws + WS_KVLAT); bf16_t* QM = (bf16_t*)(ws + WS_QM); bf16_t* KM = (bf16_t*)(ws + WS_KM);
    bf16_t* VM = (bf16_t*)(ws + WS_VM); bf16_t* OB = (bf16_t*)(ws + WS_OB); bf16_t* OA = (bf16_t*)(ws + WS_OA); bf16_t* Y = (bf16_t*)(ws + WS_Y); bf16_t* HDN = (bf16_t*)(ws + WS_HDN); float* X2 = (float*)(ws + WS_X2);
    const int lo = args.ph_lo, hi = args.ph_hi;
#ifndef PHASE_MASK
#define PHASE_MASK 0x1ff
#endif
#define IN(k) (((PHASE_MASK >> (k)) & 1) && lo <= (k) && (k) < hi)
#if MK_N_LAUNCHES == 1
    for (int u = tid; u < 32; u += NWAVES * 64) ((LAS unsigned*)(lds + MISC_OFF))[u] = 0u;
    __syncthreads();
    const XcdBarrier bar = xcd_barrier_post((unsigned*)(ws + WS_CTL), (volatile LAS unsigned*)(lds + MISC_OFF) + 8);
#define GRID_BAR() do { for (int rb_ = 0; rb_ < REP_BAR; ++rb_) xcd_barrier(bar); } while (0)
#else
#define GRID_BAR() do {} while (0)
#endif

    if (IN(0)) {
      for (int rep_ = 0; rep_ < REP_P0; ++rep_) {
        LAS float* scr = (LAS float*)(lds + wave * 16384);
        const int gw = vcu * NWAVES + wave, NGW = G * NWAVES;
        constexpr int I_W1 = (DM / 64) * (NV1 / 32), I_UQ = (384 / 64) * (768 / 32), I_UKV = (256 / 64) * (1024 / 32), I_O = (512 / 64) * (1024 / 32), I_OUT = (DM / 64) * (DM / 32),
                      I_GU = (DM / 64) * (2 * DFF / 32), I_D = (DFF / 64) * (DM / 32);
        constexpr int NITEMS = I_W1 + I_UQ + I_UKV + 2 * I_O + I_OUT + I_GU + I_D;
        const int ln = lane & 31;
        for (int it = gw; it < NITEMS; it += NGW) {
            int r = it;
            if (r < I_W1) { const int nblk = NV1 / 32, kb = r / nblk, nb = r % nblk; tr_item(args.in[2], INW, src_w1(nb * 32 + ln), nullptr, kb * 64, W1T + (size_t)nb * 32 * DM, DM, scr, lane); continue; } r -= I_W1;
            if (r < I_UQ) { const int nblk = 768 / 32, kb = r / nblk, nb = r % nblk; tr_item(args.in[5], 768, src_uq(nb * 32 + ln), args.in[4], kb * 64, WUQT + (size_t)nb * 32 * 384, 384, scr, lane); continue; } r -= I_UQ;
            if (r < I_UKV) { const int nblk = 1024 / 32, kb = r / nblk, nb = r % nblk; tr_item(args.in[7], 1024, src_ukv(nb * 32 + ln), args.in[6], kb * 64, WUKVT + (size_t)nb * 32 * 256, 256, scr, lane); continue; } r -= I_UKV;
            if (r < I_O) { const int nblk = 1024 / 32, kb = r / nblk, nb = r % nblk; tr_item(args.in[8], DM, nb * 32 + ln, nullptr, kb * 64, WOT + (size_t)nb * 32 * 1024, 1024, scr, lane); continue; } r -= I_O;
            if (r < I_O) { const int nblk = 1024 / 32, kb = r / nblk, nb = r % nblk; tr_item(args.in[9], DM, nb * 32 + ln, nullptr, kb * 64, WOT + (size_t)nb * 32 * 1024 + 512, 1024, scr, lane); continue; } r -= I_O;
            if (r < I_OUT) { const int nblk = DM / 32, kb = r / nblk, nb = r % nblk; tr_item(args.in[10], DM, nb * 32 + ln, nullptr, kb * 64, WOUTT + (size_t)nb * 32 * DM, DM, scr, lane); continue; } r -= I_OUT;
            if (r < I_GU) { const int nblk = 2 * DFF / 32, kb = r / nblk, nb = r % nblk; const int v = nb * 32, pn = v >> 8, bj = (v >> 7) & 1, c = 128 * pn + (v & 127) + ln;
                            tr_item(bj ? args.in[13] : args.in[12], DFF, c, args.in[11], kb * 64, WGUT + (size_t)v * DM, DM, scr, lane); continue; } r -= I_GU;
            { const int nblk = DM / 32, kb = r / nblk, nb = r % nblk; tr_item(args.in[14], DM, nb * 32 + ln, nullptr, kb * 64, WDT + (size_t)nb * 32 * DFF, DFF, scr, lane); }
        }
        for (int i = (vcu * NWAVES + wave) * 64 + lane; i < SEQ * 32; i += G * NWAVES * 64) {
            { const int p = i >> 5, j = i & 31; const double a = (double)p * pow(10000.0, -(double)j / 32.0); cosA[i] = (float)cos(a); sinA[i] = (float)sin(a); }
            if (i < SEQ * 16) { const int p = i >> 4, j = i & 15; const double a = (double)p * pow(10000.0, -(double)j / 16.0); cosB[i] = (float)cos(a); sinB[i] = (float)sin(a); }
        }
        const float* g1 = args.in[1];
        f32x4 gv[4];
#pragma unroll
        for (int j = 0; j < 4; ++j) gv[j] = *(const f32x4*)(g1 + 4 * lane + 256 * j);
        for (int m = gw; m < T; m += NGW) {
            const f32x4* xr = (const f32x4*)(X + (size_t)m * DM) + lane;
            f32x4 v[4]; float s = 0.f;
#pragma unroll
            for (int j = 0; j < 4; ++j) { v[j] = xr[64 * j]; s += sumsq4(v[j]); }
            const float rs = 1.0f / sqrtf(wave_sum(s) * (1.0f / DM) + EPS);
            u32x2* o8 = (u32x2*)(XN + (size_t)m * DM) + lane;
#pragma unroll
            for (int j = 0; j < 4; ++j) o8[64 * j] = pack4(v[j] * rs * gv[j]);
        }
      }
        if (IN(1)) GRID_BAR();
    }

    if (IN(1)) {
        pg8::Gemm g{XN, W1T, DM, DM, DM};
        pg8::SchedPlain S{{}, g}; S.o.init(T / 256, NV1 / 256, G, bx);
        EpiProj E{QA, KA, VA, QLAT, KVLAT, KM, SG, SSQ_Q, SSQ_KV, cosA, sinA, cosB, sinB};
        pg8::gemm_phase<EpiProj, pg8::SchedPlain, true, true>(lds, DM, DM, DM, S, E);
        if (REP_P1 > 1) pg8::gemm_phase<EpiProj, pg8::SchedPlain, true, true>(lds, DM, DM, DM, S, E);
        if (IN(2)) GRID_BAR();
    }

    if (IN(2)) {
        { pg8::Gemm g{QLAT, WUQT, 384, 384, 384};
          pg8::SchedPlain S{{}, g}; S.o.init(T / 256, 3, G, bx);
          EpiUQ E{QM, SSQ_Q, cosB, sinB};
          pg8::gemm_phase<EpiUQ, pg8::SchedPlain, true, true>(lds, 384, 384, 384, S, E);
          if (REP_P2 > 1) pg8::gemm_phase<EpiUQ, pg8::SchedPlain, true, true>(lds, 384, 384, 384, S, E); }
        { pg8::Gemm g{KVLAT, WUKVT, 256, 256, 256};
          pg8::SchedPlain S{{}, g}; S.o.init(T / 256, 4, G, (G - 1) - bx);
          EpiUKV E{KM, VM, SSQ_KV};
          pg8::gemm_phase<EpiUKV, pg8::SchedPlain, true, true>(lds, 256, 256, 256, S, E);
          if (REP_P2 > 1) pg8::gemm_phase<EpiUKV, pg8::SchedPlain, true, true>(lds, 256, 256, 256, S, E); }
        if (IN(3)) GRID_BAR();
    }

    if (IN(3)) {
        const float* sinks = args.in[3];
        for (int rep_ = 0; rep_ < REP_MLA; ++rep_)
        for (int base = vcu; base < 256; base += G) {
            const int bh = base >> 2, s = base & 3, b = bh >> 3, h = bh & 7;
            for (int i = 0; i < 4; ++i) {
                const int qb = (i == 0) ? s : (i == 1) ? 7 - s : (i == 2) ? 8 + s : 15 - s;
                const size_t row0 = (size_t)b * SEQ;
                const int q0 = qb * 256 + wave * 32;
                att::unit<96, false>(QM + (row0 + q0) * 768 + h * 96, 768, KM + row0 * 768 + h * 96, 768, VM + row0 * 512 + h * 64, 512,
                                     OB + (row0 + q0) * 512 + h * 64, 512, q0, 0, 4 * qb + 4, 4 * qb, -1e30f, 0.f, lds);
            }
        }
        for (int rep_ = 0; rep_ < REP_SWA; ++rep_)
        for (int base = vcu; base < 256; base += G) {
            const int bk = base >> 4, b = bk >> 1, kvh = bk & 1;
            for (int i = 0; i < 4; ++i) {
                const int blk = (base & 15) + 16 * i;
                const size_t row0 = (size_t)b * SEQ;
                const int hq = 4 * kvh + (wave >> 1), q0 = 64 * blk + 32 * (wave & 1);
                const int t0 = blk >= 2 ? blk - 2 : 0;
                const float sk = sinks[hq] * LOG2E;
                att::unit<64, true>(QA + (row0 + q0) * 512 + hq * 64, 512, KA + row0 * 128 + kvh * 64, 128, VA + row0 * 128 + kvh * 64, 128,
                                    OA + (row0 + q0) * 512 + hq * 64, 512, q0, t0, blk + 1, 0, sk, 1.0f, lds);
            }
        }
        if (IN(4)) GRID_BAR();
    }

    if (IN(4)) {
        pg8::SchedPair S{{}, OA, OB, WOT, 512, 1024, 512}; S.o.init(T / 256, 4, G, bx);
        EpiGate E{SG, Y};
        for (int rep_ = 0; rep_ < REP_P4; ++rep_) pg8::gemm_phase<EpiGate, pg8::SchedPair, true, true>(lds, 512, 1024, 512, S, E);
        if (IN(5)) GRID_BAR();
    }

    if (IN(5)) {
        pg8::Gemm g{Y, WOUTT, DM, DM, DM};
        pg8::SchedPlain S{{}, g}; S.o.init(T / 256, 4, G, bx);
        EpiRes1 E{X, OUT, XN, SSQ_X1};
        for (int rep_ = 0; rep_ < REP_P5; ++rep_) pg8::gemm_phase<EpiRes1, pg8::SchedPlain, true, true>(lds, DM, DM, DM, S, E);
        if (IN(6)) GRID_BAR();
    }

    if (IN(6)) {
        pg8::Gemm g{XN, WGUT, DM, DM, DM};
        pg8::SchedPlain S{{}, g}; S.o.init(T / 256, 22, G, bx);
        EpiSwiglu E{SSQ_X1, HDN};
        for (int rep_ = 0; rep_ < REP_P6; ++rep_) pg8::gemm_phase<EpiSwiglu, pg8::SchedPlain, true, true>(lds, DM, DM, DM, S, E);
        if (IN(7)) GRID_BAR();
    }

    if (IN(7)) {
        pg8::Gemm g{HDN, WDT, DFF, DFF, DFF};
        pg8::SchedPlain S{{}, g}; S.o.init(T / 256, 4, G, bx);
        EpiRes2 E{OUT, X2, SSQ_X2};
        pg8::gemm_phase<EpiRes2, pg8::SchedPlain, true, true>(lds, DFF, DFF, DFF, S, E);
        if (REP_P7 > 1) pg8::gemm_phase<EpiRes2, pg8::SchedPlain, true, true>(lds, DFF, DFF, DFF, S, E);
        if (IN(8)) GRID_BAR();
    }

    if (IN(8)) {
        const int gw = vcu * NWAVES + wave, NGW = G * NWAVES;
        const float* gf = args.in[15];
        f32x4 gv[4];
#pragma unroll
        for (int j = 0; j < 4; ++j) gv[j] = *(const f32x4*)(gf + 4 * lane + 256 * j);
        for (int rep_ = 0; rep_ < REP_P8; ++rep_)
        for (int m = gw; m < T; m += NGW) {
            float ss = 0.f;
#pragma unroll
            for (int i = 0; i < 4; ++i) { const f32x4 s4 = *(const f32x4*)(SSQ_X2 + (size_t)m * 16 + 4 * i); ss += (s4[0] + s4[1]) + (s4[2] + s4[3]); }
            const float rs = 1.0f / sqrtf(ss * (1.0f / DM) + EPS);
            const f32x4* xr = (const f32x4*)(X2 + (size_t)m * DM) + lane; f32x4* orow = (f32x4*)(OUT + (size_t)m * DM) + lane;
#pragma unroll
            for (int j = 0; j < 4; ++j) orow[64 * j] = xr[64 * j] * rs * gv[j];
        }
    }
#undef IN
#undef GRID_BAR
}

extern "C" void kernel_launch(void* const* d_in, const int* in_sizes, int n_in, void* d_out, int out_size, void* d_ws, size_t ws_size, hipStream_t stream) {
    static int grid = 0;
    if (grid == 0) {
        if (n_in != 16 || out_size != T * DM || ws_size < WS_END) { fprintf(stderr, "kernel_launch: unexpected shapes (n_in %d out %d ws %zu, need ws >= %zu)\n", n_in, out_size, ws_size, (size_t)WS_END); grid = -1; return; }
        int dev = 0, cus = 0, per_cu = 0;
        hipGetDevice(&dev); hipDeviceGetAttribute(&cus, hipDeviceAttributeMultiprocessorCount, dev);
        if (hipFuncSetAttribute((const void*)fwd_kernel, hipFuncAttributeMaxDynamicSharedMemorySize, LDS_BYTES) != hipSuccess) { fprintf(stderr, "kernel_launch: hipFuncSetAttribute failed\n"); grid = -1; return; }
        if (hipOccupancyMaxActiveBlocksPerMultiprocessor(&per_cu, (const void*)fwd_kernel, NWAVES * 64, LDS_BYTES) != hipSuccess || per_cu < 1) { fprintf(stderr, "kernel_launch: occupancy query says %d\n", per_cu); per_cu = 1; }
        (void)hipGetLastError();
        grid = cus;
        fprintf(stderr, "kernel_launch: grid %d (cus %d, per_cu %d)\n", grid, cus, per_cu);
    }
    if (grid < 0) return;
    Args a{};
    for (int i = 0; i < 16; ++i) a.in[i] = (const float*)d_in[i];
    a.out = (float*)d_out; a.ws = (unsigned char*)d_ws;
#if MK_N_LAUNCHES == 1
    a.ph_lo = 0; a.ph_hi = 9;
    if (hipMemsetAsync((char*)d_ws + WS_CTL, 0, CTL_BYTES, stream) != hipSuccess) { fprintf(stderr, "kernel_launch: memset failed\n"); return; }
    void* kargs[] = {&a};
    hipError_t e = hipLaunchCooperativeKernel((const void*)fwd_kernel, dim3(grid), dim3(NWAVES * 64), kargs, LDS_BYTES, stream);
    if (e != hipSuccess) fprintf(stderr, "cooperative launch failed: %s (grid %d)\n", hipGetErrorString(e), grid);
#else
    for (int p = 0; p < 9; ++p) { a.ph_lo = p; a.ph_hi = p + 1; hipLaunchKernelGGL(fwd_kernel, dim3(grid), dim3(NWAVES * 64), LDS_BYTES, stream, a); }
#endif
}
```

```cpp
#include <hip/hip_runtime.h>
#include <hip/hip_cooperative_groups.h>
#include <cstdio>
#include <cstdint>
namespace cg = cooperative_groups;

#ifndef REP_P0
#define REP_P0 1
#endif
#ifndef REP_P1
#define REP_P1 1
#endif
#ifndef REP_P2
#define REP_P2 1
#endif
#ifndef REP_MLA
#define REP_MLA 1
#endif
#ifndef REP_SWA
#define REP_SWA 1
#endif
#ifndef REP_P7
#define REP_P7 1
#endif
#ifndef REP_P8
#define REP_P8 1
#endif
#ifndef REP_BAR
#define REP_BAR 1
#endif
#ifndef REP_P4
#define REP_P4 1
#endif
#ifndef REP_P5
#define REP_P5 1
#endif
#ifndef REP_P6
#define REP_P6 1
#endif
#ifndef MK_N_LAUNCHES
#define MK_N_LAUNCHES 1
#endif

#define LAS __attribute__((address_space(3)))
#define GAS __attribute__((address_space(1)))
typedef unsigned short bf16_t;
typedef short bf16x8 __attribute__((ext_vector_type(8)));
typedef short s16x4 __attribute__((ext_vector_type(4)));
typedef float f32x2 __attribute__((ext_vector_type(2)));
typedef float f32x4 __attribute__((ext_vector_type(4)));
typedef float f32x16 __attribute__((ext_vector_type(16)));
typedef unsigned u32x2 __attribute__((ext_vector_type(2)));
typedef unsigned u32x4 __attribute__((ext_vector_type(4)));
typedef __bf16 bf16x2_t __attribute__((ext_vector_type(2)));

constexpr int NB = 8, SEQ = 4096, T = NB * SEQ, DM = 1024, DFF = 2816;
constexpr int INW = 3488, NV1 = 3584;
constexpr int O_QA = 0, O_KA = 512, O_VA = 640, O_QL = 768, O_KVL = 1152, O_KR = 1408, O_GA = 1440, O_GB = 2464;
constexpr float EPS = 1e-6f;
constexpr float LOG2E = 1.4426950408889634f;
constexpr float QA_SCALE = 0.125f * LOG2E;
constexpr float QM_SCALE = 0.10206207261596577f * LOG2E;

constexpr size_t MiB = 1u << 20;
constexpr size_t WS_W1T = 0 * MiB, WS_WUQT = 7 * MiB, WS_WUKVT = 8 * MiB, WS_WOT = 9 * MiB, WS_WOUTT = 11 * MiB, WS_WGUT = 13 * MiB, WS_WDT = 24 * MiB;
constexpr size_t WS_TAB = 30 * MiB;
constexpr size_t WS_SSQ = 32 * MiB;
constexpr size_t WS_XN = 38 * MiB;
constexpr size_t WS_SG = 102 * MiB;
constexpr size_t WS_QA = 230 * MiB;
constexpr size_t WS_KA = 262 * MiB, WS_VA = 270 * MiB;
constexpr size_t WS_QLAT = 278 * MiB, WS_KVLAT = 302 * MiB;
constexpr size_t WS_QM = 318 * MiB, WS_KM = 366 * MiB;
constexpr size_t WS_VM = 414 * MiB, WS_OB = 446 * MiB;
constexpr size_t WS_CTL = 478 * MiB, CTL_BYTES = 16384;
constexpr size_t WS_OA = 479 * MiB;
constexpr size_t WS_END = 511 * MiB;
constexpr size_t WS_Y = WS_QM;
constexpr size_t WS_X2 = WS_QLAT;
constexpr size_t WS_HDN = WS_SG;
static_assert(WS_HDN + (size_t)T * DFF * 2 <= WS_QLAT && WS_Y + (size_t)T * DM * 2 <= WS_VM, "overlays");

constexpr int NWAVES = 8;
constexpr int RING_BYTES = 131072, MISC_OFF = RING_BYTES + 320, LDS_BYTES = 147456;

__device__ __forceinline__ unsigned cvtpk(float lo, float hi) { f32x2 v = {lo, hi}; bf16x2_t b = __builtin_convertvector(v, bf16x2_t); return __builtin_bit_cast(unsigned, b); }
__device__ __forceinline__ u32x4 pack8(f32x4 a, f32x4 b) { u32x4 w; w.x = cvtpk(a[0], a[1]); w.y = cvtpk(a[2], a[3]); w.z = cvtpk(b[0], b[1]); w.w = cvtpk(b[2], b[3]); return w; }
__device__ __forceinline__ u32x2 pack4(f32x4 a) { u32x2 w; w.x = cvtpk(a[0], a[1]); w.y = cvtpk(a[2], a[3]); return w; }
__device__ __forceinline__ float bf_lo(unsigned w) { return __uint_as_float(w << 16); }
__device__ __forceinline__ float bf_hi(unsigned w) { return __uint_as_float(w & 0xffff0000u); }
__device__ __forceinline__ float sigmoidf_fast(float x) { return __builtin_amdgcn_rcpf(1.0f + __builtin_amdgcn_exp2f(-x * LOG2E)); }
__device__ __forceinline__ float wave_sum(float v) {
#pragma unroll
    for (int o = 1; o < 64; o <<= 1) v += __shfl_xor(v, o);
    return v;
}
__device__ __forceinline__ float sumsq4(f32x4 a) { return (a[0] * a[0] + a[1] * a[1]) + (a[2] * a[2] + a[3] * a[3]); }

namespace pg8 {
constexpr int BM = 256, BK = 64, HALF = 128, HTB = HALF * BK * 2, STAGE_BYTES = 8 * HTB, NXCD = 8, WGM = 8;
__host__ __device__ __forceinline__ int lds_byte(int r, int c) { const int st = (r >> 4) * 2 + (c >> 5), rr = r & 15, cc = c & 31, ob = rr * 64 + cc * 2; return st * 1024 + (ob ^ (((ob >> 9) & 1) << 5)); }
__host__ __device__ __forceinline__ void stage_rc(int b, int& R, int& C) { const int st = b / 1024, sb = b % 1024, swz = sb ^ (((sb >> 9) & 1) << 5); R = (st >> 1) * 16 + swz / 64; C = (st & 1) * 32 + (swz % 64) / 2; }
__host__ __device__ __forceinline__ int perm32(int rho) { const int n = rho >> 4, i = rho & 15; return 8 * (i >> 2) + 4 * n + (i & 3); }

struct Unit { int pm, pn, part; };
struct Gemm { const bf16_t* A; const bf16_t* Bt; int lda, ldb, K; size_t tstepA; };

struct TileOrder {
    int nM, nN, nwg, G, c;
    __device__ void init(int nM_, int nN_, int G_, int c_) { nM = nM_; nN = nN_; nwg = nM * nN; G = G_; c = c_; }
    __device__ bool tile(int i, int& pm, int& pn) const {
        const long L = (long)i * G + c; if (L >= nwg) return false;
        int wgid = (int)L; { const int q = nwg / NXCD, r = nwg % NXCD, xcd = wgid % NXCD, off = wgid / NXCD; wgid = (xcd < r ? xcd * (q + 1) : r * (q + 1) + (xcd - r) * q) + off; }
        const int nig = WGM * nN, gid = wgid / nig, fm = gid * WGM, gsz = (nM - fm) < WGM ? (nM - fm) : WGM;
        pm = fm + ((wgid % nig) % gsz); pn = (wgid % nig) / gsz; return true;
    }
};
struct SchedPlain {
    TileOrder o; const Gemm g;
    __device__ bool next(int i, Unit& u) const { u.part = 0; return o.tile(i, u.pm, u.pn); }
    __device__ __forceinline__ void ptrs(const Unit& u, const char*& a, const char*& b) const { a = (const char*)g.A + (size_t)u.pm * g.tstepA; b = (const char*)g.Bt + (size_t)u.pn * BM * g.ldb * 2; }
    __device__ __forceinline__ bool keep(const Unit&) const { return false; }
};
struct SchedPair {
    TileOrder o; const bf16_t* A0; const bf16_t* A1; const bf16_t* Bt; int lda, ldb, K;
    __device__ bool next(int i, Unit& u) const { u.part = i & 1; return o.tile(i >> 1, u.pm, u.pn); }
    __device__ __forceinline__ void ptrs(const Unit& u, const char*& a, const char*& b) const { a = (const char*)(u.part ? A1 : A0) + (size_t)u.pm * BM * lda * 2; b = (const char*)Bt + (size_t)u.pn * BM * ldb * 2 + (size_t)u.part * K * 2; }
    __device__ __forceinline__ bool keep(const Unit& u) const { return u.part == 0; }
};

template <class Epi, class Sched, bool ALIGN_EPI, bool SP2>
__device__ __forceinline__ void gemm_phase(LAS unsigned char* lds, const int lda, const int ldb, const int K, const Sched& S, const Epi& E, const int kstepA_ = BK * 2) {
    const int tid = threadIdx.x, wid = __builtin_amdgcn_readfirstlane(tid >> 6), lane = tid & 63, wr = wid >> 2, wc = wid & 3, fr = lane & 15, fq = lane >> 4;
    const int nt = K / BK;
    unsigned voffA[2], voffB[2];
#pragma unroll
    for (int i = 0; i < 2; ++i) { int R, C; stage_rc(tid * 16 + i * 8192, R, C); const int Rb = (R & ~31) + perm32(R & 31);
        voffA[i] = (unsigned)(R * lda + C) * 2u; voffB[i] = (unsigned)(Rb * ldb + C) * 2u; }
    const size_t kstep = (size_t)(BK * 2), kstepA = (size_t)kstepA_;
    const size_t hstepA = (size_t)HALF * lda * 2, hstepB = (size_t)HALF * ldb * 2;
    const unsigned ldsw = (unsigned)wid * 1024u;
    const int aoff = lds_byte(wr * 64 + fr, fq * 8), boff = lds_byte(wc * 32 + fr, fq * 8);
#define PG8_SA(b, h) (((b) * 2 + (h)) * HTB)
#define PG8_SB(b, h) ((4 + (b) * 2 + (h)) * HTB)
#define PG8_STAGE(bufoff, gbase, voff) do { _Pragma("unroll") for (int _i = 0; _i < 2; ++_i) \
        __builtin_amdgcn_global_load_lds((const unsigned*)((const char*)(gbase) + (voff)[_i]), (LAS unsigned*)(lds + (bufoff) + ldsw + _i * 8192), 16, 0, 0); } while (0)
#define PG8_LDA(dst, b, h) do { _Pragma("unroll") for (int m = 0; m < 4; ++m) _Pragma("unroll") for (int k = 0; k < 2; ++k) dst[m][k] = *(const LAS bf16x8*)(lds + PG8_SA(b, h) + aoff + m * 2048 + k * 1024); } while (0)
#define PG8_LDB(dst, b, h) do { _Pragma("unroll") for (int n = 0; n < 2; ++n) _Pragma("unroll") for (int k = 0; k < 2; ++k) dst[n][k] = *(const LAS bf16x8*)(lds + PG8_SB(b, h) + boff + n * 2048 + k * 1024); } while (0)
#define PG8_MMA(ai, bj, At, Bt) do { __builtin_amdgcn_s_setprio(1); _Pragma("unroll") for (int m = 0; m < 4; ++m) _Pragma("unroll") for (int n = 0; n < 2; ++n) _Pragma("unroll") for (int k = 0; k < 2; ++k) \
        acc[ai][bj][m][n] = __builtin_amdgcn_mfma_f32_16x16x32_bf16(Bt[n][k], At[m][k], acc[ai][bj][m][n], 0, 0, 0); __builtin_amdgcn_s_setprio(0); } while (0)
#define PG8_WAIT_V(n) asm volatile("s_waitcnt vmcnt(" #n ")" ::: "memory")
#define PG8_WAIT_L(n) asm volatile("s_waitcnt lgkmcnt(" #n ")" ::: "memory")
#define PG8_BAR __builtin_amdgcn_s_barrier()
#define PG8_SCHED __builtin_amdgcn_sched_barrier(0)
    Unit cur, nxt; int ui = 0;
    if (!S.next(0, cur)) return;
    f32x4 acc[2][2][4][2];
#pragma unroll
    for (int a = 0; a < 2; ++a)
#pragma unroll
        for (int b = 0; b < 2; ++b)
#pragma unroll
            for (int m = 0; m < 4; ++m)
#pragma unroll
                for (int n = 0; n < 2; ++n) acc[a][b][m][n] = (f32x4){0.f, 0.f, 0.f, 0.f};
    bf16x8 At[4][2], B0[2][2], B1[2][2];
    const char* cA; const char* cB; S.ptrs(cur, cA, cB);
    if constexpr (SP2) {
        PG8_STAGE(PG8_SB(0, 0), cB, voffB); PG8_STAGE(PG8_SB(0, 1), cB + hstepB, voffB); PG8_STAGE(PG8_SA(0, 0), cA, voffA); PG8_STAGE(PG8_SA(0, 1), cA + hstepA, voffA);
        if (wr == 1) PG8_BAR;
        PG8_WAIT_V(2); PG8_BAR;
        PG8_STAGE(PG8_SB(1, 0), cB + kstep, voffB); PG8_STAGE(PG8_SA(1, 0), cA + kstepA, voffA); PG8_STAGE(PG8_SB(1, 1), cB + hstepB + kstep, voffB);
        PG8_WAIT_V(6); PG8_BAR;
    } else {
        PG8_STAGE(PG8_SB(0, 0), cB, voffB); PG8_STAGE(PG8_SA(0, 0), cA, voffA); PG8_STAGE(PG8_SB(0, 1), cB + hstepB, voffB); PG8_STAGE(PG8_SA(0, 1), cA + hstepA, voffA);
        if (wr == 1) PG8_BAR;
        PG8_WAIT_V(4); PG8_BAR;
        PG8_STAGE(PG8_SB(1, 0), cB + kstep, voffB); PG8_STAGE(PG8_SA(1, 0), cA + kstepA, voffA); PG8_STAGE(PG8_SB(1, 1), cB + hstepB + kstep, voffB);
        PG8_WAIT_V(6); PG8_BAR;
    }
    for (;;) {
        const bool has_next = S.next(ui + 1, nxt);
        const char* nA = cA; const char* nB = cB; if (has_next) S.ptrs(nxt, nA, nB);
#pragma unroll 1
        for (int t = 0; t < nt; t += 2) {
            const bool last = (t == nt - 2);
            const char* a1 = cA + (size_t)(t + 1) * kstepA;
            const char* a2 = last ? nA : cA + (size_t)(t + 2) * kstepA; const char* b2 = last ? nB : cB + (size_t)(t + 2) * kstep;
            const char* a3 = a2 + kstepA; const char* b3 = b2 + kstep;
            if constexpr (SP2) {
            PG8_LDB(B0, 0, 0); PG8_LDB(B1, 0, 1); PG8_SCHED; PG8_LDA(At, 0, 0); PG8_STAGE(PG8_SA(1, 1), a1 + hstepA, voffA);
            PG8_WAIT_V(8); PG8_WAIT_L(0); PG8_BAR; PG8_MMA(0, 0, At, B0); PG8_MMA(0, 1, At, B1); PG8_BAR; PG8_SCHED;
            PG8_LDA(At, 0, 1); PG8_STAGE(PG8_SB(0, 0), b2, voffB); PG8_STAGE(PG8_SB(0, 1), b2 + hstepB, voffB); PG8_STAGE(PG8_SA(0, 0), a2, voffA);
            PG8_WAIT_V(8); PG8_WAIT_L(0); PG8_BAR; PG8_MMA(1, 0, At, B0); PG8_MMA(1, 1, At, B1); PG8_BAR; PG8_SCHED;
            PG8_LDB(B0, 1, 0); PG8_LDB(B1, 1, 1); PG8_SCHED; PG8_LDA(At, 1, 0); PG8_STAGE(PG8_SA(0, 1), a2 + hstepA, voffA);
            PG8_WAIT_V(8); PG8_WAIT_L(0); PG8_BAR; PG8_MMA(0, 0, At, B0); PG8_MMA(0, 1, At, B1); PG8_BAR; PG8_SCHED;
            PG8_LDA(At, 1, 1); PG8_STAGE(PG8_SB(1, 0), b3, voffB); PG8_STAGE(PG8_SB(1, 1), b3 + hstepB, voffB); PG8_STAGE(PG8_SA(1, 0), a3, voffA);
            PG8_WAIT_V(8); PG8_WAIT_L(0); PG8_BAR; PG8_MMA(1, 0, At, B0); PG8_MMA(1, 1, At, B1); PG8_BAR; PG8_SCHED;
            } else {
            PG8_LDB(B0, 0, 0); PG8_SCHED; PG8_LDA(At, 0, 0); PG8_STAGE(PG8_SA(1, 1), a1 + hstepA, voffA);
            PG8_WAIT_L(8); PG8_BAR; PG8_WAIT_L(0); PG8_MMA(0, 0, At, B0); PG8_BAR; PG8_SCHED;
            PG8_LDB(B1, 0, 1); PG8_STAGE(PG8_SB(0, 0), b2, voffB);
            PG8_BAR; PG8_WAIT_L(0); PG8_MMA(0, 1, At, B1); PG8_BAR;
            PG8_LDA(At, 0, 1); PG8_STAGE(PG8_SA(0, 0), a2, voffA);
            PG8_BAR; PG8_WAIT_L(0); PG8_MMA(1, 0, At, B0); PG8_BAR; PG8_SCHED;
            PG8_STAGE(PG8_SB(0, 1), b2 + hstepB, voffB);
            PG8_WAIT_V(6); PG8_BAR; PG8_MMA(1, 1, At, B1); PG8_BAR;
            PG8_LDB(B0, 1, 0); PG8_SCHED; PG8_LDA(At, 1, 0); PG8_STAGE(PG8_SA(0, 1), a2 + hstepA, voffA);
            PG8_WAIT_L(8); PG8_BAR; PG8_WAIT_L(0); PG8_MMA(0, 0, At, B0); PG8_BAR; PG8_SCHED;
            PG8_LDB(B1, 1, 1); PG8_STAGE(PG8_SB(1, 0), b3, voffB);
            PG8_BAR; PG8_WAIT_L(0); PG8_MMA(0, 1, At, B1); PG8_BAR;
            PG8_LDA(At, 1, 1); PG8_STAGE(PG8_SA(1, 0), a3, voffA);
            PG8_BAR; PG8_WAIT_L(0); PG8_MMA(1, 0, At, B0); PG8_BAR; PG8_SCHED;
            PG8_STAGE(PG8_SB(1, 1), b3 + hstepB, voffB);
            PG8_WAIT_V(6); PG8_BAR; PG8_MMA(1, 1, At, B1); PG8_BAR;
            }
        }
        if constexpr (ALIGN_EPI) { if (wr == 0) PG8_BAR; }
        E(acc, cur, wr, wc, fr, fq);
        if (!has_next) break;
        if (!S.keep(cur)) {
#pragma unroll
        for (int a = 0; a < 2; ++a)
#pragma unroll
            for (int b = 0; b < 2; ++b)
#pragma unroll
                for (int m = 0; m < 4; ++m)
#pragma unroll
                    for (int n = 0; n < 2; ++n) acc[a][b][m][n] = (f32x4){0.f, 0.f, 0.f, 0.f};
        }
        cur = nxt; cA = nA; cB = nB; ++ui;
        if constexpr (ALIGN_EPI) { if (wr == 1) PG8_BAR; }
    }
    PG8_WAIT_V(0);
    if constexpr (!ALIGN_EPI) { if (wr == 0) PG8_BAR; }
    PG8_BAR;
#undef PG8_SA
#undef PG8_SB
#undef PG8_STAGE
#undef PG8_LDA
#undef PG8_LDB
#undef PG8_MMA
#undef PG8_WAIT_V
#undef PG8_WAIT_L
#undef PG8_BAR
#undef PG8_SCHED
}
}
using pg8::Unit;

struct EpiProj {
    bf16_t *QA, *KA, *VA, *QLAT, *KVLAT, *KM, *SG; float *SSQ_Q, *SSQ_KV; const float *cosA, *sinA, *cosB, *sinB;
    __device__ __forceinline__ void operator()(f32x4 (&acc)[2][2][4][2], const Unit& u, int wr, int wc, int fr, int fq) const {
        const int pn = u.pn, rbase = u.pm * 256 + wr * 64 + fr;
        if (pn <= 2) {
#pragma unroll
            for (int ai = 0; ai < 2; ++ai)
#pragma unroll
                for (int m = 0; m < 4; ++m) {
                    const int r = rbase + ai * 128 + m * 16, pos = r & (SEQ - 1);
                    const int d0 = 4 * (4 * (wc & 1) + fq);
                    const f32x4 c4 = *(const f32x4*)(cosA + pos * 32 + d0), s4 = *(const f32x4*)(sinA + pos * 32 + d0);
#pragma unroll
                    for (int bj = 0; bj < 2; ++bj) {
                        if (pn == 2 && bj == 1) { *(u32x4*)(VA + (size_t)r * 128 + 32 * wc + 8 * fq) = pack8(acc[ai][1][m][0], acc[ai][1][m][1]); }
                        else {
                            const f32x4 x1 = acc[ai][bj][m][0], x2 = acc[ai][bj][m][1];
                            f32x4 o1 = x1 * c4 - x2 * s4, o2 = x2 * c4 + x1 * s4;
                            bf16_t* dst;
                            if (pn < 2) { o1 = o1 * QA_SCALE; o2 = o2 * QA_SCALE; dst = QA + (size_t)r * 512 + (4 * pn + 2 * bj + (wc >> 1)) * 64 + d0; }
                            else dst = KA + (size_t)r * 128 + (wc >> 1) * 64 + d0;
                            *(u32x2*)dst = pack4(o1); *(u32x2*)(dst + 32) = pack4(o2);
                        }
                    }
                }
        } else if (pn <= 5) {
#pragma unroll
            for (int ai = 0; ai < 2; ++ai)
#pragma unroll
                for (int m = 0; m < 4; ++m) {
                    const int r = rbase + ai * 128 + m * 16, pos = r & (SEQ - 1);
                    float q = sumsq4(acc[ai][0][m][0]) + sumsq4(acc[ai][0][m][1]);
                    if (pn != 4) q += sumsq4(acc[ai][1][m][0]) + sumsq4(acc[ai][1][m][1]);
                    q += __shfl_xor(q, 16); q += __shfl_xor(q, 32);
                    if (pn == 3) {
                        *(u32x4*)(QLAT + (size_t)r * 384 + 32 * wc + 8 * fq) = pack8(acc[ai][0][m][0], acc[ai][0][m][1]);
                        *(u32x4*)(QLAT + (size_t)r * 384 + 128 + 32 * wc + 8 * fq) = pack8(acc[ai][1][m][0], acc[ai][1][m][1]);
                        if (fq == 0) SSQ_Q[(size_t)r * 8 + wc] = q;
                    } else if (pn == 4) {
                        *(u32x4*)(QLAT + (size_t)r * 384 + 256 + 32 * wc + 8 * fq) = pack8(acc[ai][0][m][0], acc[ai][0][m][1]);
                        if (fq == 0) SSQ_Q[(size_t)r * 8 + 4 + wc] = q;
                        if (wc == 0) {
                            const int i0 = 4 * fq;
                            const f32x4 c4 = *(const f32x4*)(cosB + pos * 16 + i0), s4 = *(const f32x4*)(sinB + pos * 16 + i0);
                            const f32x4 x1 = acc[ai][1][m][0], x2 = acc[ai][1][m][1];
                            const u32x2 w1 = pack4(x1 * c4 - x2 * s4), w2 = pack4(x2 * c4 + x1 * s4);
#pragma unroll
                            for (int h = 0; h < 8; ++h) { bf16_t* dst = KM + (size_t)r * 768 + h * 96 + 64 + i0; *(u32x2*)dst = w1; *(u32x2*)(dst + 16) = w2; }
                        }
                    } else {
                        *(u32x4*)(KVLAT + (size_t)r * 256 + 32 * wc + 8 * fq) = pack8(acc[ai][0][m][0], acc[ai][0][m][1]);
                        *(u32x4*)(KVLAT + (size_t)r * 256 + 128 + 32 * wc + 8 * fq) = pack8(acc[ai][1][m][0], acc[ai][1][m][1]);
                        if (fq == 0) SSQ_KV[(size_t)r * 4 + wc] = q;
                    }
                }
        } else {
            const int cb = (pn - 6) * 256 + 32 * wc + 8 * fq;
#pragma unroll
            for (int ai = 0; ai < 2; ++ai)
#pragma unroll
                for (int m = 0; m < 4; ++m) {
                    const int r = rbase + ai * 128 + m * 16;
#pragma unroll
                    for (int bj = 0; bj < 2; ++bj) {
                        f32x4 a = acc[ai][bj][m][0], b = acc[ai][bj][m][1];
#pragma unroll
                        for (int e = 0; e < 4; ++e) { a[e] = sigmoidf_fast(a[e]); b[e] = sigmoidf_fast(b[e]); }
                        *(u32x4*)(SG + (size_t)r * 2048 + cb + 128 * bj) = pack8(a, b);
                    }
                }
        }
    }
};

struct EpiUQ {
    bf16_t* QM; const float* SSQ_Q; const float *cosB, *sinB;
    __device__ __forceinline__ void operator()(f32x4 (&acc)[2][2][4][2], const Unit& u, int wr, int wc, int fr, int fq) const {
        const int pn = u.pn, rbase = u.pm * 256 + wr * 64 + fr;
#pragma unroll
        for (int ai = 0; ai < 2; ++ai)
#pragma unroll
            for (int m = 0; m < 4; ++m) {
                const int r = rbase + ai * 128 + m * 16, pos = r & (SEQ - 1);
                const f32x4 sa = *(const f32x4*)(SSQ_Q + (size_t)r * 8), sb = *(const f32x4*)(SSQ_Q + (size_t)r * 8 + 4);
                const float ss = ((sa[0] + sa[1]) + (sa[2] + sa[3])) + ((sb[0] + sb[1]) + (sb[2] + sb[3]));
                const float rs = __builtin_amdgcn_rsqf(ss * (1.0f / 384.0f) + EPS) * QM_SCALE;
                if (pn < 2) {
#pragma unroll
                    for (int bj = 0; bj < 2; ++bj)
                        *(u32x4*)(QM + (size_t)r * 768 + (4 * pn + 2 * bj + (wc >> 1)) * 96 + 32 * (wc & 1) + 8 * fq) = pack8(acc[ai][bj][m][0] * rs, acc[ai][bj][m][1] * rs);
                } else {
                    const int i0 = 4 * fq;
                    const f32x4 c4 = *(const f32x4*)(cosB + pos * 16 + i0), s4 = *(const f32x4*)(sinB + pos * 16 + i0);
#pragma unroll
                    for (int bj = 0; bj < 2; ++bj) {
                        const f32x4 x1 = acc[ai][bj][m][0] * rs, x2 = acc[ai][bj][m][1] * rs;
                        bf16_t* dst = QM + (size_t)r * 768 + (4 * bj + wc) * 96 + 64 + i0;
                        *(u32x2*)dst = pack4(x1 * c4 - x2 * s4); *(u32x2*)(dst + 16) = pack4(x2 * c4 + x1 * s4);
                    }
                }
                asm volatile("" ::: "memory");
            }
    }
};
struct EpiUKV {
    bf16_t *KM, *VM; const float* SSQ_KV;
    __device__ __forceinline__ void operator()(f32x4 (&acc)[2][2][4][2], const Unit& u, int wr, int wc, int fr, int fq) const {
        const int pn = u.pn, rbase = u.pm * 256 + wr * 64 + fr;
#pragma unroll
        for (int ai = 0; ai < 2; ++ai)
#pragma unroll
            for (int m = 0; m < 4; ++m) {
                const int r = rbase + ai * 128 + m * 16;
                const f32x4 sa = *(const f32x4*)(SSQ_KV + (size_t)r * 4);
                const float rs = __builtin_amdgcn_rsqf(((sa[0] + sa[1]) + (sa[2] + sa[3])) * (1.0f / 256.0f) + EPS);
#pragma unroll
                for (int bj = 0; bj < 2; ++bj) {
                    const int h = 4 * (pn & 1) + 2 * bj + (wc >> 1), d = 32 * (wc & 1) + 8 * fq;
                    bf16_t* dst = (pn < 2) ? KM + (size_t)r * 768 + h * 96 + d : VM + (size_t)r * 512 + h * 64 + d;
                    *(u32x4*)dst = pack8(acc[ai][bj][m][0] * rs, acc[ai][bj][m][1] * rs);
                }
                asm volatile("" ::: "memory");
            }
    }
};
struct EpiGate {
    const bf16_t* SG; bf16_t* Y;
    __device__ __forceinline__ void operator()(f32x4 (&acc)[2][2][4][2], const Unit& u, int wr, int wc, int fr, int fq) const {
        const int rbase = u.pm * 256 + wr * 64 + fr, cb = u.pn * 256 + 32 * wc + 8 * fq;
#pragma unroll
        for (int ai = 0; ai < 2; ++ai)
#pragma unroll
            for (int m = 0; m < 4; ++m) {
                const int r = rbase + ai * 128 + m * 16;
#pragma unroll
                for (int bj = 0; bj < 2; ++bj) {
                    const int c = cb + 128 * bj;
                    const u32x4 wb = *(const u32x4*)(SG + (size_t)r * 2048 + 1024 + c);
                    f32x4 b0 = {bf_lo(wb.x), bf_hi(wb.x), bf_lo(wb.y), bf_hi(wb.y)}, b1 = {bf_lo(wb.z), bf_hi(wb.z), bf_lo(wb.w), bf_hi(wb.w)};
                    if (u.part == 0) {
                        const u32x4 wa = *(const u32x4*)(SG + (size_t)r * 2048 + c);
                        const f32x4 a0 = {bf_lo(wa.x), bf_hi(wa.x), bf_lo(wa.y), bf_hi(wa.y)}, a1 = {bf_lo(wa.z), bf_hi(wa.z), bf_lo(wa.w), bf_hi(wa.w)};
#pragma unroll
                        for (int e = 0; e < 4; ++e) { acc[ai][bj][m][0][e] *= a0[e] * __builtin_amdgcn_rcpf(b0[e]); acc[ai][bj][m][1][e] *= a1[e] * __builtin_amdgcn_rcpf(b1[e]); }
                    } else {
                        *(u32x4*)(Y + (size_t)r * 1024 + c) = pack8(acc[ai][bj][m][0] * b0, acc[ai][bj][m][1] * b1);
                    }
                }
            }
    }
};
struct EpiRes1 {
    const float* X; float* OUT; bf16_t* X1B; float* SSQ;
    __device__ __forceinline__ void operator()(f32x4 (&acc)[2][2][4][2], const Unit& u, int wr, int wc, int fr, int fq) const {
        const int rbase = u.pm * 256 + wr * 64 + fr, cb = u.pn * 256 + 32 * wc + 8 * fq;
#pragma unroll
        for (int ai = 0; ai < 2; ++ai)
#pragma unroll
            for (int m = 0; m < 4; ++m) {
                const int r = rbase + ai * 128 + m * 16; float q = 0.f;
#pragma unroll
                for (int bj = 0; bj < 2; ++bj) {
                    const size_t o = (size_t)r * 1024 + cb + 128 * bj;
                    const f32x4 v0 = *(const f32x4*)(X + o) + acc[ai][bj][m][0], v1 = *(const f32x4*)(X + o + 4) + acc[ai][bj][m][1];
                    *(f32x4*)(OUT + o) = v0; *(f32x4*)(OUT + o + 4) = v1; *(u32x4*)(X1B + o) = pack8(v0, v1);
                    q += sumsq4(v0) + sumsq4(v1);
                }
                q += __shfl_xor(q, 16); q += __shfl_xor(q, 32);
                if (fq == 0) SSQ[(size_t)r * 16 + 4 * u.pn + wc] = q;
            }
    }
};
struct EpiSwiglu {
    const float* SSQ; bf16_t* HDN;
    __device__ __forceinline__ void operator()(f32x4 (&acc)[2][2][4][2], const Unit& u, int wr, int wc, int fr, int fq) const {
        const int rbase = u.pm * 256 + wr * 64 + fr, cb = u.pn * 128 + 32 * wc + 8 * fq;
#pragma unroll
        for (int ai = 0; ai < 2; ++ai)
#pragma unroll
            for (int m = 0; m < 4; ++m) {
                const int r = rbase + ai * 128 + m * 16;
                float ss = 0.f;
#pragma unroll
                for (int i = 0; i < 4; ++i) { const f32x4 s4 = *(const f32x4*)(SSQ + (size_t)r * 16 + 4 * i); ss += (s4[0] + s4[1]) + (s4[2] + s4[3]); }
                const float rs = __builtin_amdgcn_rsqf(ss * (1.0f / 1024.0f) + EPS);
                f32x4 h0, h1;
#pragma unroll
                for (int e = 0; e < 4; ++e) {
                    const float g0 = acc[ai][0][m][0][e] * rs, g1 = acc[ai][0][m][1][e] * rs;
                    h0[e] = g0 * sigmoidf_fast(g0) * (acc[ai][1][m][0][e] * rs); h1[e] = g1 * sigmoidf_fast(g1) * (acc[ai][1][m][1][e] * rs);
                }
                *(u32x4*)(HDN + (((size_t)u.pm * (DFF / 64) + (cb >> 6)) * 256 + (r & 255)) * 64 + (cb & 63)) = pack8(h0, h1);
            }
    }
};
struct EpiRes2 {
    const float* X1; float* OUT; float* SSQ;
    __device__ __forceinline__ void operator()(f32x4 (&acc)[2][2][4][2], const Unit& u, int wr, int wc, int fr, int fq) const {
        const int rbase = u.pm * 256 + wr * 64 + fr, cb = u.pn * 256 + 32 * wc + 8 * fq;
#pragma unroll
        for (int ai = 0; ai < 2; ++ai)
#pragma unroll
            for (int m = 0; m < 4; ++m) {
                const int r = rbase + ai * 128 + m * 16; float q = 0.f;
#pragma unroll
                for (int bj = 0; bj < 2; ++bj) {
                    const size_t o = (size_t)r * 1024 + cb + 128 * bj;
                    const f32x4 v0 = *(const f32x4*)(X1 + o) + acc[ai][bj][m][0], v1 = *(const f32x4*)(X1 + o + 4) + acc[ai][bj][m][1];
                    *(f32x4*)(OUT + o) = v0; *(f32x4*)(OUT + o + 4) = v1;
                    q += sumsq4(v0) + sumsq4(v1);
                }
                q += __shfl_xor(q, 16); q += __shfl_xor(q, 32);
                if (fq == 0) SSQ[(size_t)r * 16 + 4 * u.pn + wc] = q;
            }
    }
};

namespace att {
constexpr int KSLOT = 12288, VSLOT = 8192, NKSL = 2, NVSL = 3;
constexpr int LDS_K = 0, LDS_V = NKSL * KSLOT, LDS_WS = LDS_V + NVSL * VSLOT, LDS_OST = LDS_WS + NWAVES * 256, LDS_TOTAL = LDS_OST + NWAVES * 4096;
static_assert(LDS_TOTAL <= RING_BYTES, "attention LDS");
constexpr float THR = 6.0f;
__device__ __forceinline__ int crow(int r, int hi) { return (r & 3) + 8 * (r >> 2) + 4 * hi; }
__device__ __forceinline__ void glds16(const void* g, unsigned lds_base) {
    unsigned sv; asm volatile("s_mov_b32 %0, m0\n\ts_mov_b32 m0, %2\n\ts_nop 0\n\tglobal_load_lds_dwordx4 %1, off\n\ts_mov_b32 m0, %0" : "=&s"(sv) : "v"(g), "s"(lds_base) : "memory"); }
#define ATT_WAIT_BAR() asm volatile("s_waitcnt vmcnt(0) lgkmcnt(0)\n\ts_barrier" ::: "memory")
#define MX3(a, b, c) __builtin_fmaxf(__builtin_fmaxf((a), (b)), (c))
__device__ __forceinline__ float rowmax(const f32x16& p0, const f32x16& p1) {
    float a = MX3(p0[0], p0[1], p1[0]), b = MX3(p0[2], p0[3], p1[1]); a = MX3(a, p1[2], p1[3]);
#pragma unroll
    for (int r = 4; r < 16; r += 4) { a = MX3(a, p0[r], p0[r + 1]); b = MX3(b, p0[r + 2], p0[r + 3]); a = MX3(a, p1[r], p1[r + 1]); b = MX3(b, p1[r + 2], p1[r + 3]); }
    float m = __builtin_fmaxf(a, b); auto rr = __builtin_amdgcn_permlane32_swap(__float_as_uint(m), __float_as_uint(m), false, false);
    return __builtin_fmaxf(__uint_as_float(rr[0]), __uint_as_float(rr[1])); }
typedef short v4i16_t __attribute__((ext_vector_type(4)));
__device__ __forceinline__ s16x4 vtr(const LAS char* p) { return __builtin_bit_cast(s16x4, __builtin_amdgcn_ds_read_tr16_b64_v4i16((LAS v4i16_t*)p)); }

template <int DQK, bool SWA>
__device__ __forceinline__ void unit(const bf16_t* Qw, int qpitch, const bf16_t* Kb, int kpitch, const bf16_t* Vb, int vpitch, bf16_t* Ow, int opitch,
                                     int pos0, int t0, int t1, int band_from, float m_init, float l_init, LAS unsigned char* lds) {
    constexpr int NKS = DQK / 16, NCH = DQK / 8;
    constexpr bool FIRST_REF = !SWA;
    const int tid = threadIdx.x, lane = tid & 63, r32 = lane & 31, hi = lane >> 5; const int wid = __builtin_amdgcn_readfirstlane(tid >> 6);
#ifndef ATT_LATE
#define ATT_LATE (wid >= 4)
#endif
    const bool late = ATT_LATE;
    const unsigned lds0 = (unsigned)(uintptr_t)lds;
    LAS float* wsf = (LAS float*)(lds + LDS_WS) + wid * 64;
    const bf16_t* ksrc = Kb + (size_t)lane * kpitch + wid * 8;
    const bf16_t* vsrc = Vb + (size_t)(16 * (wid & 3) + (lane >> 2)) * vpitch + (wid >> 2) * 32 + (lane & 3) * 8;
    const unsigned kdst = lds0 + LDS_K + wid * 1024, vdst = lds0 + LDS_V + wid * 1024;
#define ATT_DMA(t, ks, vs) do { glds16(ksrc + (size_t)(t) * 64 * kpitch, (unsigned)__builtin_amdgcn_readfirstlane(kdst + (ks) * KSLOT)); \
        if (NCH > 8 && wid + 8 < NCH) glds16(ksrc + (size_t)(t) * 64 * kpitch + 64, (unsigned)__builtin_amdgcn_readfirstlane(kdst + (ks) * KSLOT + 8192)); \
        glds16(vsrc + (size_t)(t) * 64 * vpitch, (unsigned)__builtin_amdgcn_readfirstlane(vdst + (vs) * VSLOT)); } while (0)
    ATT_DMA(t0, 0, 0);
    bf16x8 qr[NKS];
#pragma unroll
    for (int d0 = 0; d0 < NKS; ++d0) qr[d0] = *(const bf16x8*)(Qw + (size_t)r32 * qpitch + d0 * 16 + hi * 8);
    float mrun = FIRST_REF ? 0.f : m_init, l_reg = (hi == 0) ? l_init : 0.f; f32x16 o[2]; o[0] = f32x16{}; o[1] = f32x16{};
    f32x16 negm;
#pragma unroll
    for (int r = 0; r < 16; ++r) negm[r] = -mrun;
    asm volatile("" : "+v"(negm));
    const int qpos = pos0 + r32;
    f32x16 p0, p1;
    const LAS char* vlane = (const LAS char*)(lds + LDS_V) + ((lane >> 4) & 1) * 32 + (lane & 3) * 8 + (4 * hi + ((lane & 15) >> 2)) * 64;
    const LAS unsigned char* klane = lds + LDS_K + hi * 1024 + r32 * 16;

#define ATT_QK(ks) do { const LAS unsigned char* kb_ = klane + (ks) * KSLOT; bf16x8 kf[2 * NKS]; \
        _Pragma("unroll") for (int d0 = 0; d0 < NKS; ++d0) { kf[2 * d0] = *(const LAS bf16x8*)(kb_ + d0 * 2048); kf[2 * d0 + 1] = *(const LAS bf16x8*)(kb_ + d0 * 2048 + 512); } \
        __builtin_amdgcn_sched_barrier(0); \
        _Pragma("unroll") for (int d0 = 0; d0 < NKS; ++d0) { \
            if (d0 == 0) { p0 = __builtin_amdgcn_mfma_f32_32x32x16_bf16(kf[0], qr[0], negm, 0, 0, 0); p1 = __builtin_amdgcn_mfma_f32_32x32x16_bf16(kf[1], qr[0], negm, 0, 0, 0); } \
            else { p0 = __builtin_amdgcn_mfma_f32_32x32x16_bf16(kf[2 * d0], qr[d0], p0, 0, 0, 0); p1 = __builtin_amdgcn_mfma_f32_32x32x16_bf16(kf[2 * d0 + 1], qr[d0], p1, 0, 0, 0); } } } while (0)
#define ATT_SMPV(tt, vs) do { \
        const LAS char* vp = vlane + (vs) * VSLOT; s16x4 vlo[8], vhh[8]; \
        _Pragma("unroll") for (int i_ = 0; i_ < 8; ++i_) { vlo[i_] = vtr(vp + (i_ >> 2) * 4096 + (i_ & 3) * 1024); vhh[i_] = vtr(vp + (i_ >> 2) * 4096 + (i_ & 3) * 1024 + 512); } \
        __builtin_amdgcn_sched_barrier(0); \
        if (SWA || (tt) >= band_from) { const int kb0 = (tt) * 64 + 4 * hi; \
            _Pragma("unroll") for (int r = 0; r < 16; ++r) { const int kv = kb0 + (r & 3) + 8 * (r >> 2); \
                bool ok0 = kv <= qpos, ok1 = kv + 32 <= qpos; if (SWA) { ok0 = ok0 && (kv > qpos - 128); ok1 = ok1 && (kv + 32 > qpos - 128); } \
                if (!ok0) p0[r] = -__builtin_inff(); if (!ok1) p1[r] = -__builtin_inff(); } } \
        const float rm = rowmax(p0, p1); \
        const bool first_ = FIRST_REF && (tt) == t0; \
        if (first_ || __any(rm > THR)) { \
            const float dl = first_ ? rm : __builtin_fmaxf(rm, 0.f); mrun += dl; \
            _Pragma("unroll") for (int r = 0; r < 16; ++r) { p0[r] -= dl; p1[r] -= dl; } \
            _Pragma("unroll") for (int r = 0; r < 16; ++r) negm[r] = -mrun; \
            asm volatile("" : "+v"(negm)); \
            if (!first_) { const float f = __builtin_amdgcn_exp2f(-dl); l_reg *= f; if (hi == 0) wsf[r32] = f; \
                _Pragma("unroll") for (int r = 0; r < 16; ++r) { const float fr_ = wsf[crow(r, hi)]; o[0][r] *= fr_; o[1][r] *= fr_; } } } \
        float sa0 = 0.f, sa1 = 0.f, sa2 = 0.f, sa3 = 0.f; \
        _Pragma("unroll") for (int r = 0; r < 16; r += 2) { p0[r] = __builtin_amdgcn_exp2f(p0[r]); p1[r] = __builtin_amdgcn_exp2f(p1[r]); p0[r + 1] = __builtin_amdgcn_exp2f(p0[r + 1]); p1[r + 1] = __builtin_amdgcn_exp2f(p1[r + 1]); \
            sa0 += p0[r]; sa1 += p1[r]; sa2 += p0[r + 1]; sa3 += p1[r + 1]; } \
        l_reg += (sa0 + sa1) + (sa2 + sa3); \
        u32x4 pw[4]; \
        pw[0] = (u32x4){cvtpk(p0[0], p0[1]), cvtpk(p0[2], p0[3]), cvtpk(p0[4], p0[5]), cvtpk(p0[6], p0[7])}; \
        pw[1] = (u32x4){cvtpk(p0[8], p0[9]), cvtpk(p0[10], p0[11]), cvtpk(p0[12], p0[13]), cvtpk(p0[14], p0[15])}; \
        pw[2] = (u32x4){cvtpk(p1[0], p1[1]), cvtpk(p1[2], p1[3]), cvtpk(p1[4], p1[5]), cvtpk(p1[6], p1[7])}; \
        pw[3] = (u32x4){cvtpk(p1[8], p1[9]), cvtpk(p1[10], p1[11]), cvtpk(p1[12], p1[13]), cvtpk(p1[14], p1[15])}; \
        _Pragma("unroll") for (int d0 = 0; d0 < 2; ++d0) _Pragma("unroll") for (int ks_ = 0; ks_ < 4; ++ks_) { \
            const s16x4 lo = vlo[d0 * 4 + ks_], hh = vhh[d0 * 4 + ks_]; \
            const bf16x8 vf = (bf16x8){lo[0], lo[1], lo[2], lo[3], hh[0], hh[1], hh[2], hh[3]}; \
            o[d0] = __builtin_amdgcn_mfma_f32_32x32x16_bf16(__builtin_bit_cast(bf16x8, pw[ks_]), vf, o[d0], 0, 0, 0); } } while (0)

    ATT_WAIT_BAR();
    if (t0 + 1 < t1) ATT_DMA(t0 + 1, 1, 1);
    int ks = 0, vs = 0;
#pragma unroll 1
    for (int t = t0; t < t1; ++t) {
        const int ksn = ks ^ 1, vsn = (vs == NVSL - 1) ? 0 : vs + 1, vsnn = (vsn == NVSL - 1) ? 0 : vsn + 1;
        ATT_QK(ks);
        if (late && t + 1 < t1) { ATT_WAIT_BAR(); if (t + 2 < t1) ATT_DMA(t + 2, ks, vsnn); }
        ATT_SMPV(t, vs);
        if (!late && t + 1 < t1) { ATT_WAIT_BAR(); if (t + 2 < t1) ATT_DMA(t + 2, ks, vsnn); }
        ks = ksn; vs = vsn;
    }
    { auto rr = __builtin_amdgcn_permlane32_swap(__float_as_uint(l_reg), __float_as_uint(l_reg), false, false); l_reg = __uint_as_float(rr[0]) + __uint_as_float(rr[1]); }
    if (hi == 0) wsf[32 + r32] = l_reg;
    float rli[16];
#pragma unroll
    for (int r = 0; r < 16; ++r) rli[r] = __builtin_amdgcn_rcpf(wsf[32 + crow(r, hi)]);
    LAS bf16_t* stg = (LAS bf16_t*)(lds + LDS_OST) + wid * 2048;
#pragma unroll
    for (int r = 0; r < 16; ++r) { const int orow = crow(r, hi);
#pragma unroll
        for (int d0 = 0; d0 < 2; ++d0) stg[orow * 64 + d0 * 32 + r32] = (bf16_t)(cvtpk(o[d0][r] * rli[r], 0.f) & 0xffffu); }
    asm volatile("s_waitcnt lgkmcnt(0)" ::: "memory");
#pragma unroll
    for (int i = 0; i < 4; ++i) { const int row = i * 8 + (lane >> 3), ch = lane & 7; const u32x4 v = *(const LAS u32x4*)(stg + row * 64 + ch * 8); *(u32x4*)(Ow + (size_t)row * opitch + ch * 8) = v; }
    asm volatile("s_waitcnt lgkmcnt(0)\n\ts_barrier" ::: "memory");
#undef ATT_DMA
#undef ATT_QK
#undef ATT_SMPV
}
#undef MX3
}

#define XB_TMO      128
#define XB_XCNT(j)  (256  + 64 * (j))
#define XB_XSUB(j)  (1280 + 64 * (j))
#define XB_XGEN(j)  (2304 + 64 * (j))
#define XB_TOP      3328
#define XB_TOPGEN   3392
#define XCD_BAR_WORDS 3456
#define XB_SPIN_CAP (1u << 18)
__device__ __forceinline__ unsigned xb_ld(unsigned* p)              { return __hip_atomic_load(p, __ATOMIC_RELAXED, __HIP_MEMORY_SCOPE_AGENT); }
__device__ __forceinline__ unsigned xb_add(unsigned* p, unsigned v) { return __hip_atomic_fetch_add(p, v, __ATOMIC_RELAXED, __HIP_MEMORY_SCOPE_AGENT); }
__device__ __forceinline__ unsigned xb_xcc_id() { return (unsigned)__builtin_amdgcn_s_getreg((3 << 11) | 20) & 0xFu; }
#define XB_SPIN(cond, bar) do { unsigned _sp = 0; while (cond) { __builtin_amdgcn_s_sleep(1); \
    if ((++_sp & 255u) == 0u) { if (xb_ld(&(bar)[XB_TMO])) break; if (_sp > XB_SPIN_CAP) { atomicAdd(&(bar)[XB_TMO], 1u); break; } } } } while (0)
struct XcdBarrier { unsigned* bar; unsigned x; volatile LAS unsigned* st; };
__device__ __forceinline__ XcdBarrier xcd_barrier_post(unsigned* bar, volatile LAS unsigned* st) {
    XcdBarrier b; b.bar = bar; b.x = xb_xcc_id(); b.st = st;
    if (threadIdx.x == 0) (void)xb_add(&bar[XB_XCNT(b.x)], 1u);
    return b;
}
__device__ __forceinline__ void xcd_barrier_complete(unsigned* bar, unsigned x, unsigned& nloc, unsigned& nx) {
    const unsigned G = gridDim.x * gridDim.y * gridDim.z;
    unsigned sum, cnt, mine, sp = 0u;
    for (;;) {
        sum = 0u; cnt = 0u; mine = 0u;
#pragma unroll
        for (unsigned j = 0; j < 16; ++j) { const unsigned c = xb_ld(&bar[XB_XCNT(j)]); sum += c; cnt += (c > 0u) ? 1u : 0u; mine = (j == x) ? c : mine; }
        if (sum == G) break;
        __builtin_amdgcn_s_sleep(1);
        if ((++sp & 255u) == 0u) { if (xb_ld(&bar[XB_TMO])) break; if (sp > XB_SPIN_CAP) { atomicAdd(&bar[XB_TMO], 1u); break; } }
    }
    nloc = mine > 0u ? mine : 1u; nx = cnt > 0u ? cnt : 1u;
}
__device__ __forceinline__ void xcd_barrier(const XcdBarrier& b) {
    asm volatile("s_waitcnt vmcnt(0)" ::: "memory");
    __syncthreads();
    if (threadIdx.x == 0) {
        unsigned* bar = b.bar;
        __builtin_amdgcn_s_waitcnt(0);
        unsigned nloc = b.st[0], nx = b.st[1];
        if (nloc == 0u) { xcd_barrier_complete(bar, b.x, nloc, nx); b.st[0] = nloc; b.st[1] = nx; }
        const unsigned old = xb_add(&bar[XB_XSUB(b.x)], 1u);
        const unsigned gen = old / nloc;
        if (old + 1u == (gen + 1u) * nloc) {
            __builtin_amdgcn_fence(__ATOMIC_RELEASE, "agent");
            asm volatile("s_waitcnt vmcnt(0)" ::: "memory");
            const unsigned og = xb_add(&bar[XB_TOP], 1u);
            const unsigned tg = og / nx;
            if (og + 1u == (tg + 1u) * nx) xb_add(&bar[XB_TOPGEN], 1u);
            else XB_SPIN(xb_ld(&bar[XB_TOPGEN]) == tg, bar);
            __builtin_amdgcn_fence(__ATOMIC_ACQUIRE, "agent");
            xb_add(&bar[XB_XGEN(b.x)], 1u);
            asm volatile("s_waitcnt vmcnt(0)" ::: "memory");
        } else {
            XB_SPIN(xb_ld(&bar[XB_XGEN(b.x)]) == gen, bar);
            __builtin_amdgcn_fence(__ATOMIC_ACQUIRE, "agent");
            asm volatile("s_waitcnt vmcnt(0)" ::: "memory");
        }
    }
    __syncthreads();
}

struct Args { const float* in[16]; float* out; unsigned char* ws; int ph_lo, ph_hi; };

__device__ __forceinline__ int rope64_src(int vv) { return 4 * (vv >> 3) + (vv & 3) + 32 * ((vv >> 2) & 1); }
__device__ __forceinline__ int rope32_src(int vv) { return 4 * (vv >> 3) + (vv & 3) + 16 * ((vv >> 2) & 1); }
__device__ __forceinline__ int src_w1(int v) {
    if (v < 512) return O_QA + (v & ~63) + rope64_src(v & 63);
    if (v < 640) { const int u = v - 512; return O_KA + (u & ~63) + rope64_src(u & 63); }
    if (v < 768) return O_VA + (v - 640);
    if (v < 1152) return O_QL + (v - 768);
    if (v < 1184) return O_KR + rope32_src(v - 1152);
    if (v < 1280) return -1;
    if (v < 1536) return O_KVL + (v - 1280);
    if (v < 2560) return O_GA + (v - 1536);
    return O_GB + (v - 2560);
}
__device__ __forceinline__ int src_uq(int v) { if (v < 512) return (v >> 6) * 96 + (v & 63); const int u = v - 512; return (u >> 5) * 96 + 64 + rope32_src(u & 31); }
__device__ __forceinline__ int src_ukv(int v) { if (v < 512) return (v >> 6) * 128 + (v & 63); const int u = v - 512; return (u >> 6) * 128 + 64 + (u & 63); }

template <bool GAIN> __device__ __forceinline__ void tr_item_t(const float* W, int ldw, int sc, const float* gain, int k0, bf16_t* dst, int ldd, LAS float* scr, int lane) {
    const float msk = sc >= 0 ? 1.f : 0.f; const int scc = sc >= 0 ? sc : 0;
#pragma unroll 8
    for (int i = 0; i < 32; ++i) { const int kk = 2 * i + (lane >> 5); float v = W[(size_t)(k0 + kk) * ldw + scc] * msk; if (GAIN) v *= gain[k0 + kk]; scr[kk * 33 + (lane & 31)] = v; }
    asm volatile("s_waitcnt lgkmcnt(0)" ::: "memory");
    const int c = lane & 7;
#pragma unroll
    for (int j = 0; j < 4; ++j) { const int n = (lane >> 3) + 8 * j; const LAS float* s = scr + (8 * c) * 33 + n;
        u32x4 o; o.x = cvtpk(s[0 * 33], s[1 * 33]); o.y = cvtpk(s[2 * 33], s[3 * 33]); o.z = cvtpk(s[4 * 33], s[5 * 33]); o.w = cvtpk(s[6 * 33], s[7 * 33]);
        *(u32x4*)(dst + (size_t)n * ldd + k0 + 8 * c) = o; }
    asm volatile("s_waitcnt lgkmcnt(0)" ::: "memory");
}

__device__ __forceinline__ void tr_item(const float* W, int ldw, int sc, const float* gain, int k0, bf16_t* dst, int ldd, LAS float* scr, int lane) {
    if (gain) tr_item_t<true>(W, ldw, sc, gain, k0, dst, ldd, scr, lane); else tr_item_t<false>(W, ldw, sc, gain, k0, dst, ldd, scr, lane);
}

__global__ void __launch_bounds__(NWAVES * 64, 2) fwd_kernel(Args args) {
    extern __shared__ __attribute__((aligned(16))) unsigned char lds_raw[];
    LAS unsigned char* lds = (LAS unsigned char*)lds_raw;
    const int tid = threadIdx.x, lane = tid & 63, wave = __builtin_amdgcn_readfirstlane(tid >> 6);
    const int G = gridDim.x, bx = blockIdx.x;
    const int vcu = (G % 8 == 0) ? (bx % 8) * (G / 8) + bx / 8 : bx;
    unsigned char* ws = args.ws;
    const float* X = args.in[0]; float* OUT = args.out;
    bf16_t* W1T = (bf16_t*)(ws + WS_W1T); bf16_t* WUQT = (bf16_t*)(ws + WS_WUQT); bf16_t* WUKVT = (bf16_t*)(ws + WS_WUKVT); bf16_t* WOT = (bf16_t*)(ws + WS_WOT);
    bf16_t* WOUTT = (bf16_t*)(ws + WS_WOUTT); bf16_t* WGUT = (bf16_t*)(ws + WS_WGUT); bf16_t* WDT = (bf16_t*)(ws + WS_WDT);
    float* cosA = (float*)(ws + WS_TAB); float* sinA = cosA + SEQ * 32; float* cosB = sinA + SEQ * 32; float* sinB = cosB + SEQ * 16;
    float* SSQ_Q = (float*)(ws + WS_SSQ); float* SSQ_KV = SSQ_Q + (size_t)T * 8; float* SSQ_X1 = SSQ_KV + (size_t)T * 4; float* SSQ_X2 = SSQ_X1 + (size_t)T * 16;
    bf16_t* XN = (bf16_t*)(ws + WS_XN); bf16_t* SG = (bf16_t*)(ws + WS_SG); bf16_t* QA = (bf16_t*)(ws + WS_QA); bf16_t* KA = (bf16_t*)(ws + WS_KA); bf16_t* VA = (bf16_t*)(ws + WS_VA);
    bf16_t* QLAT = (bf16_t*)(ws + WS_QLAT); bf16_t* KVLAT = (bf16_t*)(ws + WS_KVLAT); bf16_t* QM = (bf16_t*)(ws + WS_QM); bf16_t* KM = (bf16_t*)(ws + WS_KM);
    bf16_t* VM = (bf16_t*)(ws + WS_VM); bf16_t* OB = (bf16_t*)(ws + WS_OB); bf16_t* OA = (bf16_t*)(ws + WS_OA); bf16_t* Y = (bf16_t*)(ws + WS_Y); bf16_t* HDN = (bf16_t*)(ws + WS_HDN); float* X2 = (float*)(ws + WS_X2);
    const int lo = args.ph_lo, hi = args.ph_hi;
#ifndef PHASE_MASK
#define PHASE_MASK 0x1ff
#endif
#define IN(k) (((PHASE_MASK >> (k)) & 1) && lo <= (k) && (k) < hi)
#if MK_N_LAUNCHES == 1
    for (int u = tid; u < 32; u += NWAVES * 64) ((LAS unsigned*)(lds + MISC_OFF))[u] = 0u;
    __syncthreads();
    const XcdBarrier bar = xcd_barrier_post((unsigned*)(ws + WS_CTL), (volatile LAS unsigned*)(lds + MISC_OFF) + 8);
#define GRID_BAR() do { for (int rb_ = 0; rb_ < REP_BAR; ++rb_) xcd_barrier(bar); } while (0)
#else
#define GRID_BAR() do {} while (0)
#endif

    if (IN(0)) {
      for (int rep_ = 0; rep_ < REP_P0; ++rep_) {
        LAS float* scr = (LAS float*)(lds + wave * 16384);
        const int gw = vcu * NWAVES + wave, NGW = G * NWAVES;
        constexpr int I_W1 = (DM / 64) * (NV1 / 32), I_UQ = (384 / 64) * (768 / 32), I_UKV = (256 / 64) * (1024 / 32), I_O = (512 / 64) * (1024 / 32), I_OUT = (DM / 64) * (DM / 32),
                      I_GU = (DM / 64) * (2 * DFF / 32), I_D = (DFF / 64) * (DM / 32);
        constexpr int NITEMS = I_W1 + I_UQ + I_UKV + 2 * I_O + I_OUT + I_GU + I_D;
        const int ln = lane & 31;
        for (int it = gw; it < NITEMS; it += NGW) {
            int r = it;
            if (r < I_W1) { const int nblk = NV1 / 32, kb = r / nblk, nb = r % nblk; tr_item(args.in[2], INW, src_w1(nb * 32 + ln), nullptr, kb * 64, W1T + (size_t)nb * 32 * DM, DM, scr, lane); continue; } r -= I_W1;
            if (r < I_UQ) { const int nblk = 768 / 32, kb = r / nblk, nb = r % nblk; tr_item(args.in[5], 768, src_uq(nb * 32 + ln), args.in[4], kb * 64, WUQT + (size_t)nb * 32 * 384, 384, scr, lane); continue; } r -= I_UQ;
            if (r < I_UKV) { const int nblk = 1024 / 32, kb = r / nblk, nb = r % nblk; tr_item(args.in[7], 1024, src_ukv(nb * 32 + ln), args.in[6], kb * 64, WUKVT + (size_t)nb * 32 * 256, 256, scr, lane); continue; } r -= I_UKV;
            if (r < I_O) { const int nblk = 1024 / 32, kb = r / nblk, nb = r % nblk; tr_item(args.in[8], DM, nb * 32 + ln, nullptr, kb * 64, WOT + (size_t)nb * 32 * 1024, 1024, scr, lane); continue; } r -= I_O;
            if (r < I_O) { const int nblk = 1024 / 32, kb = r / nblk, nb = r % nblk; tr_item(args.in[9], DM, nb * 32 + ln, nullptr, kb * 64, WOT + (size_t)nb * 32 * 1024 + 512, 1024, scr, lane); continue; } r -= I_O;
            if (r < I_OUT) { const int nblk = DM / 32, kb = r / nblk, nb = r % nblk; tr_item(args.in[10], DM, nb * 32 + ln, nullptr, kb * 64, WOUTT + (size_t)nb * 32 * DM, DM, scr, lane); continue; } r -= I_OUT;
            if (r < I_GU) { const int nblk = 2 * DFF / 32, kb = r / nblk, nb = r % nblk; const int v = nb * 32, pn = v >> 8, bj = (v >> 7) & 1, c = 128 * pn + (v & 127) + ln;
                            tr_item(bj ? args.in[13] : args.in[12], DFF, c, args.in[11], kb * 64, WGUT + (size_t)v * DM, DM, scr, lane); continue; } r -= I_GU;
            { const int nblk = DM / 32, kb = r / nblk, nb = r % nblk; tr_item(args.in[14], DM, nb * 32 + ln, nullptr, kb * 64, WDT + (size_t)nb * 32 * DFF, DFF, scr, lane); }
        }
        for (int i = (vcu * NWAVES + wave) * 64 + lane; i < SEQ * 32; i += G * NWAVES * 64) {
            { const int p = i >> 5, j = i & 31; const double a = (double)p * pow(10000.0, -(double)j / 32.0); cosA[i] = (float)cos(a); sinA[i] = (float)sin(a); }
            if (i < SEQ * 16) { const int p = i >> 4, j = i & 15; const double a = (double)p * pow(10000.0, -(double)j / 16.0); cosB[i] = (float)cos(a); sinB[i] = (float)sin(a); }
        }
        const float* g1 = args.in[1];
        f32x4 gv[4];
#pragma unroll
        for (int j = 0; j < 4; ++j) gv[j] = *(const f32x4*)(g1 + 4 * lane + 256 * j);
        for (int m = gw; m < T; m += NGW) {
            const f32x4* xr = (const f32x4*)(X + (size_t)m * DM) + lane;
            f32x4 v[4]; float s = 0.f;
#pragma unroll
            for (int j = 0; j < 4; ++j) { v[j] = xr[64 * j]; s += sumsq4(v[j]); }
            const float rs = 1.0f / sqrtf(wave_sum(s) * (1.0f / DM) + EPS);
            u32x2* o8 = (u32x2*)(XN + (size_t)m * DM) + lane;
#pragma unroll
            for (int j = 0; j < 4; ++j) o8[64 * j] = pack4(v[j] * rs * gv[j]);
        }
      }
        if (IN(1)) GRID_BAR();
    }

    if (IN(1)) {
        pg8::Gemm g{XN, W1T, DM, DM, DM, (size_t)256 * DM * 2};
        pg8::SchedPlain S{{}, g}; S.o.init(T / 256, NV1 / 256, G, bx);
        EpiProj E{QA, KA, VA, QLAT, KVLAT, KM, SG, SSQ_Q, SSQ_KV, cosA, sinA, cosB, sinB};
        pg8::gemm_phase<EpiProj, pg8::SchedPlain, true, true>(lds, DM, DM, DM, S, E);
        if (REP_P1 > 1) pg8::gemm_phase<EpiProj, pg8::SchedPlain, true, true>(lds, DM, DM, DM, S, E);
        if (IN(2)) GRID_BAR();
    }

    if (IN(2)) {
        { pg8::Gemm g{QLAT, WUQT, 384, 384, 384, (size_t)256 * 384 * 2};
          pg8::SchedPlain S{{}, g}; S.o.init(T / 256, 3, G, bx);
          EpiUQ E{QM, SSQ_Q, cosB, sinB};
          pg8::gemm_phase<EpiUQ, pg8::SchedPlain, true, true>(lds, 384, 384, 384, S, E);
          if (REP_P2 > 1) pg8::gemm_phase<EpiUQ, pg8::SchedPlain, true, true>(lds, 384, 384, 384, S, E); }
        { pg8::Gemm g{KVLAT, WUKVT, 256, 256, 256, (size_t)256 * 256 * 2};
          pg8::SchedPlain S{{}, g}; S.o.init(T / 256, 4, G, (G - 1) - bx);
          EpiUKV E{KM, VM, SSQ_KV};
          pg8::gemm_phase<EpiUKV, pg8::SchedPlain, true, true>(lds, 256, 256, 256, S, E);
          if (REP_P2 > 1) pg8::gemm_phase<EpiUKV, pg8::SchedPlain, true, true>(lds, 256, 256, 256, S, E); }
        if (IN(3)) GRID_BAR();
    }

    if (IN(3)) {
        const float* sinks = args.in[3];
        for (int rep_ = 0; rep_ < REP_MLA; ++rep_)
        for (int base = vcu; base < 256; base += G) {
            const int bh = base >> 2, s = base & 3, b = bh >> 3, h = bh & 7;
            for (int i = 0; i < 4; ++i) {
                const int qb = (i == 0) ? s : (i == 1) ? 7 - s : (i == 2) ? 8 + s : 15 - s;
                const size_t row0 = (size_t)b * SEQ;
                const int q0 = qb * 256 + wave * 32;
                att::unit<96, false>(QM + (row0 + q0) * 768 + h * 96, 768, KM + row0 * 768 + h * 96, 768, VM + row0 * 512 + h * 64, 512,
                                     OB + (row0 + q0) * 512 + h * 64, 512, q0, 0, 4 * qb + 4, 4 * qb, -1e30f, 0.f, lds);
            }
        }
        for (int rep_ = 0; rep_ < REP_SWA; ++rep_)
        for (int base = vcu; base < 256; base += G) {
            const int bk = base >> 4, b = bk >> 1, kvh = bk & 1;
            for (int i = 0; i < 4; ++i) {
                const int blk = (base & 15) + 16 * i;
                const size_t row0 = (size_t)b * SEQ;
                const int hq = 4 * kvh + (wave >> 1), q0 = 64 * blk + 32 * (wave & 1);
                const int t0 = blk >= 2 ? blk - 2 : 0;
                const float sk = sinks[hq] * LOG2E;
                att::unit<64, true>(QA + (row0 + q0) * 512 + hq * 64, 512, KA + row0 * 128 + kvh * 64, 128, VA + row0 * 128 + kvh * 64, 128,
                                    OA + (row0 + q0) * 512 + hq * 64, 512, q0, t0, blk + 1, 0, sk, 1.0f, lds);
            }
        }
        if (IN(4)) GRID_BAR();
    }

    if (IN(4)) {
        pg8::SchedPair S{{}, OA, OB, WOT, 512, 1024, 512}; S.o.init(T / 256, 4, G, bx);
        EpiGate E{SG, Y};
        for (int rep_ = 0; rep_ < REP_P4; ++rep_) pg8::gemm_phase<EpiGate, pg8::SchedPair, true, true>(lds, 512, 1024, 512, S, E);
        if (IN(5)) GRID_BAR();
    }

    if (IN(5)) {
        pg8::Gemm g{Y, WOUTT, DM, DM, DM, (size_t)256 * DM * 2};
        pg8::SchedPlain S{{}, g}; S.o.init(T / 256, 4, G, bx);
        EpiRes1 E{X, OUT, XN, SSQ_X1};
        for (int rep_ = 0; rep_ < REP_P5; ++rep_) pg8::gemm_phase<EpiRes1, pg8::SchedPlain, true, true>(lds, DM, DM, DM, S, E);
        if (IN(6)) GRID_BAR();
    }

    if (IN(6)) {
        pg8::Gemm g{XN, WGUT, DM, DM, DM, (size_t)256 * DM * 2};
        pg8::SchedPlain S{{}, g}; S.o.init(T / 256, 22, G, bx);
        EpiSwiglu E{SSQ_X1, HDN};
        for (int rep_ = 0; rep_ < REP_P6; ++rep_) pg8::gemm_phase<EpiSwiglu, pg8::SchedPlain, true, true>(lds, DM, DM, DM, S, E);
        if (IN(7)) GRID_BAR();
    }

    if (IN(7)) {
        pg8::Gemm g{HDN, WDT, 64, DFF, DFF, (size_t)(DFF / 64) * 256 * 64 * 2};
        pg8::SchedPlain S{{}, g}; S.o.init(T / 256, 4, G, bx);
        EpiRes2 E{OUT, X2, SSQ_X2};
        pg8::gemm_phase<EpiRes2, pg8::SchedPlain, true, true>(lds, 64, DFF, DFF, S, E, 256 * 64 * 2);
        if (REP_P7 > 1) pg8::gemm_phase<EpiRes2, pg8::SchedPlain, true, true>(lds, 64, DFF, DFF, S, E, 256 * 64 * 2);
        if (IN(8)) GRID_BAR();
    }

    if (IN(8)) {
        const int gw = vcu * NWAVES + wave, NGW = G * NWAVES;
        const float* gf = args.in[15];
        f32x4 gv[4];
#pragma unroll
        for (int j = 0; j < 4; ++j) gv[j] = *(const f32x4*)(gf + 4 * lane + 256 * j);
        for (int rep_ = 0; rep_ < REP_P8; ++rep_)
        for (int m = gw; m < T; m += NGW) {
            float ss = 0.f;
#pragma unroll
            for (int i = 0; i < 4; ++i) { const f32x4 s4 = *(const f32x4*)(SSQ_X2 + (size_t)m * 16 + 4 * i); ss += (s4[0] + s4[1]) + (s4[2] + s4[3]); }
            const float rs = 1.0f / sqrtf(ss * (1.0f / DM) + EPS);
            const f32x4* xr = (const f32x4*)(X2 + (size_t)m * DM) + lane; f32x4* orow = (f32x4*)(OUT + (size_t)m * DM) + lane;
#pragma unroll
            for (int j = 0; j < 4; ++j) orow[64 * j] = xr[64 * j] * rs * gv[j];
        }
    }
#undef IN
#undef GRID_BAR
}

extern "C" void kernel_launch(void* const* d_in, const int* in_sizes, int n_in, void* d_out, int out_size, void* d_ws, size_t ws_size, hipStream_t stream) {
    static int grid = 0;
    if (grid == 0) {
        if (n_in != 16 || out_size != T * DM || ws_size < WS_END) { fprintf(stderr, "kernel_launch: unexpected shapes (n_in %d out %d ws %zu, need ws >= %zu)\n", n_in, out_size, ws_size, (size_t)WS_END); grid = -1; return; }
        int dev = 0, cus = 0, per_cu = 0;
        hipGetDevice(&dev); hipDeviceGetAttribute(&cus, hipDeviceAttributeMultiprocessorCount, dev);
        if (hipFuncSetAttribute((const void*)fwd_kernel, hipFuncAttributeMaxDynamicSharedMemorySize, LDS_BYTES) != hipSuccess) { fprintf(stderr, "kernel_launch: hipFuncSetAttribute failed\n"); grid = -1; return; }
        if (hipOccupancyMaxActiveBlocksPerMultiprocessor(&per_cu, (const void*)fwd_kernel, NWAVES * 64, LDS_BYTES) != hipSuccess || per_cu < 1) { fprintf(stderr, "kernel_launch: occupancy query says %d\n", per_cu); per_cu = 1; }
        (void)hipGetLastError();
        grid = cus;
        fprintf(stderr, "kernel_launch: grid %d (cus %d, per_cu %d)\n", grid, cus, per_cu);
    }
    if (grid < 0) return;
    Args a{};
    for (int i = 0; i < 16; ++i) a.in[i] = (const float*)d_in[i];
    a.out = (float*)d_out; a.ws = (unsigned char*)d_ws;
#if MK_N_LAUNCHES == 1
    a.ph_lo = 0; a.ph_hi = 9;
    if (hipMemsetAsync((char*)d_ws + WS_CTL, 0, CTL_BYTES, stream) != hipSuccess) { fprintf(stderr, "kernel_launch: memset failed\n"); return; }
    void* kargs[] = {&a};
    hipError_t e = hipLaunchCooperativeKernel((const void*)fwd_kernel, dim3(grid), dim3(NWAVES * 64), kargs, LDS_BYTES, stream);
    if (e != hipSuccess) fprintf(stderr, "cooperative launch failed: %s (grid %d)\n", hipGetErrorString(e), grid);
#else
    for (int p = 0; p < 9; ++p) { a.ph_lo = p; a.ph_hi = p + 1; hipLaunchKernelGGL(fwd_kernel, dim3(grid), dim3(NWAVES * 64), LDS_BYTES, stream, a); }
#endif
}
```

```cpp
#include <hip/hip_runtime.h>
#include <hip/hip_cooperative_groups.h>
#include <cstdio>
#include <cstdint>
namespace cg = cooperative_groups;

#ifndef REP_P0
#define REP_P0 1
#endif
#ifndef REP_P1
#define REP_P1 1
#endif
#ifndef REP_P2
#define REP_P2 1
#endif
#ifndef REP_MLA
#define REP_MLA 1
#endif
#ifndef REP_SWA
#define REP_SWA 1
#endif
#ifndef REP_P7
#define REP_P7 1
#endif
#ifndef REP_P8
#define REP_P8 1
#endif
#ifndef REP_BAR
#define REP_BAR 1
#endif
#ifndef P7_REV
#define P7_REV 2
#endif
#ifndef REP_P4
#define REP_P4 1
#endif
#ifndef REP_P5
#define REP_P5 1
#endif
#ifndef REP_P6
#define REP_P6 1
#endif
#ifndef MK_N_LAUNCHES
#define MK_N_LAUNCHES 1
#endif

#define LAS __attribute__((address_space(3)))
#define GAS __attribute__((address_space(1)))
typedef unsigned short bf16_t;
typedef short bf16x8 __attribute__((ext_vector_type(8)));
typedef short s16x4 __attribute__((ext_vector_type(4)));
typedef float f32x2 __attribute__((ext_vector_type(2)));
typedef float f32x4 __attribute__((ext_vector_type(4)));
typedef float f32x16 __attribute__((ext_vector_type(16)));
typedef unsigned u32x2 __attribute__((ext_vector_type(2)));
typedef unsigned u32x4 __attribute__((ext_vector_type(4)));
typedef __bf16 bf16x2_t __attribute__((ext_vector_type(2)));

constexpr int NB = 8, SEQ = 4096, T = NB * SEQ, DM = 1024, DFF = 2816;
constexpr int INW = 3488, NV1 = 3584;
constexpr int O_QA = 0, O_KA = 512, O_VA = 640, O_QL = 768, O_KVL = 1152, O_KR = 1408, O_GA = 1440, O_GB = 2464;
constexpr float EPS = 1e-6f;
constexpr float LOG2E = 1.4426950408889634f;
constexpr float QA_SCALE = 0.125f * LOG2E;
constexpr float QM_SCALE = 0.10206207261596577f * LOG2E;

constexpr size_t MiB = 1u << 20;
constexpr size_t WS_W1T = 0 * MiB, WS_WUQT = 7 * MiB, WS_WUKVT = 8 * MiB, WS_WOT = 9 * MiB, WS_WOUTT = 11 * MiB, WS_WGUT = 13 * MiB, WS_WDT = 24 * MiB;
constexpr size_t WS_TAB = 30 * MiB;
constexpr size_t WS_SSQ = 32 * MiB;
constexpr size_t WS_XN = 38 * MiB;
constexpr size_t WS_SG = 102 * MiB;
constexpr size_t WS_QA = 230 * MiB;
constexpr size_t WS_KA = 262 * MiB, WS_VA = 270 * MiB;
constexpr size_t WS_QLAT = 278 * MiB, WS_KVLAT = 302 * MiB;
constexpr size_t WS_QM = 318 * MiB, WS_KM = 366 * MiB;
constexpr size_t WS_VM = 414 * MiB, WS_OB = 446 * MiB;
constexpr size_t WS_CTL = 478 * MiB, CTL_BYTES = 16384;
constexpr size_t WS_OA = 479 * MiB;
constexpr size_t WS_END = 511 * MiB;
constexpr size_t WS_Y = WS_QM;
constexpr size_t WS_X2 = WS_QLAT;
constexpr size_t WS_HDN = WS_SG;
static_assert(WS_HDN + (size_t)T * DFF * 2 <= WS_QLAT && WS_Y + (size_t)T * DM * 2 <= WS_VM, "overlays");

constexpr int NWAVES = 8;
constexpr int RING_BYTES = 131072, MISC_OFF = RING_BYTES + 320, LDS_BYTES = 147456;

__device__ __forceinline__ unsigned cvtpk(float lo, float hi) { f32x2 v = {lo, hi}; bf16x2_t b = __builtin_convertvector(v, bf16x2_t); return __builtin_bit_cast(unsigned, b); }
__device__ __forceinline__ u32x4 pack8(f32x4 a, f32x4 b) { u32x4 w; w.x = cvtpk(a[0], a[1]); w.y = cvtpk(a[2], a[3]); w.z = cvtpk(b[0], b[1]); w.w = cvtpk(b[2], b[3]); return w; }
__device__ __forceinline__ u32x2 pack4(f32x4 a) { u32x2 w; w.x = cvtpk(a[0], a[1]); w.y = cvtpk(a[2], a[3]); return w; }
__device__ __forceinline__ float bf_lo(unsigned w) { return __uint_as_float(w << 16); }
__device__ __forceinline__ float bf_hi(unsigned w) { return __uint_as_float(w & 0xffff0000u); }
__device__ __forceinline__ float sigmoidf_fast(float x) { return __builtin_amdgcn_rcpf(1.0f + __builtin_amdgcn_exp2f(-x * LOG2E)); }
__device__ __forceinline__ float wave_sum(float v) {
#pragma unroll
    for (int o = 1; o < 64; o <<= 1) v += __shfl_xor(v, o);
    return v;
}
__device__ __forceinline__ float sumsq4(f32x4 a) { return (a[0] * a[0] + a[1] * a[1]) + (a[2] * a[2] + a[3] * a[3]); }

namespace pg8 {
constexpr int BM = 256, BK = 64, HALF = 128, HTB = HALF * BK * 2, STAGE_BYTES = 8 * HTB, NXCD = 8, WGM = 8;
__host__ __device__ __forceinline__ int lds_byte(int r, int c) { const int st = (r >> 4) * 2 + (c >> 5), rr = r & 15, cc = c & 31, ob = rr * 64 + cc * 2; return st * 1024 + (ob ^ (((ob >> 9) & 1) << 5)); }
__host__ __device__ __forceinline__ void stage_rc(int b, int& R, int& C) { const int st = b / 1024, sb = b % 1024, swz = sb ^ (((sb >> 9) & 1) << 5); R = (st >> 1) * 16 + swz / 64; C = (st & 1) * 32 + (swz % 64) / 2; }
__host__ __device__ __forceinline__ int perm32(int rho) { const int n = rho >> 4, i = rho & 15; return 8 * (i >> 2) + 4 * n + (i & 3); }

struct Unit { int pm, pn, part; };
struct Gemm { const bf16_t* A; const bf16_t* Bt; int lda, ldb, K; size_t tstepA; };

struct TileOrder {
    int nM, nN, nwg, G, c;
    __device__ void init(int nM_, int nN_, int G_, int c_) { nM = nM_; nN = nN_; nwg = nM * nN; G = G_; c = c_; }
    __device__ bool tile(int i, int& pm, int& pn) const {
        const long L = (long)i * G + c; if (L >= nwg) return false;
        int wgid = (int)L; { const int q = nwg / NXCD, r = nwg % NXCD, xcd = wgid % NXCD, off = wgid / NXCD; wgid = (xcd < r ? xcd * (q + 1) : r * (q + 1) + (xcd - r) * q) + off; }
        const int nig = WGM * nN, gid = wgid / nig, fm = gid * WGM, gsz = (nM - fm) < WGM ? (nM - fm) : WGM;
        pm = fm + ((wgid % nig) % gsz); pn = (wgid % nig) / gsz; return true;
    }
};
struct SchedPlain {
    TileOrder o; const Gemm g; int rev;
    __device__ bool next(int i, Unit& u) const { u.part = 0; if (rev > 0) { if (i >= rev) return false; return o.tile(rev - 1 - i, u.pm, u.pn); } return o.tile(i, u.pm, u.pn); }
    __device__ __forceinline__ void ptrs(const Unit& u, const char*& a, const char*& b) const { a = (const char*)g.A + (size_t)u.pm * g.tstepA; b = (const char*)g.Bt + (size_t)u.pn * BM * g.ldb * 2; }
    __device__ __forceinline__ bool keep(const Unit&) const { return false; }
};
struct SchedPair {
    TileOrder o; const bf16_t* A0; const bf16_t* A1; const bf16_t* Bt; int lda, ldb, K;
    __device__ bool next(int i, Unit& u) const { u.part = i & 1; return o.tile(i >> 1, u.pm, u.pn); }
    __device__ __forceinline__ void ptrs(const Unit& u, const char*& a, const char*& b) const { a = (const char*)(u.part ? A1 : A0) + (size_t)u.pm * BM * lda * 2; b = (const char*)Bt + (size_t)u.pn * BM * ldb * 2 + (size_t)u.part * K * 2; }
    __device__ __forceinline__ bool keep(const Unit& u) const { return u.part == 0; }
};

template <class Epi, class Sched, bool ALIGN_EPI, bool SP2>
__device__ __forceinline__ void gemm_phase(LAS unsigned char* lds, const int lda, const int ldb, const int K, const Sched& S, const Epi& E, const int kstepA_ = BK * 2) {
    const int tid = threadIdx.x, wid = __builtin_amdgcn_readfirstlane(tid >> 6), lane = tid & 63, wr = wid >> 2, wc = wid & 3, fr = lane & 15, fq = lane >> 4;
    const int nt = K / BK;
    unsigned voffA[2], voffB[2];
#pragma unroll
    for (int i = 0; i < 2; ++i) { int R, C; stage_rc(tid * 16 + i * 8192, R, C); const int Rb = (R & ~31) + perm32(R & 31);
        voffA[i] = (unsigned)(R * lda + C) * 2u; voffB[i] = (unsigned)(Rb * ldb + C) * 2u; }
    const size_t kstep = (size_t)(BK * 2), kstepA = (size_t)kstepA_;
    const size_t hstepA = (size_t)HALF * lda * 2, hstepB = (size_t)HALF * ldb * 2;
    const unsigned ldsw = (unsigned)wid * 1024u;
    const int aoff = lds_byte(wr * 64 + fr, fq * 8), boff = lds_byte(wc * 32 + fr, fq * 8);
#define PG8_SA(b, h) (((b) * 2 + (h)) * HTB)
#define PG8_SB(b, h) ((4 + (b) * 2 + (h)) * HTB)
#define PG8_STAGE(bufoff, gbase, voff) do { _Pragma("unroll") for (int _i = 0; _i < 2; ++_i) \
        __builtin_amdgcn_global_load_lds((const unsigned*)((const char*)(gbase) + (voff)[_i]), (LAS unsigned*)(lds + (bufoff) + ldsw + _i * 8192), 16, 0, 0); } while (0)
#define PG8_LDA(dst, b, h) do { _Pragma("unroll") for (int m = 0; m < 4; ++m) _Pragma("unroll") for (int k = 0; k < 2; ++k) dst[m][k] = *(const LAS bf16x8*)(lds + PG8_SA(b, h) + aoff + m * 2048 + k * 1024); } while (0)
#define PG8_LDB(dst, b, h) do { _Pragma("unroll") for (int n = 0; n < 2; ++n) _Pragma("unroll") for (int k = 0; k < 2; ++k) dst[n][k] = *(const LAS bf16x8*)(lds + PG8_SB(b, h) + boff + n * 2048 + k * 1024); } while (0)
#define PG8_MMA(ai, bj, At, Bt) do { __builtin_amdgcn_s_setprio(1); _Pragma("unroll") for (int m = 0; m < 4; ++m) _Pragma("unroll") for (int n = 0; n < 2; ++n) _Pragma("unroll") for (int k = 0; k < 2; ++k) \
        acc[ai][bj][m][n] = __builtin_amdgcn_mfma_f32_16x16x32_bf16(Bt[n][k], At[m][k], acc[ai][bj][m][n], 0, 0, 0); __builtin_amdgcn_s_setprio(0); } while (0)
#define PG8_WAIT_V(n) asm volatile("s_waitcnt vmcnt(" #n ")" ::: "memory")
#define PG8_WAIT_L(n) asm volatile("s_waitcnt lgkmcnt(" #n ")" ::: "memory")
#define PG8_BAR __builtin_amdgcn_s_barrier()
#define PG8_SCHED __builtin_amdgcn_sched_barrier(0)
    Unit cur, nxt; int ui = 0;
    if (!S.next(0, cur)) return;
    f32x4 acc[2][2][4][2];
#pragma unroll
    for (int a = 0; a < 2; ++a)
#pragma unroll
        for (int b = 0; b < 2; ++b)
#pragma unroll
            for (int m = 0; m < 4; ++m)
#pragma unroll
                for (int n = 0; n < 2; ++n) acc[a][b][m][n] = (f32x4){0.f, 0.f, 0.f, 0.f};
    bf16x8 At[4][2], B0[2][2], B1[2][2];
    const char* cA; const char* cB; S.ptrs(cur, cA, cB);
    if constexpr (SP2) {
        PG8_STAGE(PG8_SB(0, 0), cB, voffB); PG8_STAGE(PG8_SB(0, 1), cB + hstepB, voffB); PG8_STAGE(PG8_SA(0, 0), cA, voffA); PG8_STAGE(PG8_SA(0, 1), cA + hstepA, voffA);
        if (wr == 1) PG8_BAR;
        PG8_WAIT_V(2); PG8_BAR;
        PG8_STAGE(PG8_SB(1, 0), cB + kstep, voffB); PG8_STAGE(PG8_SA(1, 0), cA + kstepA, voffA); PG8_STAGE(PG8_SB(1, 1), cB + hstepB + kstep, voffB);
        PG8_WAIT_V(6); PG8_BAR;
    } else {
        PG8_STAGE(PG8_SB(0, 0), cB, voffB); PG8_STAGE(PG8_SA(0, 0), cA, voffA); PG8_STAGE(PG8_SB(0, 1), cB + hstepB, voffB); PG8_STAGE(PG8_SA(0, 1), cA + hstepA, voffA);
        if (wr == 1) PG8_BAR;
        PG8_WAIT_V(4); PG8_BAR;
        PG8_STAGE(PG8_SB(1, 0), cB + kstep, voffB); PG8_STAGE(PG8_SA(1, 0), cA + kstepA, voffA); PG8_STAGE(PG8_SB(1, 1), cB + hstepB + kstep, voffB);
        PG8_WAIT_V(6); PG8_BAR;
    }
    for (;;) {
        const bool has_next = S.next(ui + 1, nxt);
        const char* nA = cA; const char* nB = cB; if (has_next) S.ptrs(nxt, nA, nB);
#pragma unroll 1
        for (int t = 0; t < nt; t += 2) {
            const bool last = (t == nt - 2);
            const char* a1 = cA + (size_t)(t + 1) * kstepA;
            const char* a2 = last ? nA : cA + (size_t)(t + 2) * kstepA; const char* b2 = last ? nB : cB + (size_t)(t + 2) * kstep;
            const char* a3 = a2 + kstepA; const char* b3 = b2 + kstep;
            if constexpr (SP2) {
            PG8_LDB(B0, 0, 0); PG8_LDB(B1, 0, 1); PG8_SCHED; PG8_LDA(At, 0, 0); PG8_STAGE(PG8_SA(1, 1), a1 + hstepA, voffA);
            PG8_WAIT_V(8); PG8_WAIT_L(0); PG8_BAR; PG8_MMA(0, 0, At, B0); PG8_MMA(0, 1, At, B1); PG8_BAR; PG8_SCHED;
            PG8_LDA(At, 0, 1); PG8_STAGE(PG8_SB(0, 0), b2, voffB); PG8_STAGE(PG8_SB(0, 1), b2 + hstepB, voffB); PG8_STAGE(PG8_SA(0, 0), a2, voffA);
            PG8_WAIT_V(8); PG8_WAIT_L(0); PG8_BAR; PG8_MMA(1, 0, At, B0); PG8_MMA(1, 1, At, B1); PG8_BAR; PG8_SCHED;
            PG8_LDB(B0, 1, 0); PG8_LDB(B1, 1, 1); PG8_SCHED; PG8_LDA(At, 1, 0); PG8_STAGE(PG8_SA(0, 1), a2 + hstepA, voffA);
            PG8_WAIT_V(8); PG8_WAIT_L(0); PG8_BAR; PG8_MMA(0, 0, At, B0); PG8_MMA(0, 1, At, B1); PG8_BAR; PG8_SCHED;
            PG8_LDA(At, 1, 1); PG8_STAGE(PG8_SB(1, 0), b3, voffB); PG8_STAGE(PG8_SB(1, 1), b3 + hstepB, voffB); PG8_STAGE(PG8_SA(1, 0), a3, voffA);
            PG8_WAIT_V(8); PG8_WAIT_L(0); PG8_BAR; PG8_MMA(1, 0, At, B0); PG8_MMA(1, 1, At, B1); PG8_BAR; PG8_SCHED;
            } else {
            PG8_LDB(B0, 0, 0); PG8_SCHED; PG8_LDA(At, 0, 0); PG8_STAGE(PG8_SA(1, 1), a1 + hstepA, voffA);
            PG8_WAIT_L(8); PG8_BAR; PG8_WAIT_L(0); PG8_MMA(0, 0, At, B0); PG8_BAR; PG8_SCHED;
            PG8_LDB(B1, 0, 1); PG8_STAGE(PG8_SB(0, 0), b2, voffB);
            PG8_BAR; PG8_WAIT_L(0); PG8_MMA(0, 1, At, B1); PG8_BAR;
            PG8_LDA(At, 0, 1); PG8_STAGE(PG8_SA(0, 0), a2, voffA);
            PG8_BAR; PG8_WAIT_L(0); PG8_MMA(1, 0, At, B0); PG8_BAR; PG8_SCHED;
            PG8_STAGE(PG8_SB(0, 1), b2 + hstepB, voffB);
            PG8_WAIT_V(6); PG8_BAR; PG8_MMA(1, 1, At, B1); PG8_BAR;
            PG8_LDB(B0, 1, 0); PG8_SCHED; PG8_LDA(At, 1, 0); PG8_STAGE(PG8_SA(0, 1), a2 + hstepA, voffA);
            PG8_WAIT_L(8); PG8_BAR; PG8_WAIT_L(0); PG8_MMA(0, 0, At, B0); PG8_BAR; PG8_SCHED;
            PG8_LDB(B1, 1, 1); PG8_STAGE(PG8_SB(1, 0), b3, voffB);
            PG8_BAR; PG8_WAIT_L(0); PG8_MMA(0, 1, At, B1); PG8_BAR;
            PG8_LDA(At, 1, 1); PG8_STAGE(PG8_SA(1, 0), a3, voffA);
            PG8_BAR; PG8_WAIT_L(0); PG8_MMA(1, 0, At, B0); PG8_BAR; PG8_SCHED;
            PG8_STAGE(PG8_SB(1, 1), b3 + hstepB, voffB);
            PG8_WAIT_V(6); PG8_BAR; PG8_MMA(1, 1, At, B1); PG8_BAR;
            }
        }
        if constexpr (ALIGN_EPI) { if (wr == 0) PG8_BAR; }
        E(acc, cur, wr, wc, fr, fq);
        if (!has_next) break;
        if (!S.keep(cur)) {
#pragma unroll
        for (int a = 0; a < 2; ++a)
#pragma unroll
            for (int b = 0; b < 2; ++b)
#pragma unroll
                for (int m = 0; m < 4; ++m)
#pragma unroll
                    for (int n = 0; n < 2; ++n) acc[a][b][m][n] = (f32x4){0.f, 0.f, 0.f, 0.f};
        }
        cur = nxt; cA = nA; cB = nB; ++ui;
        if constexpr (ALIGN_EPI) { if (wr == 1) PG8_BAR; }
    }
    PG8_WAIT_V(0);
    if constexpr (!ALIGN_EPI) { if (wr == 0) PG8_BAR; }
    PG8_BAR;
#undef PG8_SA
#undef PG8_SB
#undef PG8_STAGE
#undef PG8_LDA
#undef PG8_LDB
#undef PG8_MMA
#undef PG8_WAIT_V
#undef PG8_WAIT_L
#undef PG8_BAR
#undef PG8_SCHED
}
}
using pg8::Unit;

struct EpiProj {
    bf16_t *QA, *KA, *VA, *QLAT, *KVLAT, *KM, *SG; float *SSQ_Q, *SSQ_KV; const float *cosA, *sinA, *cosB, *sinB;
    __device__ __forceinline__ void operator()(f32x4 (&acc)[2][2][4][2], const Unit& u, int wr, int wc, int fr, int fq) const {
        const int pn = u.pn, rbase = u.pm * 256 + wr * 64 + fr;
        if (pn <= 2) {
#pragma unroll
            for (int ai = 0; ai < 2; ++ai)
#pragma unroll
                for (int m = 0; m < 4; ++m) {
                    const int r = rbase + ai * 128 + m * 16, pos = r & (SEQ - 1);
                    const int d0 = 4 * (4 * (wc & 1) + fq);
                    const f32x4 c4 = *(const f32x4*)(cosA + pos * 32 + d0), s4 = *(const f32x4*)(sinA + pos * 32 + d0);
#pragma unroll
                    for (int bj = 0; bj < 2; ++bj) {
                        if (pn == 2 && bj == 1) { *(u32x4*)(VA + (size_t)r * 128 + 32 * wc + 8 * fq) = pack8(acc[ai][1][m][0], acc[ai][1][m][1]); }
                        else {
                            const f32x4 x1 = acc[ai][bj][m][0], x2 = acc[ai][bj][m][1];
                            f32x4 o1 = x1 * c4 - x2 * s4, o2 = x2 * c4 + x1 * s4;
                            bf16_t* dst;
                            if (pn < 2) { o1 = o1 * QA_SCALE; o2 = o2 * QA_SCALE; dst = QA + (size_t)r * 512 + (4 * pn + 2 * bj + (wc >> 1)) * 64 + d0; }
                            else dst = KA + (size_t)r * 128 + (wc >> 1) * 64 + d0;
                            *(u32x2*)dst = pack4(o1); *(u32x2*)(dst + 32) = pack4(o2);
                        }
                    }
                }
        } else if (pn <= 5) {
#pragma unroll
            for (int ai = 0; ai < 2; ++ai)
#pragma unroll
                for (int m = 0; m < 4; ++m) {
                    const int r = rbase + ai * 128 + m * 16, pos = r & (SEQ - 1);
                    float q = sumsq4(acc[ai][0][m][0]) + sumsq4(acc[ai][0][m][1]);
                    if (pn != 4) q += sumsq4(acc[ai][1][m][0]) + sumsq4(acc[ai][1][m][1]);
                    q += __shfl_xor(q, 16); q += __shfl_xor(q, 32);
                    if (pn == 3) {
                        *(u32x4*)(QLAT + (size_t)r * 384 + 32 * wc + 8 * fq) = pack8(acc[ai][0][m][0], acc[ai][0][m][1]);
                        *(u32x4*)(QLAT + (size_t)r * 384 + 128 + 32 * wc + 8 * fq) = pack8(acc[ai][1][m][0], acc[ai][1][m][1]);
                        if (fq == 0) SSQ_Q[(size_t)r * 8 + wc] = q;
                    } else if (pn == 4) {
                        *(u32x4*)(QLAT + (size_t)r * 384 + 256 + 32 * wc + 8 * fq) = pack8(acc[ai][0][m][0], acc[ai][0][m][1]);
                        if (fq == 0) SSQ_Q[(size_t)r * 8 + 4 + wc] = q;
                        if (wc == 0) {
                            const int i0 = 4 * fq;
                            const f32x4 c4 = *(const f32x4*)(cosB + pos * 16 + i0), s4 = *(const f32x4*)(sinB + pos * 16 + i0);
                            const f32x4 x1 = acc[ai][1][m][0], x2 = acc[ai][1][m][1];
                            const u32x2 w1 = pack4(x1 * c4 - x2 * s4), w2 = pack4(x2 * c4 + x1 * s4);
#pragma unroll
                            for (int h = 0; h < 8; ++h) { bf16_t* dst = KM + (size_t)r * 768 + h * 96 + 64 + i0; *(u32x2*)dst = w1; *(u32x2*)(dst + 16) = w2; }
                        }
                    } else {
                        *(u32x4*)(KVLAT + (size_t)r * 256 + 32 * wc + 8 * fq) = pack8(acc[ai][0][m][0], acc[ai][0][m][1]);
                        *(u32x4*)(KVLAT + (size_t)r * 256 + 128 + 32 * wc + 8 * fq) = pack8(acc[ai][1][m][0], acc[ai][1][m][1]);
                        if (fq == 0) SSQ_KV[(size_t)r * 4 + wc] = q;
                    }
                }
        } else {
            const int cb = (pn - 6) * 256 + 32 * wc + 8 * fq;
#pragma unroll
            for (int ai = 0; ai < 2; ++ai)
#pragma unroll
                for (int m = 0; m < 4; ++m) {
                    const int r = rbase + ai * 128 + m * 16;
#pragma unroll
                    for (int bj = 0; bj < 2; ++bj) {
                        f32x4 a = acc[ai][bj][m][0], b = acc[ai][bj][m][1];
#pragma unroll
                        for (int e = 0; e < 4; ++e) { a[e] = sigmoidf_fast(a[e]); b[e] = sigmoidf_fast(b[e]); }
                        *(u32x4*)(SG + (size_t)r * 2048 + cb + 128 * bj) = pack8(a, b);
                    }
                }
        }
    }
};

struct EpiUQ {
    bf16_t* QM; const float* SSQ_Q; const float *cosB, *sinB;
    __device__ __forceinline__ void operator()(f32x4 (&acc)[2][2][4][2], const Unit& u, int wr, int wc, int fr, int fq) const {
        const int pn = u.pn, rbase = u.pm * 256 + wr * 64 + fr;
#pragma unroll
        for (int ai = 0; ai < 2; ++ai)
#pragma unroll
            for (int m = 0; m < 4; ++m) {
                const int r = rbase + ai * 128 + m * 16, pos = r & (SEQ - 1);
                const f32x4 sa = *(const f32x4*)(SSQ_Q + (size_t)r * 8), sb = *(const f32x4*)(SSQ_Q + (size_t)r * 8 + 4);
                const float ss = ((sa[0] + sa[1]) + (sa[2] + sa[3])) + ((sb[0] + sb[1]) + (sb[2] + sb[3]));
                const float rs = __builtin_amdgcn_rsqf(ss * (1.0f / 384.0f) + EPS) * QM_SCALE;
                if (pn < 2) {
#pragma unroll
                    for (int bj = 0; bj < 2; ++bj)
                        *(u32x4*)(QM + (size_t)r * 768 + (4 * pn + 2 * bj + (wc >> 1)) * 96 + 32 * (wc & 1) + 8 * fq) = pack8(acc[ai][bj][m][0] * rs, acc[ai][bj][m][1] * rs);
                } else {
                    const int i0 = 4 * fq;
                    const f32x4 c4 = *(const f32x4*)(cosB + pos * 16 + i0), s4 = *(const f32x4*)(sinB + pos * 16 + i0);
#pragma unroll
                    for (int bj = 0; bj < 2; ++bj) {
                        const f32x4 x1 = acc[ai][bj][m][0] * rs, x2 = acc[ai][bj][m][1] * rs;
                        bf16_t* dst = QM + (size_t)r * 768 + (4 * bj + wc) * 96 + 64 + i0;
                        *(u32x2*)dst = pack4(x1 * c4 - x2 * s4); *(u32x2*)(dst + 16) = pack4(x2 * c4 + x1 * s4);
                    }
                }
                asm volatile("" ::: "memory");
            }
    }
};
struct EpiUKV {
    bf16_t *KM, *VM; const float* SSQ_KV;
    __device__ __forceinline__ void operator()(f32x4 (&acc)[2][2][4][2], const Unit& u, int wr, int wc, int fr, int fq) const {
        const int pn = u.pn, rbase = u.pm * 256 + wr * 64 + fr;
#pragma unroll
        for (int ai = 0; ai < 2; ++ai)
#pragma unroll
            for (int m = 0; m < 4; ++m) {
                const int r = rbase + ai * 128 + m * 16;
                const f32x4 sa = *(const f32x4*)(SSQ_KV + (size_t)r * 4);
                const float rs = __builtin_amdgcn_rsqf(((sa[0] + sa[1]) + (sa[2] + sa[3])) * (1.0f / 256.0f) + EPS);
#pragma unroll
                for (int bj = 0; bj < 2; ++bj) {
                    const int h = 4 * (pn & 1) + 2 * bj + (wc >> 1), d = 32 * (wc & 1) + 8 * fq;
                    bf16_t* dst = (pn < 2) ? KM + (size_t)r * 768 + h * 96 + d : VM + (size_t)r * 512 + h * 64 + d;
                    *(u32x4*)dst = pack8(acc[ai][bj][m][0] * rs, acc[ai][bj][m][1] * rs);
                }
                asm volatile("" ::: "memory");
            }
    }
};
struct EpiGate {
    const bf16_t* SG; bf16_t* Y;
    __device__ __forceinline__ void operator()(f32x4 (&acc)[2][2][4][2], const Unit& u, int wr, int wc, int fr, int fq) const {
        const int rbase = u.pm * 256 + wr * 64 + fr, cb = u.pn * 256 + 32 * wc + 8 * fq;
#pragma unroll
        for (int ai = 0; ai < 2; ++ai)
#pragma unroll
            for (int m = 0; m < 4; ++m) {
                const int r = rbase + ai * 128 + m * 16;
#pragma unroll
                for (int bj = 0; bj < 2; ++bj) {
                    const int c = cb + 128 * bj;
                    const u32x4 wb = *(const u32x4*)(SG + (size_t)r * 2048 + 1024 + c);
                    f32x4 b0 = {bf_lo(wb.x), bf_hi(wb.x), bf_lo(wb.y), bf_hi(wb.y)}, b1 = {bf_lo(wb.z), bf_hi(wb.z), bf_lo(wb.w), bf_hi(wb.w)};
                    if (u.part == 0) {
                        const u32x4 wa = *(const u32x4*)(SG + (size_t)r * 2048 + c);
                        const f32x4 a0 = {bf_lo(wa.x), bf_hi(wa.x), bf_lo(wa.y), bf_hi(wa.y)}, a1 = {bf_lo(wa.z), bf_hi(wa.z), bf_lo(wa.w), bf_hi(wa.w)};
#pragma unroll
                        for (int e = 0; e < 4; ++e) { acc[ai][bj][m][0][e] *= a0[e] * __builtin_amdgcn_rcpf(b0[e]); acc[ai][bj][m][1][e] *= a1[e] * __builtin_amdgcn_rcpf(b1[e]); }
                    } else {
                        *(u32x4*)(Y + (size_t)r * 1024 + c) = pack8(acc[ai][bj][m][0] * b0, acc[ai][bj][m][1] * b1);
                    }
                }
            }
    }
};
struct EpiRes1 {
    const float* X; bf16_t* X1B; float* SSQ;
    __device__ __forceinline__ void operator()(f32x4 (&acc)[2][2][4][2], const Unit& u, int wr, int wc, int fr, int fq) const {
        const int rbase = u.pm * 256 + wr * 64 + fr, cb = u.pn * 256 + 32 * wc + 8 * fq;
#pragma unroll
        for (int ai = 0; ai < 2; ++ai)
#pragma unroll
            for (int m = 0; m < 4; ++m) {
                const int r = rbase + ai * 128 + m * 16; float q = 0.f;
#pragma unroll
                for (int bj = 0; bj < 2; ++bj) {
                    const size_t o = (size_t)r * 1024 + cb + 128 * bj;
                    const f32x4 v0 = *(const f32x4*)(X + o) + acc[ai][bj][m][0], v1 = *(const f32x4*)(X + o + 4) + acc[ai][bj][m][1];
                    *(u32x4*)(X1B + o) = pack8(v0, v1);
                    q += sumsq4(v0) + sumsq4(v1);
                }
                q += __shfl_xor(q, 16); q += __shfl_xor(q, 32);
                if (fq == 0) SSQ[(size_t)r * 16 + 4 * u.pn + wc] = q;
            }
    }
};
struct EpiSwiglu {
    const float* SSQ; bf16_t* HDN;
    __device__ __forceinline__ void operator()(f32x4 (&acc)[2][2][4][2], const Unit& u, int wr, int wc, int fr, int fq) const {
        const int rbase = u.pm * 256 + wr * 64 + fr, cb = u.pn * 128 + 32 * wc + 8 * fq;
#pragma unroll
        for (int ai = 0; ai < 2; ++ai)
#pragma unroll
            for (int m = 0; m < 4; ++m) {
                const int r = rbase + ai * 128 + m * 16;
                float ss = 0.f;
#pragma unroll
                for (int i = 0; i < 4; ++i) { const f32x4 s4 = *(const f32x4*)(SSQ + (size_t)r * 16 + 4 * i); ss += (s4[0] + s4[1]) + (s4[2] + s4[3]); }
                const float rs = __builtin_amdgcn_rsqf(ss * (1.0f / 1024.0f) + EPS);
                f32x4 h0, h1;
#pragma unroll
                for (int e = 0; e < 4; ++e) {
                    const float g0 = acc[ai][0][m][0][e] * rs, g1 = acc[ai][0][m][1][e] * rs;
                    h0[e] = g0 * sigmoidf_fast(g0) * (acc[ai][1][m][0][e] * rs); h1[e] = g1 * sigmoidf_fast(g1) * (acc[ai][1][m][1][e] * rs);
                }
                *(u32x4*)(HDN + (((size_t)u.pm * (DFF / 64) + (cb >> 6)) * 256 + (r & 255)) * 64 + (cb & 63)) = pack8(h0, h1);
            }
    }
};
struct EpiRes2 {
    const bf16_t* X1B; float* OUT; float* SSQ;
    __device__ __forceinline__ void operator()(f32x4 (&acc)[2][2][4][2], const Unit& u, int wr, int wc, int fr, int fq) const {
        const int rbase = u.pm * 256 + wr * 64 + fr, cb = u.pn * 256 + 32 * wc + 8 * fq;
#pragma unroll
        for (int ai = 0; ai < 2; ++ai)
#pragma unroll
            for (int m = 0; m < 4; ++m) {
                const int r = rbase + ai * 128 + m * 16; float q = 0.f;
#pragma unroll
                for (int bj = 0; bj < 2; ++bj) {
                    const size_t o = (size_t)r * 1024 + cb + 128 * bj;
                    const u32x4 xb = *(const u32x4*)(X1B + o);
                    const f32x4 v0 = (f32x4){bf_lo(xb.x), bf_hi(xb.x), bf_lo(xb.y), bf_hi(xb.y)} + acc[ai][bj][m][0], v1 = (f32x4){bf_lo(xb.z), bf_hi(xb.z), bf_lo(xb.w), bf_hi(xb.w)} + acc[ai][bj][m][1];
                    *(f32x4*)(OUT + o) = v0; *(f32x4*)(OUT + o + 4) = v1;
                    q += sumsq4(v0) + sumsq4(v1);
                }
                q += __shfl_xor(q, 16); q += __shfl_xor(q, 32);
                if (fq == 0) SSQ[(size_t)r * 16 + 4 * u.pn + wc] = q;
            }
    }
};

namespace att {
constexpr int KSLOT = 12288, VSLOT = 8192, NKSL = 2, NVSL = 3;
constexpr int LDS_K = 0, LDS_V = NKSL * KSLOT, LDS_WS = LDS_V + NVSL * VSLOT, LDS_OST = LDS_WS + NWAVES * 256, LDS_TOTAL = LDS_OST + NWAVES * 4096;
static_assert(LDS_TOTAL <= RING_BYTES, "attention LDS");
constexpr float THR = 6.0f;
__device__ __forceinline__ int crow(int r, int hi) { return (r & 3) + 8 * (r >> 2) + 4 * hi; }
__device__ __forceinline__ void glds16(const void* g, unsigned lds_base) {
    unsigned sv; asm volatile("s_mov_b32 %0, m0\n\ts_mov_b32 m0, %2\n\ts_nop 0\n\tglobal_load_lds_dwordx4 %1, off\n\ts_mov_b32 m0, %0" : "=&s"(sv) : "v"(g), "s"(lds_base) : "memory"); }
#define ATT_WAIT_BAR() asm volatile("s_waitcnt vmcnt(0) lgkmcnt(0)\n\ts_barrier" ::: "memory")
#define MX3(a, b, c) __builtin_fmaxf(__builtin_fmaxf((a), (b)), (c))
__device__ __forceinline__ float rowmax(const f32x16& p0, const f32x16& p1) {
    float a = MX3(p0[0], p0[1], p1[0]), b = MX3(p0[2], p0[3], p1[1]); a = MX3(a, p1[2], p1[3]);
#pragma unroll
    for (int r = 4; r < 16; r += 4) { a = MX3(a, p0[r], p0[r + 1]); b = MX3(b, p0[r + 2], p0[r + 3]); a = MX3(a, p1[r], p1[r + 1]); b = MX3(b, p1[r + 2], p1[r + 3]); }
    float m = __builtin_fmaxf(a, b); auto rr = __builtin_amdgcn_permlane32_swap(__float_as_uint(m), __float_as_uint(m), false, false);
    return __builtin_fmaxf(__uint_as_float(rr[0]), __uint_as_float(rr[1])); }
typedef short v4i16_t __attribute__((ext_vector_type(4)));
__device__ __forceinline__ s16x4 vtr(const LAS char* p) { return __builtin_bit_cast(s16x4, __builtin_amdgcn_ds_read_tr16_b64_v4i16((LAS v4i16_t*)p)); }

template <int DQK, bool SWA>
__device__ __forceinline__ void unit(const bf16_t* Qw, int qpitch, const bf16_t* Kb, int kpitch, const bf16_t* Vb, int vpitch, bf16_t* Ow, int opitch,
                                     int pos0, int t0, int t1, int band_from, float m_init, float l_init, LAS unsigned char* lds) {
    constexpr int NKS = DQK / 16, NCH = DQK / 8;
    constexpr bool FIRST_REF = !SWA;
    const int tid = threadIdx.x, lane = tid & 63, r32 = lane & 31, hi = lane >> 5; const int wid = __builtin_amdgcn_readfirstlane(tid >> 6);
#ifndef ATT_LATE
#define ATT_LATE (wid >= 4)
#endif
    const bool late = ATT_LATE;
    const unsigned lds0 = (unsigned)(uintptr_t)lds;
    LAS float* wsf = (LAS float*)(lds + LDS_WS) + wid * 64;
    const bf16_t* ksrc = Kb + (size_t)lane * kpitch + wid * 8;
    const bf16_t* vsrc = Vb + (size_t)(16 * (wid & 3) + (lane >> 2)) * vpitch + (wid >> 2) * 32 + (lane & 3) * 8;
    const unsigned kdst = lds0 + LDS_K + wid * 1024, vdst = lds0 + LDS_V + wid * 1024;
#define ATT_DMA(t, ks, vs) do { glds16(ksrc + (size_t)(t) * 64 * kpitch, (unsigned)__builtin_amdgcn_readfirstlane(kdst + (ks) * KSLOT)); \
        if (NCH > 8 && wid + 8 < NCH) glds16(ksrc + (size_t)(t) * 64 * kpitch + 64, (unsigned)__builtin_amdgcn_readfirstlane(kdst + (ks) * KSLOT + 8192)); \
        glds16(vsrc + (size_t)(t) * 64 * vpitch, (unsigned)__builtin_amdgcn_readfirstlane(vdst + (vs) * VSLOT)); } while (0)
    ATT_DMA(t0, 0, 0);
    bf16x8 qr[NKS];
#pragma unroll
    for (int d0 = 0; d0 < NKS; ++d0) qr[d0] = *(const bf16x8*)(Qw + (size_t)r32 * qpitch + d0 * 16 + hi * 8);
    float mrun = FIRST_REF ? 0.f : m_init, l_reg = (hi == 0) ? l_init : 0.f; f32x16 o[2]; o[0] = f32x16{}; o[1] = f32x16{};
    f32x16 negm;
#pragma unroll
    for (int r = 0; r < 16; ++r) negm[r] = -mrun;
    asm volatile("" : "+v"(negm));
    const int qpos = pos0 + r32;
    f32x16 p0, p1;
    const LAS char* vlane = (const LAS char*)(lds + LDS_V) + ((lane >> 4) & 1) * 32 + (lane & 3) * 8 + (4 * hi + ((lane & 15) >> 2)) * 64;
    const LAS unsigned char* klane = lds + LDS_K + hi * 1024 + r32 * 16;

#define ATT_QK(ks) do { const LAS unsigned char* kb_ = klane + (ks) * KSLOT; bf16x8 kf[2 * NKS]; \
        _Pragma("unroll") for (int d0 = 0; d0 < NKS; ++d0) { kf[2 * d0] = *(const LAS bf16x8*)(kb_ + d0 * 2048); kf[2 * d0 + 1] = *(const LAS bf16x8*)(kb_ + d0 * 2048 + 512); } \
        __builtin_amdgcn_sched_barrier(0); \
        _Pragma("unroll") for (int d0 = 0; d0 < NKS; ++d0) { \
            if (d0 == 0) { p0 = __builtin_amdgcn_mfma_f32_32x32x16_bf16(kf[0], qr[0], negm, 0, 0, 0); p1 = __builtin_amdgcn_mfma_f32_32x32x16_bf16(kf[1], qr[0], negm, 0, 0, 0); } \
            else { p0 = __builtin_amdgcn_mfma_f32_32x32x16_bf16(kf[2 * d0], qr[d0], p0, 0, 0, 0); p1 = __builtin_amdgcn_mfma_f32_32x32x16_bf16(kf[2 * d0 + 1], qr[d0], p1, 0, 0, 0); } } } while (0)
#define ATT_SMPV(tt, vs) do { \
        const LAS char* vp = vlane + (vs) * VSLOT; s16x4 vlo[8], vhh[8]; \
        _Pragma("unroll") for (int i_ = 0; i_ < 8; ++i_) { vlo[i_] = vtr(vp + (i_ >> 2) * 4096 + (i_ & 3) * 1024); vhh[i_] = vtr(vp + (i_ >> 2) * 4096 + (i_ & 3) * 1024 + 512); } \
        __builtin_amdgcn_sched_barrier(0); \
        if (SWA || (tt) >= band_from) { const int kb0 = (tt) * 64 + 4 * hi; \
            _Pragma("unroll") for (int r = 0; r < 16; ++r) { const int kv = kb0 + (r & 3) + 8 * (r >> 2); \
                bool ok0 = kv <= qpos, ok1 = kv + 32 <= qpos; if (SWA) { ok0 = ok0 && (kv > qpos - 128); ok1 = ok1 && (kv + 32 > qpos - 128); } \
                if (!ok0) p0[r] = -__builtin_inff(); if (!ok1) p1[r] = -__builtin_inff(); } } \
        const float rm = rowmax(p0, p1); \
        const bool first_ = FIRST_REF && (tt) == t0; \
        if (first_ || __any(rm > THR)) { \
            const float dl = first_ ? rm : __builtin_fmaxf(rm, 0.f); mrun += dl; \
            _Pragma("unroll") for (int r = 0; r < 16; ++r) { p0[r] -= dl; p1[r] -= dl; } \
            _Pragma("unroll") for (int r = 0; r < 16; ++r) negm[r] = -mrun; \
            asm volatile("" : "+v"(negm)); \
            if (!first_) { const float f = __builtin_amdgcn_exp2f(-dl); l_reg *= f; if (hi == 0) wsf[r32] = f; \
                _Pragma("unroll") for (int r = 0; r < 16; ++r) { const float fr_ = wsf[crow(r, hi)]; o[0][r] *= fr_; o[1][r] *= fr_; } } } \
        float sa0 = 0.f, sa1 = 0.f, sa2 = 0.f, sa3 = 0.f; \
        _Pragma("unroll") for (int r = 0; r < 16; r += 2) { p0[r] = __builtin_amdgcn_exp2f(p0[r]); p1[r] = __builtin_amdgcn_exp2f(p1[r]); p0[r + 1] = __builtin_amdgcn_exp2f(p0[r + 1]); p1[r + 1] = __builtin_amdgcn_exp2f(p1[r + 1]); \
            sa0 += p0[r]; sa1 += p1[r]; sa2 += p0[r + 1]; sa3 += p1[r + 1]; } \
        l_reg += (sa0 + sa1) + (sa2 + sa3); \
        u32x4 pw[4]; \
        pw[0] = (u32x4){cvtpk(p0[0], p0[1]), cvtpk(p0[2], p0[3]), cvtpk(p0[4], p0[5]), cvtpk(p0[6], p0[7])}; \
        pw[1] = (u32x4){cvtpk(p0[8], p0[9]), cvtpk(p0[10], p0[11]), cvtpk(p0[12], p0[13]), cvtpk(p0[14], p0[15])}; \
        pw[2] = (u32x4){cvtpk(p1[0], p1[1]), cvtpk(p1[2], p1[3]), cvtpk(p1[4], p1[5]), cvtpk(p1[6], p1[7])}; \
        pw[3] = (u32x4){cvtpk(p1[8], p1[9]), cvtpk(p1[10], p1[11]), cvtpk(p1[12], p1[13]), cvtpk(p1[14], p1[15])}; \
        _Pragma("unroll") for (int d0 = 0; d0 < 2; ++d0) _Pragma("unroll") for (int ks_ = 0; ks_ < 4; ++ks_) { \
            const s16x4 lo = vlo[d0 * 4 + ks_], hh = vhh[d0 * 4 + ks_]; \
            const bf16x8 vf = (bf16x8){lo[0], lo[1], lo[2], lo[3], hh[0], hh[1], hh[2], hh[3]}; \
            o[d0] = __builtin_amdgcn_mfma_f32_32x32x16_bf16(__builtin_bit_cast(bf16x8, pw[ks_]), vf, o[d0], 0, 0, 0); } } while (0)

    ATT_WAIT_BAR();
    if (t0 + 1 < t1) ATT_DMA(t0 + 1, 1, 1);
    int ks = 0, vs = 0;
#pragma unroll 1
    for (int t = t0; t < t1; ++t) {
        const int ksn = ks ^ 1, vsn = (vs == NVSL - 1) ? 0 : vs + 1, vsnn = (vsn == NVSL - 1) ? 0 : vsn + 1;
        ATT_QK(ks);
        if (late && t + 1 < t1) { ATT_WAIT_BAR(); if (t + 2 < t1) ATT_DMA(t + 2, ks, vsnn); }
        ATT_SMPV(t, vs);
        if (!late && t + 1 < t1) { ATT_WAIT_BAR(); if (t + 2 < t1) ATT_DMA(t + 2, ks, vsnn); }
        ks = ksn; vs = vsn;
    }
    { auto rr = __builtin_amdgcn_permlane32_swap(__float_as_uint(l_reg), __float_as_uint(l_reg), false, false); l_reg = __uint_as_float(rr[0]) + __uint_as_float(rr[1]); }
    if (hi == 0) wsf[32 + r32] = l_reg;
    float rli[16];
#pragma unroll
    for (int r = 0; r < 16; ++r) rli[r] = __builtin_amdgcn_rcpf(wsf[32 + crow(r, hi)]);
    LAS bf16_t* stg = (LAS bf16_t*)(lds + LDS_OST) + wid * 2048;
#pragma unroll
    for (int r = 0; r < 16; ++r) { const int orow = crow(r, hi);
#pragma unroll
        for (int d0 = 0; d0 < 2; ++d0) stg[orow * 64 + d0 * 32 + r32] = (bf16_t)(cvtpk(o[d0][r] * rli[r], 0.f) & 0xffffu); }
    asm volatile("s_waitcnt lgkmcnt(0)" ::: "memory");
#pragma unroll
    for (int i = 0; i < 4; ++i) { const int row = i * 8 + (lane >> 3), ch = lane & 7; const u32x4 v = *(const LAS u32x4*)(stg + row * 64 + ch * 8); *(u32x4*)(Ow + (size_t)row * opitch + ch * 8) = v; }
    asm volatile("s_waitcnt lgkmcnt(0)\n\ts_barrier" ::: "memory");
#undef ATT_DMA
#undef ATT_QK
#undef ATT_SMPV
}
#undef MX3
}

#define XB_TMO      128
#define XB_XCNT(j)  (256  + 64 * (j))
#define XB_XSUB(j)  (1280 + 64 * (j))
#define XB_XGEN(j)  (2304 + 64 * (j))
#define XB_TOP      3328
#define XB_TOPGEN   3392
#define XCD_BAR_WORDS 3456
#define XB_SPIN_CAP (1u << 18)
__device__ __forceinline__ unsigned xb_ld(unsigned* p)              { return __hip_atomic_load(p, __ATOMIC_RELAXED, __HIP_MEMORY_SCOPE_AGENT); }
__device__ __forceinline__ unsigned xb_add(unsigned* p, unsigned v) { return __hip_atomic_fetch_add(p, v, __ATOMIC_RELAXED, __HIP_MEMORY_SCOPE_AGENT); }
__device__ __forceinline__ unsigned xb_xcc_id() { return (unsigned)__builtin_amdgcn_s_getreg((3 << 11) | 20) & 0xFu; }
#define XB_SPIN(cond, bar) do { unsigned _sp = 0; while (cond) { __builtin_amdgcn_s_sleep(1); \
    if ((++_sp & 255u) == 0u) { if (xb_ld(&(bar)[XB_TMO])) break; if (_sp > XB_SPIN_CAP) { atomicAdd(&(bar)[XB_TMO], 1u); break; } } } } while (0)
struct XcdBarrier { unsigned* bar; unsigned x; volatile LAS unsigned* st; };
__device__ __forceinline__ XcdBarrier xcd_barrier_post(unsigned* bar, volatile LAS unsigned* st) {
    XcdBarrier b; b.bar = bar; b.x = xb_xcc_id(); b.st = st;
    if (threadIdx.x == 0) (void)xb_add(&bar[XB_XCNT(b.x)], 1u);
    return b;
}
__device__ __forceinline__ void xcd_barrier_complete(unsigned* bar, unsigned x, unsigned& nloc, unsigned& nx) {
    const unsigned G = gridDim.x * gridDim.y * gridDim.z;
    unsigned sum, cnt, mine, sp = 0u;
    for (;;) {
        sum = 0u; cnt = 0u; mine = 0u;
#pragma unroll
        for (unsigned j = 0; j < 16; ++j) { const unsigned c = xb_ld(&bar[XB_XCNT(j)]); sum += c; cnt += (c > 0u) ? 1u : 0u; mine = (j == x) ? c : mine; }
        if (sum == G) break;
        __builtin_amdgcn_s_sleep(1);
        if ((++sp & 255u) == 0u) { if (xb_ld(&bar[XB_TMO])) break; if (sp > XB_SPIN_CAP) { atomicAdd(&bar[XB_TMO], 1u); break; } }
    }
    nloc = mine > 0u ? mine : 1u; nx = cnt > 0u ? cnt : 1u;
}
__device__ __forceinline__ void xcd_barrier(const XcdBarrier& b) {
    asm volatile("s_waitcnt vmcnt(0)" ::: "memory");
    __syncthreads();
    if (threadIdx.x == 0) {
        unsigned* bar = b.bar;
        __builtin_amdgcn_s_waitcnt(0);
        unsigned nloc = b.st[0], nx = b.st[1];
        if (nloc == 0u) { xcd_barrier_complete(bar, b.x, nloc, nx); b.st[0] = nloc; b.st[1] = nx; }
        const unsigned old = xb_add(&bar[XB_XSUB(b.x)], 1u);
        const unsigned gen = old / nloc;
        if (old + 1u == (gen + 1u) * nloc) {
            __builtin_amdgcn_fence(__ATOMIC_RELEASE, "agent");
            asm volatile("s_waitcnt vmcnt(0)" ::: "memory");
            const unsigned og = xb_add(&bar[XB_TOP], 1u);
            const unsigned tg = og / nx;
            if (og + 1u == (tg + 1u) * nx) xb_add(&bar[XB_TOPGEN], 1u);
            else XB_SPIN(xb_ld(&bar[XB_TOPGEN]) == tg, bar);
            __builtin_amdgcn_fence(__ATOMIC_ACQUIRE, "agent");
            xb_add(&bar[XB_XGEN(b.x)], 1u);
            asm volatile("s_waitcnt vmcnt(0)" ::: "memory");
        } else {
            XB_SPIN(xb_ld(&bar[XB_XGEN(b.x)]) == gen, bar);
            __builtin_amdgcn_fence(__ATOMIC_ACQUIRE, "agent");
            asm volatile("s_waitcnt vmcnt(0)" ::: "memory");
        }
    }
    __syncthreads();
}

struct Args { const float* in[16]; float* out; unsigned char* ws; int ph_lo, ph_hi; };

__device__ __forceinline__ int rope64_src(int vv) { return 4 * (vv >> 3) + (vv & 3) + 32 * ((vv >> 2) & 1); }
__device__ __forceinline__ int rope32_src(int vv) { return 4 * (vv >> 3) + (vv & 3) + 16 * ((vv >> 2) & 1); }
__device__ __forceinline__ int src_w1(int v) {
    if (v < 512) return O_QA + (v & ~63) + rope64_src(v & 63);
    if (v < 640) { const int u = v - 512; return O_KA + (u & ~63) + rope64_src(u & 63); }
    if (v < 768) return O_VA + (v - 640);
    if (v < 1152) return O_QL + (v - 768);
    if (v < 1184) return O_KR + rope32_src(v - 1152);
    if (v < 1280) return -1;
    if (v < 1536) return O_KVL + (v - 1280);
    if (v < 2560) return O_GA + (v - 1536);
    return O_GB + (v - 2560);
}
__device__ __forceinline__ int src_uq(int v) { if (v < 512) return (v >> 6) * 96 + (v & 63); const int u = v - 512; return (u >> 5) * 96 + 64 + rope32_src(u & 31); }
__device__ __forceinline__ int src_ukv(int v) { if (v < 512) return (v >> 6) * 128 + (v & 63); const int u = v - 512; return (u >> 6) * 128 + 64 + (u & 63); }

template <bool GAIN> __device__ __forceinline__ void tr_item_t(const float* W, int ldw, int sc, const float* gain, int k0, bf16_t* dst, int ldd, LAS float* scr, int lane) {
    const float msk = sc >= 0 ? 1.f : 0.f; const int scc = sc >= 0 ? sc : 0;
#pragma unroll 8
    for (int i = 0; i < 32; ++i) { const int kk = 2 * i + (lane >> 5); float v = W[(size_t)(k0 + kk) * ldw + scc] * msk; if (GAIN) v *= gain[k0 + kk]; scr[kk * 33 + (lane & 31)] = v; }
    asm volatile("s_waitcnt lgkmcnt(0)" ::: "memory");
    const int c = lane & 7;
#pragma unroll
    for (int j = 0; j < 4; ++j) { const int n = (lane >> 3) + 8 * j; const LAS float* s = scr + (8 * c) * 33 + n;
        u32x4 o; o.x = cvtpk(s[0 * 33], s[1 * 33]); o.y = cvtpk(s[2 * 33], s[3 * 33]); o.z = cvtpk(s[4 * 33], s[5 * 33]); o.w = cvtpk(s[6 * 33], s[7 * 33]);
        *(u32x4*)(dst + (size_t)n * ldd + k0 + 8 * c) = o; }
    asm volatile("s_waitcnt lgkmcnt(0)" ::: "memory");
}

__device__ __forceinline__ void tr_item(const float* W, int ldw, int sc, const float* gain, int k0, bf16_t* dst, int ldd, LAS float* scr, int lane) {
    if (gain) tr_item_t<true>(W, ldw, sc, gain, k0, dst, ldd, scr, lane); else tr_item_t<false>(W, ldw, sc, gain, k0, dst, ldd, scr, lane);
}

__global__ void __launch_bounds__(NWAVES * 64, 2) fwd_kernel(Args args) {
    extern __shared__ __attribute__((aligned(16))) unsigned char lds_raw[];
    LAS unsigned char* lds = (LAS unsigned char*)lds_raw;
    const int tid = threadIdx.x, lane = tid & 63, wave = __builtin_amdgcn_readfirstlane(tid >> 6);
    const int G = gridDim.x, bx = blockIdx.x;
    const int vcu = (G % 8 == 0) ? (bx % 8) * (G / 8) + bx / 8 : bx;
    unsigned char* ws = args.ws;
    const float* X = args.in[0]; float* OUT = args.out;
    bf16_t* W1T = (bf16_t*)(ws + WS_W1T); bf16_t* WUQT = (bf16_t*)(ws + WS_WUQT); bf16_t* WUKVT = (bf16_t*)(ws + WS_WUKVT); bf16_t* WOT = (bf16_t*)(ws + WS_WOT);
    bf16_t* WOUTT = (bf16_t*)(ws + WS_WOUTT); bf16_t* WGUT = (bf16_t*)(ws + WS_WGUT); bf16_t* WDT = (bf16_t*)(ws + WS_WDT);
    float* cosA = (float*)(ws + WS_TAB); float* sinA = cosA + SEQ * 32; float* cosB = sinA + SEQ * 32; float* sinB = cosB + SEQ * 16;
    float* SSQ_Q = (float*)(ws + WS_SSQ); float* SSQ_KV = SSQ_Q + (size_t)T * 8; float* SSQ_X1 = SSQ_KV + (size_t)T * 4; float* SSQ_X2 = SSQ_X1 + (size_t)T * 16;
    bf16_t* XN = (bf16_t*)(ws + WS_XN); bf16_t* SG = (bf16_t*)(ws + WS_SG); bf16_t* QA = (bf16_t*)(ws + WS_QA); bf16_t* KA = (bf16_t*)(ws + WS_KA); bf16_t* VA = (bf16_t*)(ws + WS_VA);
    bf16_t* QLAT = (bf16_t*)(ws + WS_QLAT); bf16_t* KVLAT = (bf16_t*)(ws + WS_KVLAT); bf16_t* QM = (bf16_t*)(ws + WS_QM); bf16_t* KM = (bf16_t*)(ws + WS_KM);
    bf16_t* VM = (bf16_t*)(ws + WS_VM); bf16_t* OB = (bf16_t*)(ws + WS_OB); bf16_t* OA = (bf16_t*)(ws + WS_OA); bf16_t* Y = (bf16_t*)(ws + WS_Y); bf16_t* HDN = (bf16_t*)(ws + WS_HDN); float* X2 = (float*)(ws + WS_X2);
    const int lo = args.ph_lo, hi = args.ph_hi;
#ifndef PHASE_MASK
#define PHASE_MASK 0x1ff
#endif
#define IN(k) (((PHASE_MASK >> (k)) & 1) && lo <= (k) && (k) < hi)
#if MK_N_LAUNCHES == 1
    for (int u = tid; u < 32; u += NWAVES * 64) ((LAS unsigned*)(lds + MISC_OFF))[u] = 0u;
    __syncthreads();
    const XcdBarrier bar = xcd_barrier_post((unsigned*)(ws + WS_CTL), (volatile LAS unsigned*)(lds + MISC_OFF) + 8);
#define GRID_BAR() do { for (int rb_ = 0; rb_ < REP_BAR; ++rb_) xcd_barrier(bar); } while (0)
#else
#define GRID_BAR() do {} while (0)
#endif

    if (IN(0)) {
      for (int rep_ = 0; rep_ < REP_P0; ++rep_) {
        LAS float* scr = (LAS float*)(lds + wave * 16384);
        const int gw = vcu * NWAVES + wave, NGW = G * NWAVES;
        constexpr int I_W1 = (DM / 64) * (NV1 / 32), I_UQ = (384 / 64) * (768 / 32), I_UKV = (256 / 64) * (1024 / 32), I_O = (512 / 64) * (1024 / 32), I_OUT = (DM / 64) * (DM / 32),
                      I_GU = (DM / 64) * (2 * DFF / 32), I_D = (DFF / 64) * (DM / 32);
        constexpr int NITEMS = I_W1 + I_UQ + I_UKV + 2 * I_O + I_OUT + I_GU + I_D;
        const int ln = lane & 31;
        for (int it = gw; it < NITEMS; it += NGW) {
            int r = it;
            if (r < I_W1) { const int nblk = NV1 / 32, kb = r / nblk, nb = r % nblk; tr_item(args.in[2], INW, src_w1(nb * 32 + ln), nullptr, kb * 64, W1T + (size_t)nb * 32 * DM, DM, scr, lane); continue; } r -= I_W1;
            if (r < I_UQ) { const int nblk = 768 / 32, kb = r / nblk, nb = r % nblk; tr_item(args.in[5], 768, src_uq(nb * 32 + ln), args.in[4], kb * 64, WUQT + (size_t)nb * 32 * 384, 384, scr, lane); continue; } r -= I_UQ;
            if (r < I_UKV) { const int nblk = 1024 / 32, kb = r / nblk, nb = r % nblk; tr_item(args.in[7], 1024, src_ukv(nb * 32 + ln), args.in[6], kb * 64, WUKVT + (size_t)nb * 32 * 256, 256, scr, lane); continue; } r -= I_UKV;
            if (r < I_O) { const int nblk = 1024 / 32, kb = r / nblk, nb = r % nblk; tr_item(args.in[8], DM, nb * 32 + ln, nullptr, kb * 64, WOT + (size_t)nb * 32 * 1024, 1024, scr, lane); continue; } r -= I_O;
            if (r < I_O) { const int nblk = 1024 / 32, kb = r / nblk, nb = r % nblk; tr_item(args.in[9], DM, nb * 32 + ln, nullptr, kb * 64, WOT + (size_t)nb * 32 * 1024 + 512, 1024, scr, lane); continue; } r -= I_O;
            if (r < I_OUT) { const int nblk = DM / 32, kb = r / nblk, nb = r % nblk; tr_item(args.in[10], DM, nb * 32 + ln, nullptr, kb * 64, WOUTT + (size_t)nb * 32 * DM, DM, scr, lane); continue; } r -= I_OUT;
            if (r < I_GU) { const int nblk = 2 * DFF / 32, kb = r / nblk, nb = r % nblk; const int v = nb * 32, pn = v >> 8, bj = (v >> 7) & 1, c = 128 * pn + (v & 127) + ln;
                            tr_item(bj ? args.in[13] : args.in[12], DFF, c, args.in[11], kb * 64, WGUT + (size_t)v * DM, DM, scr, lane); continue; } r -= I_GU;
            { const int nblk = DM / 32, kb = r / nblk, nb = r % nblk; tr_item(args.in[14], DM, nb * 32 + ln, nullptr, kb * 64, WDT + (size_t)nb * 32 * DFF, DFF, scr, lane); }
        }
        for (int i = (vcu * NWAVES + wave) * 64 + lane; i < SEQ * 32; i += G * NWAVES * 64) {
            { const int p = i >> 5, j = i & 31; const double a = (double)p * pow(10000.0, -(double)j / 32.0); cosA[i] = (float)cos(a); sinA[i] = (float)sin(a); }
            if (i < SEQ * 16) { const int p = i >> 4, j = i & 15; const double a = (double)p * pow(10000.0, -(double)j / 16.0); cosB[i] = (float)cos(a); sinB[i] = (float)sin(a); }
        }
        const float* g1 = args.in[1];
        f32x4 gv[4];
#pragma unroll
        for (int j = 0; j < 4; ++j) gv[j] = *(const f32x4*)(g1 + 4 * lane + 256 * j);
        for (int m = gw; m < T; m += NGW) {
            const f32x4* xr = (const f32x4*)(X + (size_t)m * DM) + lane;
            f32x4 v[4]; float s = 0.f;
#pragma unroll
            for (int j = 0; j < 4; ++j) { v[j] = xr[64 * j]; s += sumsq4(v[j]); }
            const float rs = 1.0f / sqrtf(wave_sum(s) * (1.0f / DM) + EPS);
            u32x2* o8 = (u32x2*)(XN + (size_t)m * DM) + lane;
#pragma unroll
            for (int j = 0; j < 4; ++j) o8[64 * j] = pack4(v[j] * rs * gv[j]);
        }
      }
        if (IN(1)) GRID_BAR();
    }

    if (IN(1)) {
        pg8::Gemm g{XN, W1T, DM, DM, DM, (size_t)256 * DM * 2};
        pg8::SchedPlain S{{}, g, 0}; S.o.init(T / 256, NV1 / 256, G, bx);
        EpiProj E{QA, KA, VA, QLAT, KVLAT, KM, SG, SSQ_Q, SSQ_KV, cosA, sinA, cosB, sinB};
        pg8::gemm_phase<EpiProj, pg8::SchedPlain, true, true>(lds, DM, DM, DM, S, E);
        if (REP_P1 > 1) pg8::gemm_phase<EpiProj, pg8::SchedPlain, true, true>(lds, DM, DM, DM, S, E);
        if (IN(2)) GRID_BAR();
    }

    if (IN(2)) {
        { pg8::Gemm g{QLAT, WUQT, 384, 384, 384, (size_t)256 * 384 * 2};
          pg8::SchedPlain S{{}, g, 0}; S.o.init(T / 256, 3, G, bx);
          EpiUQ E{QM, SSQ_Q, cosB, sinB};
          pg8::gemm_phase<EpiUQ, pg8::SchedPlain, true, true>(lds, 384, 384, 384, S, E);
          if (REP_P2 > 1) pg8::gemm_phase<EpiUQ, pg8::SchedPlain, true, true>(lds, 384, 384, 384, S, E); }
        { pg8::Gemm g{KVLAT, WUKVT, 256, 256, 256, (size_t)256 * 256 * 2};
          pg8::SchedPlain S{{}, g, 0}; S.o.init(T / 256, 4, G, (G - 1) - bx);
          EpiUKV E{KM, VM, SSQ_KV};
          pg8::gemm_phase<EpiUKV, pg8::SchedPlain, true, true>(lds, 256, 256, 256, S, E);
          if (REP_P2 > 1) pg8::gemm_phase<EpiUKV, pg8::SchedPlain, true, true>(lds, 256, 256, 256, S, E); }
        if (IN(3)) GRID_BAR();
    }

    if (IN(3)) {
        const float* sinks = args.in[3];
        for (int rep_ = 0; rep_ < REP_MLA; ++rep_)
        for (int base = vcu; base < 256; base += G) {
            const int bh = base >> 2, s = base & 3, b = bh >> 3, h = bh & 7;
            for (int i = 0; i < 4; ++i) {
                const int qb = (i == 0) ? s : (i == 1) ? 7 - s : (i == 2) ? 8 + s : 15 - s;
                const size_t row0 = (size_t)b * SEQ;
                const int q0 = qb * 256 + wave * 32;
                att::unit<96, false>(QM + (row0 + q0) * 768 + h * 96, 768, KM + row0 * 768 + h * 96, 768, VM + row0 * 512 + h * 64, 512,
                                     OB + (row0 + q0) * 512 + h * 64, 512, q0, 0, 4 * qb + 4, 4 * qb, -1e30f, 0.f, lds);
            }
        }
        for (int rep_ = 0; rep_ < REP_SWA; ++rep_)
        for (int base = vcu; base < 256; base += G) {
            const int bk = base >> 4, b = bk >> 1, kvh = bk & 1;
            for (int i = 0; i < 4; ++i) {
                const int blk = (base & 15) + 16 * i;
                const size_t row0 = (size_t)b * SEQ;
                const int hq = 4 * kvh + (wave >> 1), q0 = 64 * blk + 32 * (wave & 1);
                const int t0 = blk >= 2 ? blk - 2 : 0;
                const float sk = sinks[hq] * LOG2E;
                att::unit<64, true>(QA + (row0 + q0) * 512 + hq * 64, 512, KA + row0 * 128 + kvh * 64, 128, VA + row0 * 128 + kvh * 64, 128,
                                    OA + (row0 + q0) * 512 + hq * 64, 512, q0, t0, blk + 1, 0, sk, 1.0f, lds);
            }
        }
        if (IN(4)) GRID_BAR();
    }

    if (IN(4)) {
        pg8::SchedPair S{{}, OA, OB, WOT, 512, 1024, 512}; S.o.init(T / 256, 4, G, bx);
        EpiGate E{SG, Y};
        for (int rep_ = 0; rep_ < REP_P4; ++rep_) pg8::gemm_phase<EpiGate, pg8::SchedPair, true, true>(lds, 512, 1024, 512, S, E);
        if (IN(5)) GRID_BAR();
    }

    if (IN(5)) {
        pg8::Gemm g{Y, WOUTT, DM, DM, DM, (size_t)256 * DM * 2};
        pg8::SchedPlain S{{}, g, 0}; S.o.init(T / 256, 4, G, bx);
        EpiRes1 E{X, XN, SSQ_X1};
        for (int rep_ = 0; rep_ < REP_P5; ++rep_) pg8::gemm_phase<EpiRes1, pg8::SchedPlain, true, true>(lds, DM, DM, DM, S, E);
        if (IN(6)) GRID_BAR();
    }

    if (IN(6)) {
        pg8::Gemm g{XN, WGUT, DM, DM, DM, (size_t)256 * DM * 2};
        pg8::SchedPlain S{{}, g, 0}; S.o.init(T / 256, 22, G, bx);
        EpiSwiglu E{SSQ_X1, HDN};
        for (int rep_ = 0; rep_ < REP_P6; ++rep_) pg8::gemm_phase<EpiSwiglu, pg8::SchedPlain, true, true>(lds, DM, DM, DM, S, E);
        if (IN(7)) GRID_BAR();
    }

    if (IN(7)) {
        pg8::Gemm g{HDN, WDT, 64, DFF, DFF, (size_t)(DFF / 64) * 256 * 64 * 2};
        pg8::SchedPlain S{{}, g, (G == 256) ? P7_REV : 0}; S.o.init(T / 256, 4, G, bx);
        EpiRes2 E{XN, X2, SSQ_X2};
        pg8::gemm_phase<EpiRes2, pg8::SchedPlain, true, true>(lds, 64, DFF, DFF, S, E, 256 * 64 * 2);
        if (REP_P7 > 1) pg8::gemm_phase<EpiRes2, pg8::SchedPlain, true, true>(lds, 64, DFF, DFF, S, E, 256 * 64 * 2);
        if (IN(8)) GRID_BAR();
    }

    if (IN(8)) {
        const int gw = vcu * NWAVES + wave, NGW = G * NWAVES;
        const float* gf = args.in[15];
        f32x4 gv[4];
#pragma unroll
        for (int j = 0; j < 4; ++j) gv[j] = *(const f32x4*)(gf + 4 * lane + 256 * j);
        for (int rep_ = 0; rep_ < REP_P8; ++rep_)
        for (int m = gw; m < T; m += NGW) {
            float ss = 0.f;
#pragma unroll
            for (int i = 0; i < 4; ++i) { const f32x4 s4 = *(const f32x4*)(SSQ_X2 + (size_t)m * 16 + 4 * i); ss += (s4[0] + s4[1]) + (s4[2] + s4[3]); }
            const float rs = 1.0f / sqrtf(ss * (1.0f / DM) + EPS);
            const f32x4* xr = (const f32x4*)(X2 + (size_t)m * DM) + lane; f32x4* orow = (f32x4*)(OUT + (size_t)m * DM) + lane;
#pragma unroll
            for (int j = 0; j < 4; ++j) orow[64 * j] = xr[64 * j] * rs * gv[j];
        }
    }
#undef IN
#undef GRID_BAR
}

extern "C" void kernel_launch(void* const* d_in, const int* in_sizes, int n_in, void* d_out, int out_size, void* d_ws, size_t ws_size, hipStream_t stream) {
    static int grid = 0;
    if (grid == 0) {
        if (n_in != 16 || out_size != T * DM || ws_size < WS_END) { fprintf(stderr, "kernel_launch: unexpected shapes (n_in %d out %d ws %zu, need ws >= %zu)\n", n_in, out_size, ws_size, (size_t)WS_END); grid = -1; return; }
        int dev = 0, cus = 0, per_cu = 0;
        hipGetDevice(&dev); hipDeviceGetAttribute(&cus, hipDeviceAttributeMultiprocessorCount, dev);
        if (hipFuncSetAttribute((const void*)fwd_kernel, hipFuncAttributeMaxDynamicSharedMemorySize, LDS_BYTES) != hipSuccess) { fprintf(stderr, "kernel_launch: hipFuncSetAttribute failed\n"); grid = -1; return; }
        if (hipOccupancyMaxActiveBlocksPerMultiprocessor(&per_cu, (const void*)fwd_kernel, NWAVES * 64, LDS_BYTES) != hipSuccess || per_cu < 1) { fprintf(stderr, "kernel_launch: occupancy query says %d\n", per_cu); per_cu = 1; }
        (void)hipGetLastError();
        grid = cus;
        fprintf(stderr, "kernel_launch: grid %d (cus %d, per_cu %d)\n", grid, cus, per_cu);
    }
    if (grid < 0) return;
    Args a{};
    for (int i = 0; i < 16; ++i) a.in[i] = (const float*)d_in[i];
    a.out = (float*)d_out; a.ws = (unsigned char*)d_ws;
#if MK_N_LAUNCHES == 1
    a.ph_lo = 0; a.ph_hi = 9;
    if (hipMemsetAsync((char*)d_ws + WS_CTL, 0, CTL_BYTES, stream) != hipSuccess) { fprintf(stderr, "kernel_launch: memset failed\n"); return; }
    void* kargs[] = {&a};
    hipError_t e = hipLaunchCooperativeKernel((const void*)fwd_kernel, dim3(grid), dim3(NWAVES * 64), kargs, LDS_BYTES, stream);
    if (e != hipSuccess) fprintf(stderr, "cooperative launch failed: %s (grid %d)\n", hipGetErrorString(e), grid);
#else
    for (int p = 0; p < 9; ++p) { a.ph_lo = p; a.ph_hi = p + 1; hipLaunchKernelGGL(fwd_kernel, dim3(grid), dim3(NWAVES * 64), LDS_BYTES, stream, a); }
#endif
}
```
